# Optimizing an MI355X kernel written in HIP

```python
import math
import numpy as np
import jax
import jax.numpy as jnp
from jax import lax

D_MODEL = 2048
BATCH = 4
SEQ = 2048
DEPTH = 2
DEC_BATCH = 1
DEC_SEQ = 16384
PAST_LEN = 128

LRU_WIDTH = D_MODEL // 2
LRU_BLOCKS = 16
LRU_BLOCK_W = LRU_WIDTH // LRU_BLOCKS
LRU_CONV_W = 4
LRU_C = 8.0
S5_WIDTH = D_MODEL // 2
S5_GROUP_CH = 16
S5_GROUPS = S5_WIDTH // S5_GROUP_CH
S5_STATE = 64
HEAD_DIM = 64
ATT_GROUPS = ((128, 1), (512, 4), (2048, 16))
N_ATT_GROUPS = 3
ATT_WIDTH = 3 * D_MODEL // 4
ATT_HEADS = ATT_WIDTH // HEAD_DIM
HEADS_PER_GROUP = ATT_HEADS // N_ATT_GROUPS
ATT_OUT = HEADS_PER_GROUP * HEAD_DIM
Q_BLOCK = 128
REL_BUCKETS = 32
REL_MAX_DIST = 1024
D_FF = 11 * D_MODEL // 4
N_NORMS = 6
N_IN = 2 * LRU_WIDTH + S5_WIDTH + 3 * ATT_WIDTH + 3 * D_MODEL
RMS_EPS = 1e-6
NEG_INF = -1e30

kernel_name = 'hybrid_bidir_rglru_s5_dilated_attn_encoder'


def _t5_buckets(rel):
    half = REL_BUCKETS // 2
    max_exact = half // 2
    sign = (rel > 0).astype(np.int32) * half
    n = np.abs(rel)
    large = max_exact + (np.log(np.maximum(n, 1) / max_exact)
                         / np.log(REL_MAX_DIST / max_exact) * (half - max_exact)).astype(np.int32)
    large = np.minimum(large, half - 1)
    return sign + np.where(n < max_exact, n, large)


def _rmsnorm(x, g):
    x32 = x.astype(jnp.float32)
    y = x32 * lax.rsqrt(jnp.mean(x32 * x32, axis=-1, keepdims=True) + RMS_EPS)
    return (y * g.astype(jnp.float32)).astype(x.dtype)


def _swiglu(h, w1, w3, w2):
    return (jax.nn.silu(h @ w1) * (h @ w3)) @ w2


def _centred_dwconv(x, w, b):
    T = x.shape[1]
    left = LRU_CONV_W // 2
    xp = jnp.pad(x, ((0, 0), (left, LRU_CONV_W - 1 - left), (0, 0)))
    y = b
    for kk in range(LRU_CONV_W):
        y = y + xp[:, kk:kk + T] * w[kk]
    return y


def _linear_combine(e1, e2):
    a1, b1 = e1
    a2, b2 = e2
    return a1 * a2, a2 * b1 + b2


def _complex_combine(e1, e2):
    ar1, ai1, br1, bi1 = e1
    ar2, ai2, br2, bi2 = e2
    return (ar2 * ar1 - ai2 * ai1, ar2 * ai1 + ai2 * ar1,
            ar2 * br1 - ai2 * bi1 + br2, ar2 * bi1 + ai2 * br1 + bi2)


def _rglru_direction(xc, wa, ba, wx, bx, lam, reverse):
    B, T, W = xc.shape
    xb = xc.reshape(B, T, LRU_BLOCKS, LRU_BLOCK_W)
    r = jax.nn.sigmoid(jnp.einsum('btni,nij->btnj', xb, wa).reshape(B, T, W) + ba)
    i = jax.nn.sigmoid(jnp.einsum('btni,nij->btnj', xb, wx).reshape(B, T, W) + bx)
    log_a = -LRU_C * r * jax.nn.softplus(-lam.astype(jnp.float32))
    a = jnp.exp(log_a)
    b = jnp.sqrt(-jnp.expm1(2.0 * log_a)) * (i * xc)
    _, h = lax.associative_scan(_linear_combine, (a, b), axis=1, reverse=reverse)
    return h


def _s5_direction(u, lam_re, lam_im, log_dt, b_re, b_im, c_re, c_im, reverse):
    B, T, _ = u.shape
    lr = lam_re.astype(jnp.float32)
    li = lam_im.astype(jnp.float32)
    dt = jnp.exp(log_dt.astype(jnp.float32))[:, None]
    mag = jnp.exp(lr * dt)
    ar = mag * jnp.cos(li * dt)
    ai = mag * jnp.sin(li * dt)
    den = lr * lr + li * li
    cr = ((ar - 1.0) * lr + ai * li) / den
    ci = (ai * lr - (ar - 1.0) * li) / den
    bbr = cr[..., None] * b_re - ci[..., None] * b_im
    bbi = cr[..., None] * b_im + ci[..., None] * b_re
    ug = u.reshape(B, T, S5_GROUPS, S5_GROUP_CH)
    bur = jnp.einsum('btgc,gpc->btgp', ug, bbr)
    bui = jnp.einsum('btgc,gpc->btgp', ug, bbi)
    arb = jnp.broadcast_to(ar, bur.shape)
    aib = jnp.broadcast_to(ai, bur.shape)
    _, _, xr, xi = lax.associative_scan(_complex_combine, (arb, aib, bur, bui), axis=1, reverse=reverse)
    y = jnp.einsum('btgp,gcp->btgc', xr, c_re) - jnp.einsum('btgp,gcp->btgc', xi, c_im)
    return y.reshape(B, T, S5_WIDTH)


def _dilated_attention(q, k, v, rel_bias):
    B, T, H, Dh = q.shape
    n_blk = T // Q_BLOCK
    q = q * (HEAD_DIM ** -0.5)
    specs = []
    for g, (window, dil) in enumerate(ATT_GROUPS):
        n_side = (window // 2) // dil
        offs = dil * np.arange(-n_side, n_side + 1)
        hs = slice(g * HEADS_PER_GROUP, (g + 1) * HEADS_PER_GROUP)
        bias = rel_bias[_t5_buckets(offs)][:, hs].T.astype(jnp.float32)
        specs.append((offs, bias, q[:, :, hs], k[:, :, hs], v[:, :, hs]))

    def block(i):
        pos = i * Q_BLOCK + jnp.arange(Q_BLOCK)
        outs, lses = [], []
        for offs, bias, qg, kg, vg in specs:
            idx = pos[:, None] + offs[None, :]
            valid = (idx >= 0) & (idx < T)
            idx = jnp.clip(idx, 0, T - 1)
            qb = lax.dynamic_slice_in_dim(qg, i * Q_BLOCK, Q_BLOCK, axis=1)
            kb = jnp.take(kg, idx, axis=1)
            vb = jnp.take(vg, idx, axis=1)
            s = jnp.einsum('bqhd,bqjhd->bhqj', qb, kb).astype(jnp.float32) + bias[None, :, None, :]
            s = jnp.where(valid[None, None], s, NEG_INF)
            lse = jax.nn.logsumexp(s, axis=-1)
            p = jnp.exp(s - lse[..., None])
            outs.append(jnp.einsum('bhqj,bqjhd->bqhd', p, vb.astype(jnp.float32)))
            lses.append(lse)
        wts = jnp.transpose(jax.nn.softmax(jnp.stack(lses, axis=-1), axis=-1), (0, 2, 1, 3))
        o = jnp.sum(jnp.stack(outs, axis=-1) * wts[..., None, :], axis=-1)
        return o.reshape(B, Q_BLOCK, ATT_OUT).astype(q.dtype)

    y = lax.map(block, jnp.arange(n_blk))
    return jnp.transpose(y, (1, 0, 2, 3)).reshape(B, T, ATT_OUT)


def _mixer(h, w_in, conv_w, conv_b, lru_wa, lru_ba, lru_wx, lru_bx, lru_L,
           lam_re, lam_im, log_dt, b_re, b_im, c_re, c_im, s5_d, glu_w, glu_b,
           w_br_lru, w_br_s5, w_br_att, w_out, rel_bias):
    B, T, _ = h.shape
    z = h @ w_in
    cuts = np.cumsum([LRU_WIDTH, LRU_WIDTH, S5_WIDTH, ATT_WIDTH, ATT_WIDTH, ATT_WIDTH, D_MODEL, D_MODEL])
    xl, gl, u, q, k, v, ga, gb, gc = jnp.split(z, [int(c) for c in cuts], axis=-1)
    xc = _centred_dwconv(xl, conv_w, conv_b).astype(jnp.float32)
    y_lru = (_rglru_direction(xc, lru_wa[0], lru_ba[0], lru_wx[0], lru_bx[0], lru_L[0], False)
             + _rglru_direction(xc, lru_wa[1], lru_ba[1], lru_wx[1], lru_bx[1], lru_L[1], True))
    y_lru = y_lru.astype(h.dtype) * jax.nn.gelu(gl)
    u32 = u.astype(jnp.float32)
    y = (_s5_direction(u32, lam_re[0], lam_im[0], log_dt[0], b_re[0], b_im[0], c_re[0], c_im[0], False)
         + _s5_direction(u32, lam_re[1], lam_im[1], log_dt[1], b_re[1], b_im[1], c_re[1], c_im[1], True)
         + s5_d * u32)
    y1 = jax.nn.gelu(y)
    y_s5 = (y1 * jax.nn.sigmoid(y1 @ glu_w + glu_b)).astype(h.dtype)
    y_att = _dilated_attention(q.reshape(B, T, ATT_HEADS, HEAD_DIM), k.reshape(B, T, ATT_HEADS, HEAD_DIM),
                               v.reshape(B, T, ATT_HEADS, HEAD_DIM), rel_bias)
    m = (jax.nn.sigmoid(ga) * (y_lru @ w_br_lru)
         + jax.nn.sigmoid(gb) * (y_s5 @ w_br_s5)
         + jax.nn.sigmoid(gc) * (y_att @ w_br_att))
    return m @ w_out


def _trunk(x, params):
    (norm_g, w_in, lru_conv_w, lru_conv_b, lru_wa, lru_ba, lru_wx, lru_bx, lru_L,
     s5_lam_re, s5_lam_im, s5_log_dt, s5_b_re, s5_b_im, s5_c_re, s5_c_im, s5_d, s5_glu_w, s5_glu_b,
     rel_bias, w_br_lru, w_br_s5, w_br_att, w_out, ffn_w1, ffn_w3, ffn_w2) = params
    for l in range(DEPTH):
        g = norm_g[l]
        h = _rmsnorm(x, g[0])
        x = x + 0.5 * _rmsnorm(_swiglu(h, ffn_w1[l, 0], ffn_w3[l, 0], ffn_w2[l, 0]), g[1])
        h = _rmsnorm(x, g[2])
        mix = _mixer(h, w_in[l], lru_conv_w[l], lru_conv_b[l], lru_wa[l], lru_ba[l], lru_wx[l], lru_bx[l], lru_L[l],
                     s5_lam_re[l], s5_lam_im[l], s5_log_dt[l], s5_b_re[l], s5_b_im[l], s5_c_re[l], s5_c_im[l],
                     s5_d[l], s5_glu_w[l], s5_glu_b[l], w_br_lru[l], w_br_s5[l], w_br_att[l], w_out[l], rel_bias)
        x = x + _rmsnorm(mix, g[3])
        h = _rmsnorm(x, g[4])
        x = x + 0.5 * _rmsnorm(_swiglu(h, ffn_w1[l, 1], ffn_w3[l, 1], ffn_w2[l, 1]), g[5])
    return x


def setup_inputs(seed: int = 0) -> dict:
    key = jax.random.key(seed)
    ks = jax.random.split(key, 32)
    f32 = jnp.float32
    L, D = DEPTH, D_MODEL

    def nrm(k, shape, scale):
        return jax.random.normal(k, shape, f32) * scale

    x_prompt = nrm(ks[0], (BATCH, SEQ, D), 1.0)
    x_sample = nrm(ks[1], (DEC_BATCH, DEC_SEQ, D), 1.0)
    norm_g = 1.0 + nrm(ks[2], (L, N_NORMS, D), 0.02)
    w_in = nrm(ks[3], (L, D, N_IN), D ** -0.5)
    lru_conv_w = nrm(ks[4], (L, LRU_CONV_W, LRU_WIDTH), LRU_CONV_W ** -0.5)
    lru_conv_b = nrm(ks[5], (L, LRU_WIDTH), 0.01)
    lru_wa = nrm(ks[6], (L, 2, LRU_BLOCKS, LRU_BLOCK_W, LRU_BLOCK_W), LRU_BLOCK_W ** -0.5)
    lru_ba = nrm(ks[7], (L, 2, LRU_WIDTH), 0.01)
    lru_wx = nrm(ks[8], (L, 2, LRU_BLOCKS, LRU_BLOCK_W, LRU_BLOCK_W), LRU_BLOCK_W ** -0.5)
    lru_bx = nrm(ks[9], (L, 2, LRU_WIDTH), 0.01)
    a_init = jax.random.uniform(ks[10], (L, 2, LRU_WIDTH), f32, 0.9, 0.999) ** (1.0 / LRU_C)
    lru_L = jnp.log(a_init) - jnp.log1p(-a_init)
    n_idx = jnp.arange(S5_STATE, dtype=f32)
    s5_lam_re = -0.5 + nrm(ks[11], (L, 2, S5_GROUPS, S5_STATE), 0.02)
    s5_lam_im = jnp.pi * n_idx + nrm(ks[12], (L, 2, S5_GROUPS, S5_STATE), 0.02)
    s5_log_dt = jax.random.uniform(ks[13], (L, 2, S5_GROUPS), f32, math.log(1e-3), math.log(1e-1))
    s5_b_re = nrm(ks[14], (L, 2, S5_GROUPS, S5_STATE, S5_GROUP_CH), (2 * S5_GROUP_CH) ** -0.5)
    s5_b_im = nrm(ks[15], (L, 2, S5_GROUPS, S5_STATE, S5_GROUP_CH), (2 * S5_GROUP_CH) ** -0.5)
    s5_c_re = nrm(ks[16], (L, 2, S5_GROUPS, S5_GROUP_CH, S5_STATE), 0.5)
    s5_c_im = nrm(ks[17], (L, 2, S5_GROUPS, S5_GROUP_CH, S5_STATE), 0.5)
    s5_d = nrm(ks[18], (L, S5_WIDTH), 1.0)
    s5_glu_w = nrm(ks[19], (L, S5_WIDTH, S5_WIDTH), S5_WIDTH ** -0.5)
    s5_glu_b = nrm(ks[20], (L, S5_WIDTH), 0.01)
    rel_bias = nrm(ks[21], (REL_BUCKETS, ATT_HEADS), 0.5)
    w_br_lru = nrm(ks[22], (L, LRU_WIDTH, D), LRU_WIDTH ** -0.5)
    w_br_s5 = nrm(ks[23], (L, S5_WIDTH, D), S5_WIDTH ** -0.5)
    w_br_att = nrm(ks[24], (L, ATT_OUT, D), ATT_OUT ** -0.5)
    w_out = nrm(ks[25], (L, D, D), D ** -0.5)
    ffn_w1 = nrm(ks[26], (L, 2, D, D_FF), D ** -0.5)
    ffn_w3 = nrm(ks[27], (L, 2, D, D_FF), D ** -0.5)
    ffn_w2 = nrm(ks[28], (L, 2, D_FF, D), D_FF ** -0.5)
    return {'x_prompt': x_prompt, 'x_sample': x_sample, 'norm_g': norm_g, 'w_in': w_in,
            'lru_conv_w': lru_conv_w, 'lru_conv_b': lru_conv_b, 'lru_wa': lru_wa, 'lru_ba': lru_ba,
            'lru_wx': lru_wx, 'lru_bx': lru_bx, 'lru_L': lru_L,
            's5_lam_re': s5_lam_re, 's5_lam_im': s5_lam_im, 's5_log_dt': s5_log_dt,
            's5_b_re': s5_b_re, 's5_b_im': s5_b_im, 's5_c_re': s5_c_re, 's5_c_im': s5_c_im,
            's5_d': s5_d, 's5_glu_w': s5_glu_w, 's5_glu_b': s5_glu_b, 'rel_bias': rel_bias,
            'w_br_lru': w_br_lru, 'w_br_s5': w_br_s5, 'w_br_att': w_br_att, 'w_out': w_out,
            'ffn_w1': ffn_w1, 'ffn_w3': ffn_w3, 'ffn_w2': ffn_w2}


def reference(x_prompt, x_sample, norm_g, w_in, lru_conv_w, lru_conv_b, lru_wa, lru_ba, lru_wx, lru_bx, lru_L,
              s5_lam_re, s5_lam_im, s5_log_dt, s5_b_re, s5_b_im, s5_c_re, s5_c_im, s5_d, s5_glu_w, s5_glu_b,
              rel_bias, w_br_lru, w_br_s5, w_br_att, w_out, ffn_w1, ffn_w3, ffn_w2):
    params = (norm_g, w_in, lru_conv_w, lru_conv_b, lru_wa, lru_ba, lru_wx, lru_bx, lru_L,
              s5_lam_re, s5_lam_im, s5_log_dt, s5_b_re, s5_b_im, s5_c_re, s5_c_im, s5_d, s5_glu_w, s5_glu_b,
              rel_bias, w_br_lru, w_br_s5, w_br_att, w_out, ffn_w1, ffn_w3, ffn_w2)
    y_prompt = _trunk(x_prompt, params)
    y_sample = _trunk(x_sample, params)
    return (y_prompt, y_sample)
```

```cpp
#include <hip/hip_runtime.h>
#include <hip/hip_cooperative_groups.h>
#include <cstdio>
namespace cg = cooperative_groups;

#ifndef ONE_LAUNCH
#define ONE_LAUNCH 1
#endif

#define LAS __attribute__((address_space(3)))
typedef unsigned short bf16_t;
typedef short bf16x8 __attribute__((ext_vector_type(8)));
typedef float f32x4 __attribute__((ext_vector_type(4)));
typedef unsigned u32x4 __attribute__((ext_vector_type(4)));
typedef unsigned u32x2 __attribute__((ext_vector_type(2)));

constexpr int DM = 2048, MT = 24576, DFF = 5632, NSUB = MT / 16, NCHK = MT / 64;
constexpr float RMS_EPS = 1e-6f;
constexpr int LDS_BYTES = 131072;

constexpr size_t MiB = (size_t)1 << 20;
constexpr size_t SM_G = 0, SM_Y = 8 * MiB, SM_APOW = 24 * MiB, SM_BBAR = 26 * MiB, SM_KD = 27 * MiB, SM_LWT = 29 * MiB,
                 SM_SA = 30 * MiB, SM_SH = 33 * MiB, SM_CIN = 36 * MiB, SM_LSE = 39 * MiB;
constexpr size_t WS_W = 42 * MiB, WS_H = 116 * MiB, WS_BIG = 212 * MiB, WS_END = 908 * MiB;
constexpr size_t B_XL = WS_BIG, B_GL = WS_BIG + 48 * MiB, B_A2 = WS_BIG + 96 * MiB, B_Q = WS_BIG + 192 * MiB, B_K = WS_BIG + 264 * MiB,
                 B_V = WS_BIG + 336 * MiB, B_GA = WS_BIG + 408 * MiB, B_GB = WS_BIG + 504 * MiB, B_GC = WS_BIG + 600 * MiB;
constexpr size_t B_HID = WS_BIG, B_Y = B_GA, B_Y1 = B_K, B_YATT = B_K + 48 * MiB, B_M = B_A2, B_YS5 = WS_H, B_S = WS_H;
constexpr size_t W_13 = 0, W_2 = (size_t)11264 * 2048;
constexpr size_t W_IN = 0, W_GLU = 28311552, W_BRL = 29360128, W_BRS = 31457280, W_BRA = 33554432, W_OUT = 34603008;

struct Params { const float* in[29]; float* out; unsigned char* ws; int ph_lo, ph_hi; };

__device__ const unsigned char BUCKET[3][132] = {
 {11,11,11,11,11,11,11,11,11,11,11,11,11,11,11,10,10,10,10,10,10,10,10,10,10,10,10,10,10,10,10,10,10,10,10,10,10,10,9,9,9,9,9,9,9,9,9,9,9,9,8,8,8,8,8,8,8,7,6,5,4,3,2,1,0,17,18,19,20,21,22,23,24,24,24,24,24,24,24,25,25,25,25,25,25,25,25,25,25,25,25,26,26,26,26,26,26,26,26,26,26,26,26,26,26,26,26,26,26,26,26,26,26,26,27,27,27,27,27,27,27,27,27,27,27,27,27,27,27,0,0,0},
 {13,13,13,13,13,13,13,13,13,13,13,13,13,13,13,13,13,13,13,13,13,13,13,12,12,12,12,12,12,12,12,12,12,12,12,12,12,12,12,12,12,12,11,11,11,11,11,11,11,11,11,11,10,10,10,10,10,10,9,9,9,8,8,4,0,20,24,24,25,25,25,26,26,26,26,26,26,27,27,27,27,27,27,27,27,27,27,28,28,28,28,28,28,28,28,28,28,28,28,28,28,28,28,28,28,28,29,29,29,29,29,29,29,29,29,29,29,29,29,29,29,29,29,29,29,29,29,29,29,0,0,0},
 {15,15,15,15,15,15,15,15,15,15,15,15,15,15,15,15,15,15,15,15,15,15,15,15,15,15,15,15,15,15,14,14,14,14,14,14,14,14,14,14,14,14,14,14,14,13,13,13,13,13,13,13,13,13,12,12,12,12,12,11,11,10,10,9,0,25,26,26,27,27,28,28,28,28,28,29,29,29,29,29,29,29,29,29,30,30,30,30,30,30,30,30,30,30,30,30,30,30,30,31,31,31,31,31,31,31,31,31,31,31,31,31,31,31,31,31,31,31,31,31,31,31,31,31,31,31,31,31,31,0,0,0}};

__device__ __forceinline__ unsigned cvt_pk_bf16(float lo, float hi) { unsigned r; asm("v_cvt_pk_bf16_f32 %0, %1, %2" : "=v"(r) : "v"(lo), "v"(hi)); return r; }
__device__ __forceinline__ bf16_t f2bf(float f) { return (bf16_t)(cvt_pk_bf16(f, 0.f) & 0xffffu); }
__device__ __forceinline__ float bf2f(bf16_t b) { return __uint_as_float(((unsigned)b) << 16); }
__device__ __forceinline__ float bflo(unsigned w) { return __uint_as_float(w << 16); }
__device__ __forceinline__ float bfhi(unsigned w) { return __uint_as_float(w & 0xffff0000u); }
__device__ __forceinline__ float sigm(float x) { return __builtin_amdgcn_rcpf(1.0f + __expf(-x)); }
__device__ __forceinline__ float silu(float x) { return x * sigm(x); }
__device__ __forceinline__ float gelu_t(float x) { return x * sigm(1.5957691216057308f * (x + 0.044715f * x * x * x)); }
__device__ __forceinline__ float wave_sum(float v) {
#pragma unroll
    for (int o = 32; o >= 1; o >>= 1) v += __shfl_xor(v, o);
    return v;
}

__device__ __forceinline__ int ltid() { int t = threadIdx.x; asm volatile("" : "+v"(t)); return t; }
__device__ __forceinline__ int lbid() { int b = blockIdx.x; asm volatile("" : "+s"(b)); return b; }

constexpr int BM = 256, BK = 64, HALF = 128, HTB = HALF * BK * 2, NXCD = 8, WGM = 8;
__device__ __forceinline__ int lds_byte(int r, int c) { const int st = (r >> 4) * 2 + (c >> 5), rr = r & 15, cc = c & 31, ob = rr * 64 + cc * 2; return st * 1024 + (ob ^ (((ob >> 9) & 1) << 5)); }
__device__ __forceinline__ void stage_rc(int b, int& R, int& C) { const int st = b / 1024, sb = b % 1024, swz = sb ^ (((sb >> 9) & 1) << 5); R = (st >> 1) * 16 + swz / 64; C = (st & 1) * 32 + (swz % 64) / 2; }
__device__ __forceinline__ int perm32(int rho) { const int n = rho >> 4, i = rho & 15; return 8 * (i >> 2) + 4 * n + (i & 3); }

struct Unit { int pm, pn, b; };
struct Gemm { const bf16_t* A; const bf16_t* Bt; int lda, ldb, K, nM, nN, nb; size_t sA, sB; };
struct Order {
    int nM, nN, nwg, tot, G, c, nb;
    __device__ void init(const Gemm& g, int G_, int c_) { nM = g.nM; nN = g.nN; nwg = nM * nN; nb = g.nb; tot = nwg * nb; G = G_; c = c_; }
    __device__ bool next(int i, Unit& u) const {
        const long L = (long)i * G + c; if (L >= tot) return false;
        if (nb > 1) { const int b = (int)(L / nwg), rem = (int)(L % nwg); u.b = b; u.pm = rem % nM; u.pn = rem / nM; return true; }
        int wgid = (int)L; { const int q = nwg / NXCD, r = nwg % NXCD, xcd = wgid % NXCD, off = wgid / NXCD; wgid = (xcd < r ? xcd * (q + 1) : r * (q + 1) + (xcd - r) * q) + off; }
        const int nig = WGM * nN, gid = wgid / nig, fm = gid * WGM, gsz = (nM - fm) < WGM ? (nM - fm) : WGM;
        u.pm = fm + ((wgid % nig) % gsz); u.pn = (wgid % nig) / gsz; u.b = 0; return true;
    }
};

template <class Epi>
__device__ __forceinline__ void gemm_phase(LAS unsigned char* lds, const Gemm g, const Epi& E) {
    Order S; S.init(g, (int)gridDim.x, lbid());
    const int tid = ltid(), wid = __builtin_amdgcn_readfirstlane(tid >> 6), lane = tid & 63, wr = wid >> 2, wc = wid & 3, fr = lane & 15, fq = lane >> 4;
    const int K = g.K, nt = K / BK;
    unsigned voffA[2], voffB[2];
#pragma unroll
    for (int i = 0; i < 2; ++i) { int R, C; stage_rc(tid * 16 + i * 8192, R, C); const int Rb = Epi::PERM ? ((R & ~31) + perm32(R & 31)) : R;
        voffA[i] = (unsigned)(R * g.lda + C) * 2u; voffB[i] = (unsigned)(Rb * g.ldb + C) * 2u; }
    const size_t kstep = (size_t)(BK * 2);
    const size_t hstepA = (size_t)HALF * g.lda * 2, hstepB = (size_t)HALF * g.ldb * 2;
    const size_t tstepA = 2 * hstepA, tstepB = 2 * hstepB;
    const unsigned ldsw = (unsigned)wid * 1024u;
    const int aoff = lds_byte(wr * 64 + fr, fq * 8), boff = lds_byte(wc * 32 + fr, fq * 8);
#define PG8_SA(b, h) (((b) * 2 + (h)) * HTB)
#define PG8_SB(b, h) ((4 + (b) * 2 + (h)) * HTB)
#define PG8_STAGE(bufoff, gbase, voff) do { _Pragma("unroll") for (int _i = 0; _i < 2; ++_i) \
        __builtin_amdgcn_global_load_lds((const unsigned*)((const char*)(gbase) + (voff)[_i]), (LAS unsigned*)(lds + (bufoff) + ldsw + _i * 8192), 16, 0, 0); } while (0)
#define PG8_LDA(dst, b, h) do { _Pragma("unroll") for (int m = 0; m < 4; ++m) _Pragma("unroll") for (int k = 0; k < 2; ++k) dst[m][k] = *(const LAS bf16x8*)(lds + PG8_SA(b, h) + aoff + m * 2048 + k * 1024); } while (0)
#define PG8_LDB(dst, b, h) do { _Pragma("unroll") for (int n = 0; n < 2; ++n) _Pragma("unroll") for (int k = 0; k < 2; ++k) dst[n][k] = *(const LAS bf16x8*)(lds + PG8_SB(b, h) + boff + n * 2048 + k * 1024); } while (0)
#define PG8_MMA(ai, bj, At, Bt) do { __builtin_amdgcn_s_setprio(1); _Pragma("unroll") for (int m = 0; m < 4; ++m) _Pragma("unroll") for (int n = 0; n < 2; ++n) _Pragma("unroll") for (int k = 0; k < 2; ++k) \
        acc[ai][bj][m][n] = __builtin_amdgcn_mfma_f32_16x16x32_bf16(Bt[n][k], At[m][k], acc[ai][bj][m][n], 0, 0, 0); __builtin_amdgcn_s_setprio(0); } while (0)
#define PG8_WAIT_V(n) asm volatile("s_waitcnt vmcnt(" #n ")" ::: "memory")
#define PG8_WAIT_L(n) asm volatile("s_waitcnt lgkmcnt(" #n ")" ::: "memory")
#define PG8_BAR __builtin_amdgcn_s_barrier()
#define PG8_SCHED __builtin_amdgcn_sched_barrier(0)
    Unit cur, nxt; int ui = 0;
    if (!S.next(0, cur)) return;
    f32x4 acc[2][2][4][2];
#pragma unroll
    for (int a = 0; a < 2; ++a)
#pragma unroll
        for (int b = 0; b < 2; ++b)
#pragma unroll
            for (int m = 0; m < 4; ++m)
#pragma unroll
                for (int n = 0; n < 2; ++n) acc[a][b][m][n] = (f32x4){0.f, 0.f, 0.f, 0.f};
    bf16x8 At[4][2], B0[2][2], B1[2][2];
    const char* cA = (const char*)(g.A + (size_t)cur.b * g.sA) + (size_t)cur.pm * tstepA; const char* cB = (const char*)(g.Bt + (size_t)cur.b * g.sB) + (size_t)cur.pn * tstepB;
    PG8_STAGE(PG8_SB(0, 0), cB, voffB); PG8_STAGE(PG8_SA(0, 0), cA, voffA); PG8_STAGE(PG8_SB(0, 1), cB + hstepB, voffB); PG8_STAGE(PG8_SA(0, 1), cA + hstepA, voffA);
    if (wr == 1) PG8_BAR;
    PG8_WAIT_V(4); PG8_BAR;
    PG8_STAGE(PG8_SB(1, 0), cB + kstep, voffB); PG8_STAGE(PG8_SA(1, 0), cA + kstep, voffA); PG8_STAGE(PG8_SB(1, 1), cB + hstepB + kstep, voffB);
    PG8_WAIT_V(6); PG8_BAR;
    for (;;) {
        const bool has_next = S.next(ui + 1, nxt);
        const char* nA = has_next ? (const char*)(g.A + (size_t)nxt.b * g.sA) + (size_t)nxt.pm * tstepA : cA; const char* nB = has_next ? (const char*)(g.Bt + (size_t)nxt.b * g.sB) + (size_t)nxt.pn * tstepB : cB;
        for (int t = 0; t < nt; t += 2) {
            const bool last = (t == nt - 2);
            const char* a1 = cA + (size_t)(t + 1) * kstep;
            const char* a2 = last ? nA : cA + (size_t)(t + 2) * kstep; const char* b2 = last ? nB : cB + (size_t)(t + 2) * kstep;
            const char* a3 = a2 + kstep; const char* b3 = b2 + kstep;
            PG8_LDB(B0, 0, 0); PG8_SCHED; PG8_LDA(At, 0, 0); PG8_STAGE(PG8_SA(1, 1), a1 + hstepA, voffA);
            PG8_WAIT_L(8); PG8_BAR; PG8_WAIT_L(0); PG8_MMA(0, 0, At, B0); PG8_BAR; PG8_SCHED;
            PG8_LDB(B1, 0, 1); PG8_STAGE(PG8_SB(0, 0), b2, voffB);
            PG8_BAR; PG8_WAIT_L(0); PG8_MMA(0, 1, At, B1); PG8_BAR;
            PG8_LDA(At, 0, 1); PG8_STAGE(PG8_SA(0, 0), a2, voffA);
            PG8_BAR; PG8_WAIT_L(0); PG8_MMA(1, 0, At, B0); PG8_BAR; PG8_SCHED;
            PG8_STAGE(PG8_SB(0, 1), b2 + hstepB, voffB);
            PG8_WAIT_V(6); PG8_BAR; PG8_MMA(1, 1, At, B1); PG8_BAR;
            PG8_LDB(B0, 1, 0); PG8_SCHED; PG8_LDA(At, 1, 0); PG8_STAGE(PG8_SA(0, 1), a2 + hstepA, voffA);
            PG8_WAIT_L(8); PG8_BAR; PG8_WAIT_L(0); PG8_MMA(0, 0, At, B0); PG8_BAR; PG8_SCHED;
            PG8_LDB(B1, 1, 1); PG8_STAGE(PG8_SB(1, 0), b3, voffB);
            PG8_BAR; PG8_WAIT_L(0); PG8_MMA(0, 1, At, B1); PG8_BAR;
            PG8_LDA(At, 1, 1); PG8_STAGE(PG8_SA(1, 0), a3, voffA);
            PG8_BAR; PG8_WAIT_L(0); PG8_MMA(1, 0, At, B0); PG8_BAR; PG8_SCHED;
            PG8_STAGE(PG8_SB(1, 1), b3 + hstepB, voffB);
            PG8_WAIT_V(6); PG8_BAR; PG8_MMA(1, 1, At, B1); PG8_BAR;
        }
        E(acc, cur, wr, wc, fr, fq);
        if (!has_next) break;
#pragma unroll
        for (int a = 0; a < 2; ++a)
#pragma unroll
            for (int b = 0; b < 2; ++b)
#pragma unroll
                for (int m = 0; m < 4; ++m)
#pragma unroll
                    for (int n = 0; n < 2; ++n) acc[a][b][m][n] = (f32x4){0.f, 0.f, 0.f, 0.f};
        cur = nxt; cA = nA; cB = nB; ++ui;
    }
    PG8_WAIT_V(0);
    if (wr == 0) PG8_BAR;
    PG8_BAR;
#undef PG8_SA
#undef PG8_SB
#undef PG8_STAGE
#undef PG8_LDA
#undef PG8_LDB
#undef PG8_MMA
#undef PG8_WAIT_V
#undef PG8_WAIT_L
#undef PG8_BAR
#undef PG8_SCHED
}

typedef const f32x4 (&AccRef)[2][2][4][2];
__device__ __forceinline__ u32x4 pack8(f32x4 v0, f32x4 v1) { u32x4 w; w.x = cvt_pk_bf16(v0[0], v0[1]); w.y = cvt_pk_bf16(v0[2], v0[3]); w.z = cvt_pk_bf16(v1[0], v1[1]); w.w = cvt_pk_bf16(v1[2], v1[3]); return w; }
__device__ __forceinline__ void unpack8(u32x4 w, f32x4& v0, f32x4& v1) { v0 = (f32x4){bflo(w.x), bfhi(w.x), bflo(w.y), bfhi(w.y)}; v1 = (f32x4){bflo(w.z), bfhi(w.z), bflo(w.w), bfhi(w.w)}; }

struct EpiSwiglu {
    static constexpr bool PERM = true; bf16_t* O;
    __device__ __forceinline__ void operator()(AccRef acc, const Unit& u, int wr, int wc, int fr, int fq) const {
        const int row0 = u.pm * BM + wr * 64 + fr, col = u.pn * 128 + wc * 32 + 8 * fq;
#pragma unroll
        for (int ai = 0; ai < 2; ++ai)
#pragma unroll
            for (int m = 0; m < 4; ++m) {
                f32x4 v0, v1;
#pragma unroll
                for (int j = 0; j < 4; ++j) { v0[j] = silu(acc[ai][0][m][0][j]) * acc[ai][1][m][0][j]; v1[j] = silu(acc[ai][0][m][1][j]) * acc[ai][1][m][1][j]; }
                *(u32x4*)(O + (size_t)(row0 + ai * HALF + m * 16) * DFF + col) = pack8(v0, v1);
            }
    }
};
struct EpiBf16 {
    static constexpr bool PERM = true; bf16_t* O; int ldc;
    __device__ __forceinline__ void operator()(AccRef acc, const Unit& u, int wr, int wc, int fr, int fq) const {
        const int row0 = u.pm * BM + wr * 64 + fr, col0 = u.pn * BM + wc * 32 + 8 * fq;
#pragma unroll
        for (int ai = 0; ai < 2; ++ai)
#pragma unroll
            for (int m = 0; m < 4; ++m)
#pragma unroll
                for (int bj = 0; bj < 2; ++bj)
                    *(u32x4*)(O + (size_t)(row0 + ai * HALF + m * 16) * ldc + col0 + bj * HALF) = pack8(acc[ai][bj][m][0], acc[ai][bj][m][1]);
    }
};
struct EpiWin {
    static constexpr bool PERM = true; unsigned char* ws;
    __device__ __forceinline__ void operator()(AccRef acc, const Unit& u, int wr, int wc, int fr, int fq) const {
        const int pn = u.pn; int act, ld, cb; size_t base;
        if (pn < 4) { act = 0; ld = 1024; cb = pn * 256; base = B_XL; }
        else if (pn < 8) { act = 1; ld = 1024; cb = (pn - 4) * 256; base = B_GL; }
        else if (pn < 12) { act = 2; ld = 0; cb = (pn - 8) * 256; base = B_A2; }
        else if (pn < 18) { act = 3; ld = 1536; cb = (pn - 12) * 256; base = B_Q; }
        else if (pn < 24) { act = 0; ld = 1536; cb = (pn - 18) * 256; base = B_K; }
        else if (pn < 30) { act = 0; ld = 1536; cb = (pn - 24) * 256; base = B_V; }
        else if (pn < 38) { act = 4; ld = 2048; cb = (pn - 30) * 256; base = B_GA; }
        else if (pn < 46) { act = 4; ld = 2048; cb = (pn - 38) * 256; base = B_GB; }
        else { act = 4; ld = 2048; cb = (pn - 46) * 256; base = B_GC; }
        bf16_t* O = (bf16_t*)(ws + base);
        const int row0 = u.pm * BM + wr * 64 + fr, col0 = cb + wc * 32 + 8 * fq;
#pragma unroll
        for (int ai = 0; ai < 2; ++ai)
#pragma unroll
            for (int m = 0; m < 4; ++m)
#pragma unroll
                for (int bj = 0; bj < 2; ++bj) {
                    const int row = row0 + ai * HALF + m * 16, col = col0 + bj * HALF;
                    f32x4 v0 = acc[ai][bj][m][0], v1 = acc[ai][bj][m][1];
                    if (act == 1) {
#pragma unroll
                        for (int j = 0; j < 4; ++j) { v0[j] = gelu_t(v0[j]); v1[j] = gelu_t(v1[j]); } }
                    else if (act == 3) { v0 *= 0.125f; v1 *= 0.125f; }
                    else if (act == 4) {
#pragma unroll
                        for (int j = 0; j < 4; ++j) { v0[j] = sigm(v0[j]); v1[j] = sigm(v1[j]); } }
                    size_t off;
                    if (act == 2) off = ((size_t)(col >> 4) * NSUB + (row >> 4)) * 512 + (row & 15) * 16 + (col & 15);
                    else off = (size_t)row * ld + col;
                    *(u32x4*)(O + off) = pack8(v0, v1);
                }
    }
};
struct EpiS {
    static constexpr bool PERM = false; float* S;
    __device__ __forceinline__ void operator()(AccRef acc, const Unit& u, int wr, int wc, int fr, int fq) const {
        const int row0 = u.pm * BM + wr * 64 + fr, col0 = wc * 32 + 4 * fq;
        float* base = S + (size_t)u.b * NSUB * 256;
#pragma unroll
        for (int ai = 0; ai < 2; ++ai)
#pragma unroll
            for (int m = 0; m < 4; ++m)
#pragma unroll
                for (int bj = 0; bj < 2; ++bj)
#pragma unroll
                    for (int n = 0; n < 2; ++n)
                        *(f32x4*)(base + (size_t)(row0 + ai * HALF + m * 16) * 256 + col0 + bj * HALF + n * 16) = acc[ai][bj][m][n];
    }
};
struct EpiY {
    static constexpr bool PERM = true; bf16_t* Y1;
    __device__ __forceinline__ void operator()(AccRef acc, const Unit& u, int wr, int wc, int fr, int fq) const {
        const int row0 = u.pm * BM + wr * 64 + fr, n0 = wc * 32 + 8 * fq;
#pragma unroll
        for (int ai = 0; ai < 2; ++ai)
#pragma unroll
            for (int m = 0; m < 4; ++m)
#pragma unroll
                for (int bj = 0; bj < 2; ++bj) {
                    const int j = row0 + ai * HALF + m * 16, nn = n0 + bj * HALF, tok = j * 16 + (nn >> 4);
                    f32x4 v0 = acc[ai][bj][m][0], v1 = acc[ai][bj][m][1];
#pragma unroll
                    for (int q = 0; q < 4; ++q) { v0[q] = gelu_t(v0[q]); v1[q] = gelu_t(v1[q]); }
                    *(u32x4*)(Y1 + (size_t)tok * 1024 + u.b * 16 + (nn & 15)) = pack8(v0, v1);
                }
    }
};
struct EpiGlu {
    static constexpr bool PERM = true; const bf16_t* Y1; bf16_t* O; const float* bias;
    __device__ __forceinline__ void operator()(AccRef acc, const Unit& u, int wr, int wc, int fr, int fq) const {
        const int row0 = u.pm * BM + wr * 64 + fr, col0 = u.pn * BM + wc * 32 + 8 * fq;
#pragma unroll
        for (int bj = 0; bj < 2; ++bj) {
            const int col = col0 + bj * HALF;
            const f32x4 b0 = *(const f32x4*)(bias + col), b1 = *(const f32x4*)(bias + col + 4);
#pragma unroll
            for (int ai = 0; ai < 2; ++ai)
#pragma unroll
                for (int m = 0; m < 4; ++m) {
                    const size_t off = (size_t)(row0 + ai * HALF + m * 16) * 1024 + col;
                    f32x4 y0, y1v; unpack8(*(const u32x4*)(Y1 + off), y0, y1v);
                    f32x4 v0 = acc[ai][bj][m][0] + b0, v1 = acc[ai][bj][m][1] + b1;
#pragma unroll
                    for (int q = 0; q < 4; ++q) { v0[q] = y0[q] * sigm(v0[q]); v1[q] = y1v[q] * sigm(v1[q]); }
                    *(u32x4*)(O + off) = pack8(v0, v1);
                }
        }
    }
};
template <bool FIRST> struct EpiMerge {
    static constexpr bool PERM = true; const bf16_t* Gt; bf16_t* Mo;
    __device__ __forceinline__ void operator()(AccRef acc, const Unit& u, int wr, int wc, int fr, int fq) const {
        const int row0 = u.pm * BM + wr * 64 + fr, col0 = u.pn * BM + wc * 32 + 8 * fq;
#pragma unroll
        for (int ai = 0; ai < 2; ++ai)
#pragma unroll
            for (int m = 0; m < 4; ++m)
#pragma unroll
                for (int bj = 0; bj < 2; ++bj) {
                    const size_t off = (size_t)(row0 + ai * HALF + m * 16) * 2048 + col0 + bj * HALF;
                    f32x4 g0, g1; unpack8(*(const u32x4*)(Gt + off), g0, g1);
                    f32x4 v0 = g0 * acc[ai][bj][m][0], v1 = g1 * acc[ai][bj][m][1];
                    if (!FIRST) { f32x4 p0, p1; unpack8(*(const u32x4*)(Mo + off), p0, p1); v0 += p0; v1 += p1; }
                    *(u32x4*)(Mo + off) = pack8(v0, v1);
                }
    }
};

__device__ void cvt_job(unsigned char* shm, const float* src, bf16_t* dst, int K, int N, int mode) {
    bf16_t* T = (bf16_t*)shm;
    const int tid = ltid(), bid = lbid(), nkt = K / 64, nnt = N / 64, tot = nkt * nnt;
    for (int t = bid; t < tot; t += gridDim.x) {
        const int nti = t % nnt, kt = t / nnt;
        { const int k = tid >> 3, n8 = (tid & 7) * 8;
          const float* s = src + (size_t)(kt * 64 + k) * N + nti * 64 + n8;
          const f32x4 v0 = *(const f32x4*)s, v1 = *(const f32x4*)(s + 4);
#pragma unroll
          for (int j = 0; j < 4; ++j) { T[(n8 + j) * 72 + k] = f2bf(v0[j]); T[(n8 + 4 + j) * 72 + k] = f2bf(v1[j]); } }
        __syncthreads();
        { const int n = tid >> 3, k8 = (tid & 7) * 8; const int nn = nti * 64 + n;
          const int drow = mode == 0 ? nn : ((nn >> 7) * 256 + (nn & 127) + (mode == 2 ? 128 : 0));
          *(u32x4*)(dst + (size_t)drow * K + kt * 64 + k8) = *(const u32x4*)(T + n * 72 + k8); }
        __syncthreads();
    }
}
__device__ void cvt_ffn(const Params& p, unsigned char* shm, int l, int sub) {
    bf16_t* W = (bf16_t*)(p.ws + WS_W); const size_t wo = (size_t)(l * 2 + sub) * DM * DFF;
    cvt_job(shm, p.in[26] + wo, W + W_13, DM, DFF, 1);
    cvt_job(shm, p.in[27] + wo, W + W_13, DM, DFF, 2);
    cvt_job(shm, p.in[28] + wo, W + W_2, DFF, DM, 0);
}
__device__ void cvt_mixer(const Params& p, unsigned char* shm, int l) {
    bf16_t* W = (bf16_t*)(p.ws + WS_W);
    cvt_job(shm, p.in[3] + (size_t)l * DM * 13824, W + W_IN, DM, 13824, 0);
    cvt_job(shm, p.in[19] + (size_t)l * 1024 * 1024, W + W_GLU, 1024, 1024, 0);
    cvt_job(shm, p.in[22] + (size_t)l * 1024 * DM, W + W_BRL, 1024, DM, 0);
    cvt_job(shm, p.in[23] + (size_t)l * 1024 * DM, W + W_BRS, 1024, DM, 0);
    cvt_job(shm, p.in[24] + (size_t)l * 512 * DM, W + W_BRA, 512, DM, 0);
    cvt_job(shm, p.in[25] + (size_t)l * DM * DM, W + W_OUT, DM, DM, 0);
}

__device__ void norm_rows(const Params& p, bool first, const bf16_t* y, float scale, const float* gpost, const float* gpre, bf16_t* h) {
    const int tid = ltid(), bid = lbid(), lane = tid & 63, wid = tid >> 6;
    for (int row = bid * 8 + wid; row < MT; row += gridDim.x * 8) {
        const float* xr = first ? (row < 8192 ? p.in[0] + (size_t)row * DM : p.in[1] + (size_t)(row - 8192) * DM) : p.out + (size_t)row * DM;
        f32x4 xv[8];
#pragma unroll
        for (int c = 0; c < 8; ++c) xv[c] = *(const f32x4*)(xr + (c * 64 + lane) * 4);
        if (y) {
            f32x4 yv[8]; float ss = 0.f;
#pragma unroll
            for (int c = 0; c < 8; ++c) { const u32x2 w = *(const u32x2*)(y + (size_t)row * DM + (c * 64 + lane) * 4);
                yv[c] = (f32x4){bflo(w.x), bfhi(w.x), bflo(w.y), bfhi(w.y)}; ss += yv[c][0] * yv[c][0] + yv[c][1] * yv[c][1] + yv[c][2] * yv[c][2] + yv[c][3] * yv[c][3]; }
            ss = wave_sum(ss);
            const float rs = rsqrtf(ss * (1.0f / DM) + RMS_EPS) * scale;
#pragma unroll
            for (int c = 0; c < 8; ++c) { const f32x4 gp = *(const f32x4*)(gpost + (c * 64 + lane) * 4); xv[c] += yv[c] * gp * rs; }
        }
        if (y || first) {
#pragma unroll
            for (int c = 0; c < 8; ++c) *(f32x4*)(p.out + (size_t)row * DM + (c * 64 + lane) * 4) = xv[c];
        }
        if (gpre) {
            float ss = 0.f;
#pragma unroll
            for (int c = 0; c < 8; ++c) ss += xv[c][0] * xv[c][0] + xv[c][1] * xv[c][1] + xv[c][2] * xv[c][2] + xv[c][3] * xv[c][3];
            ss = wave_sum(ss);
            const float rs = rsqrtf(ss * (1.0f / DM) + RMS_EPS);
#pragma unroll
            for (int c = 0; c < 8; ++c) { const f32x4 gp = *(const f32x4*)(gpre + (c * 64 + lane) * 4); const f32x4 v = xv[c] * gp * rs;
                u32x2 w; w.x = cvt_pk_bf16(v[0], v[1]); w.y = cvt_pk_bf16(v[2], v[3]); *(u32x2*)(h + (size_t)row * DM + (c * 64 + lane) * 4) = w; }
        }
    }
}

__device__ void s5_stage1(const Params& p, int l) {
    float2* Apow = (float2*)(p.ws + SM_APOW); float2* Bbar = (float2*)(p.ws + SM_BBAR);
    for (int idx = lbid() * 512 + ltid(); idx < 8192; idx += gridDim.x * 512) {
        const float lr = p.in[11][l * 8192 + idx], li = p.in[12][l * 8192 + idx], dt = expf(p.in[13][l * 128 + (idx >> 6)]);
        float ar = 1.f, ai = 0.f;
        for (int k = 0; k < 18; ++k) { const float mag = expf((float)k * lr * dt); float s, c; sincosf((float)k * li * dt, &s, &c); Apow[idx * 18 + k] = make_float2(mag * c, mag * s); if (k == 1) { ar = mag * c; ai = mag * s; } }
        const float den = lr * lr + li * li, cr = ((ar - 1.0f) * lr + ai * li) / den, ci = (ai * lr - (ar - 1.0f) * li) / den;
        for (int c = 0; c < 16; ++c) { const float br = p.in[14][(size_t)l * 131072 + idx * 16 + c], bi = p.in[15][(size_t)l * 131072 + idx * 16 + c];
            Bbar[idx * 16 + c] = make_float2(cr * br - ci * bi, cr * bi + ci * br); }
    }
}
__device__ void s5_stage2(const Params& p, int l) {
    const float2* Apow = (const float2*)(p.ws + SM_APOW); const float2* Bbar = (const float2*)(p.ws + SM_BBAR);
    float* Kd = (float*)(p.ws + SM_KD); bf16_t* Gm = (bf16_t*)(p.ws + SM_G); bf16_t* Ym = (bf16_t*)(p.ws + SM_Y); bf16_t* LWT = (bf16_t*)(p.ws + SM_LWT);
    const float* cre = p.in[16] + (size_t)l * 131072; const float* cim = p.in[17] + (size_t)l * 131072;
    const int gs = gridDim.x * 512, t0 = lbid() * 512 + ltid();
    for (int o = t0; o < 524288; o += gs) {
        const int c2 = o & 15, c = (o >> 4) & 15, k = (o >> 8) & 15, dg = o >> 12;
        float acc = 0.f;
        for (int pp = 0; pp < 64; ++pp) { const int sidx = dg * 64 + pp; const float2 A = Apow[sidx * 18 + k], Bb = Bbar[sidx * 16 + c2];
            const float Cr = cre[(dg * 16 + c) * 64 + pp], Ci = cim[(dg * 16 + c) * 64 + pp];
            const float abr = A.x * Bb.x - A.y * Bb.y, abi = A.x * Bb.y + A.y * Bb.x; acc += Cr * abr - Ci * abi; }
        Kd[o] = acc;
    }
    for (int o = t0; o < 64 * 65536; o += gs) {
        const int kk = o & 255, n = (o >> 8) & 255, g = o >> 16;
        { const int d = n >> 7, ri = (n >> 6) & 1, pp = n & 63, s = kk >> 4, c2 = kk & 15, e = d == 0 ? 15 - s : s; const int sidx = (d * 64 + g) * 64 + pp;
          const float2 A = Apow[sidx * 18 + e], Bb = Bbar[sidx * 16 + c2];
          Gm[o] = f2bf(ri ? A.x * Bb.y + A.y * Bb.x : A.x * Bb.x - A.y * Bb.y); }
        { const int tau = n >> 4, c = n & 15, d = kk >> 7, ri = (kk >> 6) & 1, pp = kk & 63, e = d == 0 ? tau + 1 : 16 - tau; const int sidx = (d * 64 + g) * 64 + pp;
          const float2 A = Apow[sidx * 18 + e]; const float Cr = cre[((d * 64 + g) * 16 + c) * 64 + pp], Ci = cim[((d * 64 + g) * 16 + c) * 64 + pp];
          Ym[((size_t)g * 256 + n) * 512 + 256 + kk] = f2bf(ri ? -(Cr * A.y + Ci * A.x) : Cr * A.x - Ci * A.y); }
    }
    for (int o = t0; o < 262144; o += gs) {
        const int i = o & 63, j = (o >> 6) & 63, n = (o >> 12) & 15, gate = (o >> 16) & 1, d = o >> 17;
        const float* src = gate ? p.in[8] : p.in[6];
        LWT[o] = f2bf(src[(size_t)((l * 2 + d) * 16 + n) * 4096 + i * 64 + j]);
    }
}
__device__ void s5_stage3(const Params& p, int l) {
    const float* Kd = (const float*)(p.ws + SM_KD); bf16_t* Ym = (bf16_t*)(p.ws + SM_Y); const float* Dk = p.in[18] + l * 1024;
    for (int o = lbid() * 512 + ltid(); o < 64 * 65536; o += gridDim.x * 512) {
        const int kk = o & 255, n = (o >> 8) & 255, g = o >> 16, s = kk >> 4, c2 = kk & 15, tau = n >> 4, c = n & 15;
        float v = 0.f;
        if (s <= tau) v += Kd[((0 * 64 + g) * 16 + (tau - s)) * 256 + c * 16 + c2];
        if (s >= tau) v += Kd[((1 * 64 + g) * 16 + (s - tau)) * 256 + c * 16 + c2];
        if (s == tau && c == c2) v += Dk[g * 16 + c];
        Ym[((size_t)g * 256 + n) * 512 + kk] = f2bf(v);
    }
}
__device__ void s5_bscan(const Params& p) {
    const float2* Apow = (const float2*)(p.ws + SM_APOW); const float* S = (const float*)(p.ws + B_S); bf16_t* A2 = (bf16_t*)(p.ws + B_A2);
    const int tid_ = ltid();
    for (int it = lbid(); it < 80; it += gridDim.x) {
        const int c = it * 512 + tid_, pp = c & 63, d = (c >> 6) & 1, g = (c >> 7) & 63, seq = c >> 13;
        const int j0 = seq < 4 ? seq * 128 : 512, nj = seq < 4 ? 128 : 1024;
        const float2 A16 = Apow[((d * 64 + g) * 64 + pp) * 18 + 16];
        const float* Sg = S + (size_t)g * NSUB * 256 + d * 128 + pp; bf16_t* Xg = A2 + (size_t)g * NSUB * 512 + 256 + d * 128 + pp;
        float xr = 0.f, xi = 0.f;
        for (int jb = 0; jb < nj; jb += 16) {
            float sr[16], si[16];
#pragma unroll
            for (int u = 0; u < 16; ++u) { const int j = d ? (j0 + nj - 1 - (jb + u)) : (j0 + jb + u); sr[u] = Sg[(size_t)j * 256]; si[u] = Sg[(size_t)j * 256 + 64]; }
#pragma unroll
            for (int u = 0; u < 16; ++u) { const int j = d ? (j0 + nj - 1 - (jb + u)) : (j0 + jb + u);
                Xg[(size_t)j * 512] = f2bf(xr); Xg[(size_t)j * 512 + 64] = f2bf(xi);
                const float nr = A16.x * xr - A16.y * xi + sr[u], ni = A16.x * xi + A16.y * xr + si[u]; xr = nr; xi = ni; }
        }
    }
}

template <int PASS>
__device__ void lru_items(const Params& p, unsigned char* shm, int l) {
    float* xcf = (float*)shm;
    bf16_t* xcb = (bf16_t*)(shm + 16640);
    bf16_t* wt = (bf16_t*)(shm + 25856);
    float* As = (float*)(shm + 62720);
    float* Bs = (float*)(shm + 95488);
    const bf16_t* XL = (const bf16_t*)(p.ws + B_XL); bf16_t* GL = (bf16_t*)(p.ws + B_GL); const bf16_t* LWT = (const bf16_t*)(p.ws + SM_LWT);
    float* SA = (float*)(p.ws + SM_SA); float* SH = (float*)(p.ws + SM_SH); const float* CIN = (const float*)(p.ws + SM_CIN);
    const float* cw = p.in[4] + l * 4096; const float* cbias = p.in[5] + l * 1024;
    const int tid = ltid(), lane = tid & 63, w = tid >> 6, fr = lane & 15, fq = lane >> 4;
    for (int it = lbid(); it < NCHK * 16; it += gridDim.x) {
        const int ck = it >> 4, n = it & 15, t0 = ck * 64;
        const int s_start = t0 < 8192 ? (t0 & ~2047) : 8192, s_end = t0 < 8192 ? s_start + 2048 : MT;
#pragma unroll
        for (int i = 0; i < 8; ++i) { const int e = tid + 512 * i, t = e >> 6, j = e & 63, ch = n * 64 + j;
            float v = cbias[ch];
#pragma unroll
            for (int kk = 0; kk < 4; ++kk) { const int tok = t0 + t + kk - 2; if (tok >= s_start && tok < s_end) v += bf2f(XL[(size_t)tok * 1024 + ch]) * cw[kk * 1024 + ch]; }
            xcf[t * 65 + j] = v; xcb[t * 72 + j] = f2bf(v); }
#pragma unroll
        for (int i = 0; i < 4; ++i) { const int e = tid + 512 * i, mtx = e >> 9, rem = e & 511, j = rem >> 3, c8 = rem & 7;
            *(u32x4*)(wt + (mtx * 64 + j) * 72 + c8 * 8) = *(const u32x4*)(LWT + ((size_t)(mtx * 16 + n) * 64 + j) * 64 + c8 * 8); }
        __syncthreads();
        { const int d = w >> 2, tt = w & 3;
          const bf16x8 a0 = *(const bf16x8*)(xcb + (tt * 16 + fr) * 72 + fq * 8), a1 = *(const bf16x8*)(xcb + (tt * 16 + fr) * 72 + 32 + fq * 8);
#pragma unroll
          for (int jt = 0; jt < 4; ++jt) {
              f32x4 accr = (f32x4){0.f, 0.f, 0.f, 0.f}, acci = (f32x4){0.f, 0.f, 0.f, 0.f};
              const bf16_t* wr_ = wt + ((d * 2 + 0) * 64 + jt * 16 + fr) * 72 + fq * 8; const bf16_t* wi_ = wt + ((d * 2 + 1) * 64 + jt * 16 + fr) * 72 + fq * 8;
              accr = __builtin_amdgcn_mfma_f32_16x16x32_bf16(a0, *(const bf16x8*)wr_, accr, 0, 0, 0);
              accr = __builtin_amdgcn_mfma_f32_16x16x32_bf16(a1, *(const bf16x8*)(wr_ + 32), accr, 0, 0, 0);
              acci = __builtin_amdgcn_mfma_f32_16x16x32_bf16(a0, *(const bf16x8*)wi_, acci, 0, 0, 0);
              acci = __builtin_amdgcn_mfma_f32_16x16x32_bf16(a1, *(const bf16x8*)(wi_ + 32), acci, 0, 0, 0);
              const int j = jt * 16 + fr, ch = n * 64 + j; const int pi = (l * 2 + d) * 1024 + ch;
              const float ba = p.in[7][pi], bx = p.in[9][pi], sp = log1pf(expf(-p.in[10][pi]));
#pragma unroll
              for (int i = 0; i < 4; ++i) { const int t = tt * 16 + fq * 4 + i;
                  const float r = sigm(accr[i] + ba), ig = sigm(acci[i] + bx), la = -8.0f * r * sp;
                  As[(d * 64 + t) * 64 + j] = expf(la);
                  Bs[(d * 64 + t) * 64 + j] = sqrtf(fmaxf(-expm1f(2.0f * la), 0.f)) * ig * xcf[t * 65 + j]; }
          } }
        __syncthreads();
        if (tid < 128) { const int d = tid >> 6, j = tid & 63, ch = n * 64 + j; const size_t so = (size_t)(ck * 2 + d) * 1024 + ch;
            if (PASS == 0) { float h = 0.f, P = 1.f;
#pragma unroll 4
                for (int s = 0; s < 64; ++s) { const int t = d ? 63 - s : s; const float a = As[(d * 64 + t) * 64 + j]; h = a * h + Bs[(d * 64 + t) * 64 + j]; P *= a; }
                SA[so] = P; SH[so] = h; }
            else { float h = CIN[so];
#pragma unroll 4
                for (int s = 0; s < 64; ++s) { const int t = d ? 63 - s : s; const float a = As[(d * 64 + t) * 64 + j]; h = a * h + Bs[(d * 64 + t) * 64 + j]; Bs[(d * 64 + t) * 64 + j] = h; } } }
        if (PASS == 1) { __syncthreads();
#pragma unroll
            for (int i = 0; i < 8; ++i) { const int e = tid + 512 * i, t = e >> 6, j = e & 63; const size_t go = (size_t)(t0 + t) * 1024 + n * 64 + j;
                GL[go] = f2bf((Bs[t * 64 + j] + Bs[(64 + t) * 64 + j]) * bf2f(GL[go])); } }
        __syncthreads();
    }
}
__device__ void lru_carry(const Params& p) {
    const float* SA = (const float*)(p.ws + SM_SA); const float* SH = (const float*)(p.ws + SM_SH); float* CIN = (float*)(p.ws + SM_CIN);
    const int tid_ = ltid();
    for (int it = lbid(); it < 20; it += gridDim.x) {
        const int c = it * 512 + tid_, ch = c & 1023, d = (c >> 10) & 1, seq = c >> 11;
        const int k0 = seq < 4 ? seq * 32 : 128, nk = seq < 4 ? 32 : 256;
        float carry = 0.f;
        for (int kb = 0; kb < nk; kb += 8) {
            float a[8], h[8];
#pragma unroll
            for (int u = 0; u < 8; ++u) { const int k = d ? (k0 + nk - 1 - (kb + u)) : (k0 + kb + u); a[u] = SA[(size_t)(k * 2 + d) * 1024 + ch]; h[u] = SH[(size_t)(k * 2 + d) * 1024 + ch]; }
#pragma unroll
            for (int u = 0; u < 8; ++u) { const int k = d ? (k0 + nk - 1 - (kb + u)) : (k0 + kb + u); CIN[(size_t)(k * 2 + d) * 1024 + ch] = carry; carry = a[u] * carry + h[u]; }
        }
    }
}

__device__ void attn_items(const Params& p, unsigned char* shm) {
    bf16_t* Ks = (bf16_t*)shm;
    bf16_t* Vt = (bf16_t*)(shm + 36864);
    bf16_t* Ps = (bf16_t*)(shm + 72704);
    float* bs = (float*)(shm + 115712);
    bf16_t* Qb = (bf16_t*)(p.ws + B_Q); const bf16_t* Kb = (const bf16_t*)(p.ws + B_K); const bf16_t* Vb = (const bf16_t*)(p.ws + B_V);
    float* LSE = (float*)(p.ws + SM_LSE);
    const int tid = ltid(), lane = tid & 63, w = tid >> 6, fr = lane & 15, fq = lane >> 4;
    for (int it = lbid(); it < 24 * 192; it += gridDim.x) {
        const int hd = it / 192, qt = it % 192;
        int seq_start, T, lt; if (qt < 64) { seq_start = (qt >> 4) * 2048; T = 2048; lt = qt & 15; } else { seq_start = 8192; T = 16384; lt = qt - 64; }
        const int g = hd >> 3, dil = g == 0 ? 1 : (g == 1 ? 4 : 16), n_lat = T / dil, tpr = n_lat >> 7, r = lt / tpr, q0 = (lt % tpr) << 7;
        for (int e = tid; e < 2176; e += 512) { const int kk = e >> 3, c8 = e & 7, lat = q0 - 64 + kk; const bool ok = kk < 256 && lat >= 0 && lat < n_lat;
            u32x4 kv = (u32x4){0u, 0u, 0u, 0u}, vv = (u32x4){0u, 0u, 0u, 0u};
            if (ok) { const size_t go = (size_t)(seq_start + r + dil * lat) * 1536 + hd * 64 + c8 * 8; kv = *(const u32x4*)(Kb + go); vv = *(const u32x4*)(Vb + go); }
            if (kk < 256) *(u32x4*)(Ks + kk * 72 + c8 * 8) = kv;
#pragma unroll
            for (int j = 0; j < 8; ++j) Vt[(c8 * 8 + j) * 280 + kk] = (bf16_t)((vv[j >> 1] >> ((j & 1) * 16)) & 0xffffu); }
        if (tid < 129) bs[tid] = p.in[21][(int)BUCKET[g][tid] * 24 + hd];
        __syncthreads();
        const size_t qo = (size_t)(seq_start + r + dil * (q0 + 16 * w + fr)) * 1536 + hd * 64;
        const bf16x8 aq0 = *(const bf16x8*)(Qb + qo + fq * 8), aq1 = *(const bf16x8*)(Qb + qo + 32 + fq * 8);
        f32x4 s[9];
#pragma unroll
        for (int kt = 0; kt < 9; ++kt) { const bf16_t* kr = Ks + (16 * w + 16 * kt + fr) * 72 + fq * 8;
            f32x4 a = (f32x4){0.f, 0.f, 0.f, 0.f};
            a = __builtin_amdgcn_mfma_f32_16x16x32_bf16(aq0, *(const bf16x8*)kr, a, 0, 0, 0);
            a = __builtin_amdgcn_mfma_f32_16x16x32_bf16(aq1, *(const bf16x8*)(kr + 32), a, 0, 0, 0); s[kt] = a; }
        float mx[4], ls[4];
#pragma unroll
        for (int i = 0; i < 4; ++i) { const int qi = fq * 4 + i; float m = -3.0e38f;
#pragma unroll
            for (int kt = 0; kt < 9; ++kt) { const int rel = 16 * kt + fr - 64 - qi, klat = q0 - 64 + 16 * w + 16 * kt + fr;
                const bool ok = rel >= -64 && rel <= 64 && klat >= 0 && klat < n_lat; const int bi = min(max(rel + 64, 0), 128);
                const float v = ok ? s[kt][i] + bs[bi] : -1.0e30f; s[kt][i] = v; m = fmaxf(m, v); }
            m = fmaxf(m, __shfl_xor(m, 1)); m = fmaxf(m, __shfl_xor(m, 2)); m = fmaxf(m, __shfl_xor(m, 4)); m = fmaxf(m, __shfl_xor(m, 8));
            float sum = 0.f;
#pragma unroll
            for (int kt = 0; kt < 9; ++kt) { const float pv = __expf(s[kt][i] - m); s[kt][i] = pv; sum += pv; }
            sum += __shfl_xor(sum, 1); sum += __shfl_xor(sum, 2); sum += __shfl_xor(sum, 4); sum += __shfl_xor(sum, 8);
            mx[i] = m; ls[i] = sum; }
        bf16_t* Pw = Ps + w * 16 * 168;
#pragma unroll
        for (int i = 0; i < 4; ++i) {
#pragma unroll
            for (int kt = 0; kt < 9; ++kt) Pw[(fq * 4 + i) * 168 + 16 * kt + fr] = f2bf(s[kt][i]);
            Pw[(fq * 4 + i) * 168 + 144 + fr] = 0; }
        __syncthreads();
        f32x4 o[4];
#pragma unroll
        for (int nt = 0; nt < 4; ++nt) o[nt] = (f32x4){0.f, 0.f, 0.f, 0.f};
#pragma unroll
        for (int ks = 0; ks < 5; ++ks) { const bf16x8 ap = *(const bf16x8*)(Pw + fr * 168 + ks * 32 + fq * 8);
#pragma unroll
            for (int nt = 0; nt < 4; ++nt) o[nt] = __builtin_amdgcn_mfma_f32_16x16x32_bf16(ap, *(const bf16x8*)(Vt + (nt * 16 + fr) * 280 + 16 * w + ks * 32 + fq * 8), o[nt], 0, 0, 0); }
#pragma unroll
        for (int i = 0; i < 4; ++i) { const float inv = 1.0f / ls[i]; const int tok = seq_start + r + dil * (q0 + 16 * w + fq * 4 + i);
#pragma unroll
            for (int nt = 0; nt < 4; ++nt) Qb[(size_t)tok * 1536 + hd * 64 + nt * 16 + fr] = f2bf(o[nt][i] * inv);
            if (fr == 0) LSE[(size_t)tok * 24 + hd] = mx[i] + __logf(ls[i]); }
        __syncthreads();
    }
}
__device__ void attn_combine(const Params& p) {
    const bf16_t* Ab = (const bf16_t*)(p.ws + B_Q); const float* LSE = (const float*)(p.ws + SM_LSE); bf16_t* YA = (bf16_t*)(p.ws + B_YATT);
    for (int e = lbid() * 512 + ltid(); e < MT * 64; e += gridDim.x * 512) {
        const int tok = e >> 6, h = (e >> 3) & 7, c8 = e & 7;
        const float l0 = LSE[(size_t)tok * 24 + h], l1 = LSE[(size_t)tok * 24 + 8 + h], l2 = LSE[(size_t)tok * 24 + 16 + h];
        const float m = fmaxf(l0, fmaxf(l1, l2)); float w0 = __expf(l0 - m), w1 = __expf(l1 - m), w2 = __expf(l2 - m); const float inv = 1.0f / (w0 + w1 + w2); w0 *= inv; w1 *= inv; w2 *= inv;
        f32x4 a0, a1, b0, b1, c0, c1;
        unpack8(*(const u32x4*)(Ab + (size_t)tok * 1536 + h * 64 + c8 * 8), a0, a1);
        unpack8(*(const u32x4*)(Ab + (size_t)tok * 1536 + (8 + h) * 64 + c8 * 8), b0, b1);
        unpack8(*(const u32x4*)(Ab + (size_t)tok * 1536 + (16 + h) * 64 + c8 * 8), c0, c1);
        *(u32x4*)(YA + (size_t)tok * 512 + h * 64 + c8 * 8) = pack8(a0 * w0 + b0 * w1 + c0 * w2, a1 * w0 + b1 * w1 + c1 * w2);
    }
}

__device__ __forceinline__ Gemm mk_gemm(const bf16_t* A, int lda, const bf16_t* Bt, int ldb, int K, int nM, int nN, int nb = 1, size_t sA = 0, size_t sB = 0) {
    Gemm g; g.A = A; g.Bt = Bt; g.lda = lda; g.ldb = ldb; g.K = K; g.nM = nM; g.nN = nN; g.nb = nb; g.sA = sA; g.sB = sB; return g; }

__global__ __launch_bounds__(512, 2) void mega(Params p) {
    extern __shared__ __attribute__((aligned(16))) unsigned char shm[];
    LAS unsigned char* lds = (LAS unsigned char*)shm;
    cg::grid_group grid = cg::this_grid();
#pragma nounroll
    for (int ph = p.ph_lo; ph < p.ph_hi; ++ph) {
        unsigned char* ws = p.ws; asm volatile("" : "+s"(ws));
        const int l = ph == 0 ? 0 : (ph - 1) / 14, kind = ph == 0 ? 0 : (ph - 1) % 14 + 1;
        bf16_t* W = (bf16_t*)(ws + WS_W); bf16_t* H = (bf16_t*)(ws + WS_H);
        bf16_t* HID = (bf16_t*)(ws + B_HID); bf16_t* Y = (bf16_t*)(ws + B_Y); bf16_t* A2 = (bf16_t*)(ws + B_A2);
        bf16_t* Y1 = (bf16_t*)(ws + B_Y1); bf16_t* YS5 = (bf16_t*)(ws + B_YS5); bf16_t* Mb = (bf16_t*)(ws + B_M);
        const float* ng = p.in[2]; const float* gl_ = ng + l * 6 * DM;
        switch (kind) {
        case 0:
            cvt_ffn(p, shm, 0, 0); s5_stage1(p, 0);
            norm_rows(p, true, nullptr, 0.f, nullptr, ng, H);
            break;
        case 1: case 12: {
            if (kind == 1) s5_stage2(p, l);
            __syncthreads();
            EpiSwiglu e; e.O = HID; gemm_phase(lds, mk_gemm(H, DM, W + W_13, DM, DM, MT / 256, 44), e);
        } break;
        case 2: case 13: {
            if (kind == 2) s5_stage3(p, l);
            __syncthreads();
            EpiBf16 e; e.O = Y; e.ldc = DM; gemm_phase(lds, mk_gemm(HID, DFF, W + W_2, DFF, DFF, MT / 256, 8), e);
        } break;
        case 3:
            cvt_mixer(p, shm, l);
            norm_rows(p, false, Y, 0.5f, gl_ + 1 * DM, gl_ + 2 * DM, H);
            break;
        case 4: {
            EpiWin e; e.ws = ws; gemm_phase(lds, mk_gemm(H, DM, W + W_IN, DM, DM, MT / 256, 54), e);
        } break;
        case 5: {
            { EpiS e; e.S = (float*)(ws + B_S); gemm_phase(lds, mk_gemm(A2, 512, (const bf16_t*)(ws + SM_G), 256, 256, NSUB / 256, 1, 64, (size_t)NSUB * 512, 65536), e); }
            __syncthreads();
            lru_items<0>(p, shm, l);
            attn_items(p, shm);
        } break;
        case 6:
            lru_carry(p); s5_bscan(p); attn_combine(p);
            break;
        case 7: {
            { EpiY e; e.Y1 = Y1; gemm_phase(lds, mk_gemm(A2, 512, (const bf16_t*)(ws + SM_Y), 512, 512, NSUB / 256, 1, 64, (size_t)NSUB * 512, 131072), e); }
            __syncthreads();
            lru_items<1>(p, shm, l);
        } break;
        case 8: {
            EpiGlu e; e.Y1 = Y1; e.O = YS5; e.bias = p.in[20] + l * 1024; gemm_phase(lds, mk_gemm(Y1, 1024, W + W_GLU, 1024, 1024, MT / 256, 4), e);
        } break;
        case 9: {
            { EpiMerge<true> e; e.Gt = (const bf16_t*)(ws + B_GA); e.Mo = Mb; gemm_phase(lds, mk_gemm((const bf16_t*)(ws + B_GL), 1024, W + W_BRL, 1024, 1024, MT / 256, 8), e); }
            { EpiMerge<false> e; e.Gt = (const bf16_t*)(ws + B_GB); e.Mo = Mb; gemm_phase(lds, mk_gemm(YS5, 1024, W + W_BRS, 1024, 1024, MT / 256, 8), e); }
            { EpiMerge<false> e; e.Gt = (const bf16_t*)(ws + B_GC); e.Mo = Mb; gemm_phase(lds, mk_gemm((const bf16_t*)(ws + B_YATT), 512, W + W_BRA, 512, 512, MT / 256, 8), e); }
        } break;
        case 10: {
            EpiBf16 e; e.O = Y; e.ldc = DM; gemm_phase(lds, mk_gemm(Mb, DM, W + W_OUT, DM, DM, MT / 256, 8), e);
        } break;
        case 11:
            cvt_ffn(p, shm, l, 1);
            norm_rows(p, false, Y, 1.0f, gl_ + 3 * DM, gl_ + 4 * DM, H);
            break;
        default:
            if (l == 0) { cvt_ffn(p, shm, 1, 0); s5_stage1(p, 1); }
            norm_rows(p, false, Y, 0.5f, gl_ + 5 * DM, l == 0 ? ng + 6 * DM : nullptr, H);
            break;
        }
        if (ph + 1 < p.ph_hi) grid.sync();
    }
}
constexpr int N_PHASES = 1 + 2 * 14;

extern "C" void kernel_launch(void* const* d_in, const int* in_sizes, int n_in, void* d_out, int out_size, void* d_ws, size_t ws_size, hipStream_t stream) {
    static int grid = 0;
    if (grid == 0) {
        if (n_in != 29 || ws_size < WS_END) { fprintf(stderr, "kernel_launch: need 29 inputs and %zu bytes of workspace (got %d, %zu)\n", (size_t)WS_END, n_in, ws_size); grid = -1; return; }
        if (hipFuncSetAttribute((const void*)mega, hipFuncAttributeMaxDynamicSharedMemorySize, LDS_BYTES) != hipSuccess) { fprintf(stderr, "hipFuncSetAttribute failed\n"); grid = -1; return; }
        int dev = 0, cus = 0, per_cu = 0;
        (void)hipGetDevice(&dev); (void)hipDeviceGetAttribute(&cus, hipDeviceAttributeMultiprocessorCount, dev);
        (void)hipOccupancyMaxActiveBlocksPerMultiprocessor(&per_cu, (const void*)mega, 512, LDS_BYTES);
        if (per_cu < 1) per_cu = 1;
        (void)hipGetLastError();
        grid = cus * 1;
    }
    if (grid < 0) return;
    Params p{};
    for (int i = 0; i < 29; ++i) p.in[i] = (const float*)d_in[i];
    p.out = (float*)d_out; p.ws = (unsigned char*)d_ws;
#if ONE_LAUNCH
    p.ph_lo = 0; p.ph_hi = N_PHASES;
    void* args[] = {&p};
    hipError_t e = hipLaunchCooperativeKernel((void*)mega, dim3(grid), dim3(512), args, LDS_BYTES, stream);
    if (e != hipSuccess) fprintf(stderr, "cooperative launch failed: %s (grid %d)\n", hipGetErrorString(e), grid);
#else
    for (int ph = 0; ph < N_PHASES; ++ph) { p.ph_lo = ph; p.ph_hi = ph + 1; hipLaunchKernelGGL(mega, dim3(grid), dim3(512), LDS_BYTES, stream, p); }
#endif
}
```

```cpp
#include <hip/hip_runtime.h>
#include <hip/hip_cooperative_groups.h>
#include <cstdio>
namespace cg = cooperative_groups;

#ifndef ONE_LAUNCH
#define ONE_LAUNCH 1
#endif

#define LAS __attribute__((address_space(3)))
typedef unsigned short bf16_t;
typedef short bf16x8 __attribute__((ext_vector_type(8)));
typedef float f32x4 __attribute__((ext_vector_type(4)));
typedef unsigned u32x4 __attribute__((ext_vector_type(4)));
typedef unsigned u32x2 __attribute__((ext_vector_type(2)));

constexpr int DM = 2048, MT = 24576, DFF = 5632, NSUB = MT / 16, NCHK = MT / 64;
constexpr float RMS_EPS = 1e-6f;
constexpr int LDS_BYTES = 147456;

constexpr size_t MiB = (size_t)1 << 20;
constexpr size_t SM_G = 0, SM_Y = 8 * MiB, SM_APOW = 24 * MiB, SM_BBAR = 26 * MiB, SM_KD = 27 * MiB, SM_LWT = 29 * MiB,
                 SM_SA = 30 * MiB, SM_SH = 33 * MiB, SM_CIN = 36 * MiB, SM_LSE = 39 * MiB;
constexpr size_t WS_W = 42 * MiB, WS_H = 116 * MiB, WS_BIG = 212 * MiB, WS_END = 908 * MiB;
constexpr size_t B_XL = WS_BIG, B_GL = WS_BIG + 48 * MiB, B_A2 = WS_BIG + 96 * MiB, B_Q = WS_BIG + 192 * MiB, B_K = WS_BIG + 264 * MiB,
                 B_V = WS_BIG + 336 * MiB, B_GA = WS_BIG + 408 * MiB, B_GB = WS_BIG + 504 * MiB, B_GC = WS_BIG + 600 * MiB;
constexpr size_t B_HID = WS_BIG, B_Y = B_GA, B_Y1 = B_K, B_YATT = B_K + 48 * MiB, B_M = B_A2, B_YS5 = WS_H, B_S = WS_H;
constexpr size_t W_13 = 0, W_2 = (size_t)11264 * 2048;
constexpr size_t W_IN = 0, W_GLU = 28311552, W_BRL = 29360128, W_BRS = 31457280, W_BRA = 33554432, W_OUT = 34603008;

struct Params { const float* in[29]; float* out; unsigned char* ws; int ph_lo, ph_hi; };

__device__ const unsigned char BUCKET[3][132] = {
 {11,11,11,11,11,11,11,11,11,11,11,11,11,11,11,10,10,10,10,10,10,10,10,10,10,10,10,10,10,10,10,10,10,10,10,10,10,10,9,9,9,9,9,9,9,9,9,9,9,9,8,8,8,8,8,8,8,7,6,5,4,3,2,1,0,17,18,19,20,21,22,23,24,24,24,24,24,24,24,25,25,25,25,25,25,25,25,25,25,25,25,26,26,26,26,26,26,26,26,26,26,26,26,26,26,26,26,26,26,26,26,26,26,26,27,27,27,27,27,27,27,27,27,27,27,27,27,27,27,0,0,0},
 {13,13,13,13,13,13,13,13,13,13,13,13,13,13,13,13,13,13,13,13,13,13,13,12,12,12,12,12,12,12,12,12,12,12,12,12,12,12,12,12,12,12,11,11,11,11,11,11,11,11,11,11,10,10,10,10,10,10,9,9,9,8,8,4,0,20,24,24,25,25,25,26,26,26,26,26,26,27,27,27,27,27,27,27,27,27,27,28,28,28,28,28,28,28,28,28,28,28,28,28,28,28,28,28,28,28,29,29,29,29,29,29,29,29,29,29,29,29,29,29,29,29,29,29,29,29,29,29,29,0,0,0},
 {15,15,15,15,15,15,15,15,15,15,15,15,15,15,15,15,15,15,15,15,15,15,15,15,15,15,15,15,15,15,14,14,14,14,14,14,14,14,14,14,14,14,14,14,14,13,13,13,13,13,13,13,13,13,12,12,12,12,12,11,11,10,10,9,0,25,26,26,27,27,28,28,28,28,28,29,29,29,29,29,29,29,29,29,30,30,30,30,30,30,30,30,30,30,30,30,30,30,30,31,31,31,31,31,31,31,31,31,31,31,31,31,31,31,31,31,31,31,31,31,31,31,31,31,31,31,31,31,31,0,0,0}};

__device__ __forceinline__ unsigned cvt_pk_bf16(float lo, float hi) { unsigned r; asm("v_cvt_pk_bf16_f32 %0, %1, %2" : "=v"(r) : "v"(lo), "v"(hi)); return r; }
__device__ __forceinline__ bf16_t f2bf(float f) { return (bf16_t)(cvt_pk_bf16(f, 0.f) & 0xffffu); }
__device__ __forceinline__ float bf2f(bf16_t b) { return __uint_as_float(((unsigned)b) << 16); }
__device__ __forceinline__ float bflo(unsigned w) { return __uint_as_float(w << 16); }
__device__ __forceinline__ float bfhi(unsigned w) { return __uint_as_float(w & 0xffff0000u); }
__device__ __forceinline__ float sigm(float x) { return __builtin_amdgcn_rcpf(1.0f + __expf(-x)); }
__device__ __forceinline__ float silu(float x) { return x * sigm(x); }
__device__ __forceinline__ float gelu_t(float x) { return x * sigm(1.5957691216057308f * (x + 0.044715f * x * x * x)); }
__device__ __forceinline__ float wave_sum(float v) {
#pragma unroll
    for (int o = 32; o >= 1; o >>= 1) v += __shfl_xor(v, o);
    return v;
}

__device__ __forceinline__ int ltid() { int t = threadIdx.x; asm volatile("" : "+v"(t)); return t; }
__device__ __forceinline__ int lbid() { int b = blockIdx.x; asm volatile("" : "+s"(b)); return b; }

constexpr int BM = 256, BK = 64, HALF = 128, HTB = HALF * BK * 2, NXCD = 8, WGM = 8;
__device__ __forceinline__ int lds_byte(int r, int c) { const int st = (r >> 4) * 2 + (c >> 5), rr = r & 15, cc = c & 31, ob = rr * 64 + cc * 2; return st * 1024 + (ob ^ (((ob >> 9) & 1) << 5)); }
__device__ __forceinline__ void stage_rc(int b, int& R, int& C) { const int st = b / 1024, sb = b % 1024, swz = sb ^ (((sb >> 9) & 1) << 5); R = (st >> 1) * 16 + swz / 64; C = (st & 1) * 32 + (swz % 64) / 2; }
__device__ __forceinline__ int perm32(int rho) { const int n = rho >> 4, i = rho & 15; return 8 * (i >> 2) + 4 * n + (i & 3); }

struct Unit { int pm, pn, b; };
struct Gemm { const bf16_t* A; const bf16_t* Bt; int lda, ldb, K, nM, nN, nb; size_t sA, sB; };
struct Order {
    int nM, nN, nwg, tot, G, c, nb;
    __device__ void init(const Gemm& g, int G_, int c_) { nM = g.nM; nN = g.nN; nwg = nM * nN; nb = g.nb; tot = nwg * nb; G = G_; c = c_; }
    __device__ bool next(int i, Unit& u) const {
        const long L = (long)i * G + c; if (L >= tot) return false;
        if (nb > 1) { const int b = (int)(L / nwg), rem = (int)(L % nwg); u.b = b; u.pm = rem % nM; u.pn = rem / nM; return true; }
        int wgid = (int)L; { const int q = nwg / NXCD, r = nwg % NXCD, xcd = wgid % NXCD, off = wgid / NXCD; wgid = (xcd < r ? xcd * (q + 1) : r * (q + 1) + (xcd - r) * q) + off; }
        const int nig = WGM * nN, gid = wgid / nig, fm = gid * WGM, gsz = (nM - fm) < WGM ? (nM - fm) : WGM;
        u.pm = fm + ((wgid % nig) % gsz); u.pn = (wgid % nig) / gsz; u.b = 0; return true;
    }
};

template <class Epi>
__device__ __forceinline__ void gemm_phase(LAS unsigned char* lds, const Gemm g, const Epi& E) {
    Order S; S.init(g, (int)gridDim.x, lbid());
    const int tid = ltid(), wid = __builtin_amdgcn_readfirstlane(tid >> 6), lane = tid & 63, wr = wid >> 2, wc = wid & 3, fr = lane & 15, fq = lane >> 4;
    const int K = g.K, nt = K / BK;
    unsigned voffA[2], voffB[2];
#pragma unroll
    for (int i = 0; i < 2; ++i) { int R, C; stage_rc(tid * 16 + i * 8192, R, C); const int Rb = Epi::PERM ? ((R & ~31) + perm32(R & 31)) : R;
        voffA[i] = (unsigned)(R * g.lda + C) * 2u; voffB[i] = (unsigned)(Rb * g.ldb + C) * 2u; }
    const size_t kstep = (size_t)(BK * 2);
    const size_t hstepA = (size_t)HALF * g.lda * 2, hstepB = (size_t)HALF * g.ldb * 2;
    const size_t tstepA = 2 * hstepA, tstepB = 2 * hstepB;
    const unsigned ldsw = (unsigned)wid * 1024u;
    const int aoff = lds_byte(wr * 64 + fr, fq * 8), boff = lds_byte(wc * 32 + fr, fq * 8);
#define PG8_SA(b, h) (((b) * 2 + (h)) * HTB)
#define PG8_SB(b, h) ((4 + (b) * 2 + (h)) * HTB)
#define PG8_STAGE(bufoff, gbase, voff) do { _Pragma("unroll") for (int _i = 0; _i < 2; ++_i) \
        __builtin_amdgcn_global_load_lds((const unsigned*)((const char*)(gbase) + (voff)[_i]), (LAS unsigned*)(lds + (bufoff) + ldsw + _i * 8192), 16, 0, 0); } while (0)
#define PG8_LDA(dst, b, h) do { _Pragma("unroll") for (int m = 0; m < 4; ++m) _Pragma("unroll") for (int k = 0; k < 2; ++k) dst[m][k] = *(const LAS bf16x8*)(lds + PG8_SA(b, h) + aoff + m * 2048 + k * 1024); } while (0)
#define PG8_LDB(dst, b, h) do { _Pragma("unroll") for (int n = 0; n < 2; ++n) _Pragma("unroll") for (int k = 0; k < 2; ++k) dst[n][k] = *(const LAS bf16x8*)(lds + PG8_SB(b, h) + boff + n * 2048 + k * 1024); } while (0)
#define PG8_MMA(ai, bj, At, Bt) do { __builtin_amdgcn_s_setprio(1); _Pragma("unroll") for (int m = 0; m < 4; ++m) _Pragma("unroll") for (int n = 0; n < 2; ++n) _Pragma("unroll") for (int k = 0; k < 2; ++k) \
        acc[ai][bj][m][n] = __builtin_amdgcn_mfma_f32_16x16x32_bf16(Bt[n][k], At[m][k], acc[ai][bj][m][n], 0, 0, 0); __builtin_amdgcn_s_setprio(0); } while (0)
#define PG8_WAIT_V(n) asm volatile("s_waitcnt vmcnt(" #n ")" ::: "memory")
#define PG8_WAIT_L(n) asm volatile("s_waitcnt lgkmcnt(" #n ")" ::: "memory")
#define PG8_BAR __builtin_amdgcn_s_barrier()
#define PG8_SCHED __builtin_amdgcn_sched_barrier(0)
    Unit cur, nxt; int ui = 0;
    if (!S.next(0, cur)) return;
    f32x4 acc[2][2][4][2];
#pragma unroll
    for (int a = 0; a < 2; ++a)
#pragma unroll
        for (int b = 0; b < 2; ++b)
#pragma unroll
            for (int m = 0; m < 4; ++m)
#pragma unroll
                for (int n = 0; n < 2; ++n) acc[a][b][m][n] = (f32x4){0.f, 0.f, 0.f, 0.f};
    bf16x8 At[4][2], B0[2][2], B1[2][2];
    const char* cA = (const char*)(g.A + (size_t)cur.b * g.sA) + (size_t)cur.pm * tstepA; const char* cB = (const char*)(g.Bt + (size_t)cur.b * g.sB) + (size_t)cur.pn * tstepB;
    PG8_STAGE(PG8_SB(0, 0), cB, voffB); PG8_STAGE(PG8_SA(0, 0), cA, voffA); PG8_STAGE(PG8_SB(0, 1), cB + hstepB, voffB); PG8_STAGE(PG8_SA(0, 1), cA + hstepA, voffA);
    if (wr == 1) PG8_BAR;
    PG8_WAIT_V(4); PG8_BAR;
    PG8_STAGE(PG8_SB(1, 0), cB + kstep, voffB); PG8_STAGE(PG8_SA(1, 0), cA + kstep, voffA); PG8_STAGE(PG8_SB(1, 1), cB + hstepB + kstep, voffB);
    PG8_WAIT_V(6); PG8_BAR;
    for (;;) {
        const bool has_next = S.next(ui + 1, nxt);
        const char* nA = has_next ? (const char*)(g.A + (size_t)nxt.b * g.sA) + (size_t)nxt.pm * tstepA : cA; const char* nB = has_next ? (const char*)(g.Bt + (size_t)nxt.b * g.sB) + (size_t)nxt.pn * tstepB : cB;
        for (int t = 0; t < nt; t += 2) {
            const bool last = (t == nt - 2);
            const char* a1 = cA + (size_t)(t + 1) * kstep;
            const char* a2 = last ? nA : cA + (size_t)(t + 2) * kstep; const char* b2 = last ? nB : cB + (size_t)(t + 2) * kstep;
            const char* a3 = a2 + kstep; const char* b3 = b2 + kstep;
            PG8_LDB(B0, 0, 0); PG8_SCHED; PG8_LDA(At, 0, 0); PG8_STAGE(PG8_SA(1, 1), a1 + hstepA, voffA);
            PG8_WAIT_L(8); PG8_BAR; PG8_WAIT_L(0); PG8_MMA(0, 0, At, B0); PG8_BAR; PG8_SCHED;
            PG8_LDB(B1, 0, 1); PG8_STAGE(PG8_SB(0, 0), b2, voffB);
            PG8_BAR; PG8_WAIT_L(0); PG8_MMA(0, 1, At, B1); PG8_BAR;
            PG8_LDA(At, 0, 1); PG8_STAGE(PG8_SA(0, 0), a2, voffA);
            PG8_BAR; PG8_WAIT_L(0); PG8_MMA(1, 0, At, B0); PG8_BAR; PG8_SCHED;
            PG8_STAGE(PG8_SB(0, 1), b2 + hstepB, voffB);
            PG8_WAIT_V(6); PG8_BAR; PG8_MMA(1, 1, At, B1); PG8_BAR;
            PG8_LDB(B0, 1, 0); PG8_SCHED; PG8_LDA(At, 1, 0); PG8_STAGE(PG8_SA(0, 1), a2 + hstepA, voffA);
            PG8_WAIT_L(8); PG8_BAR; PG8_WAIT_L(0); PG8_MMA(0, 0, At, B0); PG8_BAR; PG8_SCHED;
            PG8_LDB(B1, 1, 1); PG8_STAGE(PG8_SB(1, 0), b3, voffB);
            PG8_BAR; PG8_WAIT_L(0); PG8_MMA(0, 1, At, B1); PG8_BAR;
            PG8_LDA(At, 1, 1); PG8_STAGE(PG8_SA(1, 0), a3, voffA);
            PG8_BAR; PG8_WAIT_L(0); PG8_MMA(1, 0, At, B0); PG8_BAR; PG8_SCHED;
            PG8_STAGE(PG8_SB(1, 1), b3 + hstepB, voffB);
            PG8_WAIT_V(6); PG8_BAR; PG8_MMA(1, 1, At, B1); PG8_BAR;
        }
        E(acc, cur, wr, wc, fr, fq);
        if (!has_next) break;
#pragma unroll
        for (int a = 0; a < 2; ++a)
#pragma unroll
            for (int b = 0; b < 2; ++b)
#pragma unroll
                for (int m = 0; m < 4; ++m)
#pragma unroll
                    for (int n = 0; n < 2; ++n) acc[a][b][m][n] = (f32x4){0.f, 0.f, 0.f, 0.f};
        cur = nxt; cA = nA; cB = nB; ++ui;
    }
    PG8_WAIT_V(0);
    if (wr == 0) PG8_BAR;
    PG8_BAR;
#undef PG8_SA
#undef PG8_SB
#undef PG8_STAGE
#undef PG8_LDA
#undef PG8_LDB
#undef PG8_MMA
#undef PG8_WAIT_V
#undef PG8_WAIT_L
#undef PG8_BAR
#undef PG8_SCHED
}

typedef const f32x4 (&AccRef)[2][2][4][2];
__device__ __forceinline__ u32x4 pack8(f32x4 v0, f32x4 v1) { u32x4 w; w.x = cvt_pk_bf16(v0[0], v0[1]); w.y = cvt_pk_bf16(v0[2], v0[3]); w.z = cvt_pk_bf16(v1[0], v1[1]); w.w = cvt_pk_bf16(v1[2], v1[3]); return w; }
__device__ __forceinline__ void unpack8(u32x4 w, f32x4& v0, f32x4& v1) { v0 = (f32x4){bflo(w.x), bfhi(w.x), bflo(w.y), bfhi(w.y)}; v1 = (f32x4){bflo(w.z), bfhi(w.z), bflo(w.w), bfhi(w.w)}; }

struct EpiSwiglu {
    static constexpr bool PERM = true; bf16_t* O;
    __device__ __forceinline__ void operator()(AccRef acc, const Unit& u, int wr, int wc, int fr, int fq) const {
        const int row0 = u.pm * BM + wr * 64 + fr, col = u.pn * 128 + wc * 32 + 8 * fq;
#pragma unroll
        for (int ai = 0; ai < 2; ++ai)
#pragma unroll
            for (int m = 0; m < 4; ++m) {
                f32x4 v0, v1;
#pragma unroll
                for (int j = 0; j < 4; ++j) { v0[j] = silu(acc[ai][0][m][0][j]) * acc[ai][1][m][0][j]; v1[j] = silu(acc[ai][0][m][1][j]) * acc[ai][1][m][1][j]; }
                *(u32x4*)(O + (size_t)(row0 + ai * HALF + m * 16) * DFF + col) = pack8(v0, v1);
            }
    }
};
struct EpiBf16 {
    static constexpr bool PERM = true; bf16_t* O; int ldc;
    __device__ __forceinline__ void operator()(AccRef acc, const Unit& u, int wr, int wc, int fr, int fq) const {
        const int row0 = u.pm * BM + wr * 64 + fr, col0 = u.pn * BM + wc * 32 + 8 * fq;
#pragma unroll
        for (int ai = 0; ai < 2; ++ai)
#pragma unroll
            for (int m = 0; m < 4; ++m)
#pragma unroll
                for (int bj = 0; bj < 2; ++bj)
                    *(u32x4*)(O + (size_t)(row0 + ai * HALF + m * 16) * ldc + col0 + bj * HALF) = pack8(acc[ai][bj][m][0], acc[ai][bj][m][1]);
    }
};
struct EpiWin {
    static constexpr bool PERM = true; unsigned char* ws;
    __device__ __forceinline__ void operator()(AccRef acc, const Unit& u, int wr, int wc, int fr, int fq) const {
        const int pn = u.pn; int act, ld, cb; size_t base;
        if (pn < 4) { act = 0; ld = 1024; cb = pn * 256; base = B_XL; }
        else if (pn < 8) { act = 1; ld = 1024; cb = (pn - 4) * 256; base = B_GL; }
        else if (pn < 12) { act = 2; ld = 0; cb = (pn - 8) * 256; base = B_A2; }
        else if (pn < 18) { act = 3; ld = 1536; cb = (pn - 12) * 256; base = B_Q; }
        else if (pn < 24) { act = 0; ld = 1536; cb = (pn - 18) * 256; base = B_K; }
        else if (pn < 30) { act = 0; ld = 1536; cb = (pn - 24) * 256; base = B_V; }
        else if (pn < 38) { act = 4; ld = 2048; cb = (pn - 30) * 256; base = B_GA; }
        else if (pn < 46) { act = 4; ld = 2048; cb = (pn - 38) * 256; base = B_GB; }
        else { act = 4; ld = 2048; cb = (pn - 46) * 256; base = B_GC; }
        bf16_t* O = (bf16_t*)(ws + base);
        const int row0 = u.pm * BM + wr * 64 + fr, col0 = cb + wc * 32 + 8 * fq;
#pragma unroll
        for (int ai = 0; ai < 2; ++ai)
#pragma unroll
            for (int m = 0; m < 4; ++m)
#pragma unroll
                for (int bj = 0; bj < 2; ++bj) {
                    const int row = row0 + ai * HALF + m * 16, col = col0 + bj * HALF;
                    f32x4 v0 = acc[ai][bj][m][0], v1 = acc[ai][bj][m][1];
                    if (act == 1) {
#pragma unroll
                        for (int j = 0; j < 4; ++j) { v0[j] = gelu_t(v0[j]); v1[j] = gelu_t(v1[j]); } }
                    else if (act == 3) { v0 *= 0.125f; v1 *= 0.125f; }
                    else if (act == 4) {
#pragma unroll
                        for (int j = 0; j < 4; ++j) { v0[j] = sigm(v0[j]); v1[j] = sigm(v1[j]); } }
                    size_t off;
                    if (act == 2) off = ((size_t)(col >> 4) * NSUB + (row >> 4)) * 512 + (row & 15) * 16 + (col & 15);
                    else off = (size_t)row * ld + col;
                    *(u32x4*)(O + off) = pack8(v0, v1);
                }
    }
};
struct EpiS {
    static constexpr bool PERM = false; float* S;
    __device__ __forceinline__ void operator()(AccRef acc, const Unit& u, int wr, int wc, int fr, int fq) const {
        const int row0 = u.pm * BM + wr * 64 + fr, col0 = wc * 32 + 4 * fq;
        float* base = S + (size_t)u.b * NSUB * 256;
#pragma unroll
        for (int ai = 0; ai < 2; ++ai)
#pragma unroll
            for (int m = 0; m < 4; ++m)
#pragma unroll
                for (int bj = 0; bj < 2; ++bj)
#pragma unroll
                    for (int n = 0; n < 2; ++n)
                        *(f32x4*)(base + (size_t)(row0 + ai * HALF + m * 16) * 256 + col0 + bj * HALF + n * 16) = acc[ai][bj][m][n];
    }
};
struct EpiY {
    static constexpr bool PERM = true; bf16_t* Y1;
    __device__ __forceinline__ void operator()(AccRef acc, const Unit& u, int wr, int wc, int fr, int fq) const {
        const int row0 = u.pm * BM + wr * 64 + fr, n0 = wc * 32 + 8 * fq;
#pragma unroll
        for (int ai = 0; ai < 2; ++ai)
#pragma unroll
            for (int m = 0; m < 4; ++m)
#pragma unroll
                for (int bj = 0; bj < 2; ++bj) {
                    const int j = row0 + ai * HALF + m * 16, nn = n0 + bj * HALF, tok = j * 16 + (nn >> 4);
                    f32x4 v0 = acc[ai][bj][m][0], v1 = acc[ai][bj][m][1];
#pragma unroll
                    for (int q = 0; q < 4; ++q) { v0[q] = gelu_t(v0[q]); v1[q] = gelu_t(v1[q]); }
                    *(u32x4*)(Y1 + (size_t)tok * 1024 + u.b * 16 + (nn & 15)) = pack8(v0, v1);
                }
    }
};
struct EpiGlu {
    static constexpr bool PERM = true; const bf16_t* Y1; bf16_t* O; const float* bias;
    __device__ __forceinline__ void operator()(AccRef acc, const Unit& u, int wr, int wc, int fr, int fq) const {
        const int row0 = u.pm * BM + wr * 64 + fr, col0 = u.pn * BM + wc * 32 + 8 * fq;
#pragma unroll
        for (int bj = 0; bj < 2; ++bj) {
            const int col = col0 + bj * HALF;
            const f32x4 b0 = *(const f32x4*)(bias + col), b1 = *(const f32x4*)(bias + col + 4);
#pragma unroll
            for (int ai = 0; ai < 2; ++ai)
#pragma unroll
                for (int m = 0; m < 4; ++m) {
                    const size_t off = (size_t)(row0 + ai * HALF + m * 16) * 1024 + col;
                    f32x4 y0, y1v; unpack8(*(const u32x4*)(Y1 + off), y0, y1v);
                    f32x4 v0 = acc[ai][bj][m][0] + b0, v1 = acc[ai][bj][m][1] + b1;
#pragma unroll
                    for (int q = 0; q < 4; ++q) { v0[q] = y0[q] * sigm(v0[q]); v1[q] = y1v[q] * sigm(v1[q]); }
                    *(u32x4*)(O + off) = pack8(v0, v1);
                }
        }
    }
};
template <bool FIRST> struct EpiMerge {
    static constexpr bool PERM = true; const bf16_t* Gt; bf16_t* Mo;
    __device__ __forceinline__ void operator()(AccRef acc, const Unit& u, int wr, int wc, int fr, int fq) const {
        const int row0 = u.pm * BM + wr * 64 + fr, col0 = u.pn * BM + wc * 32 + 8 * fq;
#pragma unroll
        for (int ai = 0; ai < 2; ++ai)
#pragma unroll
            for (int m = 0; m < 4; ++m)
#pragma unroll
                for (int bj = 0; bj < 2; ++bj) {
                    const size_t off = (size_t)(row0 + ai * HALF + m * 16) * 2048 + col0 + bj * HALF;
                    f32x4 g0, g1; unpack8(*(const u32x4*)(Gt + off), g0, g1);
                    f32x4 v0 = g0 * acc[ai][bj][m][0], v1 = g1 * acc[ai][bj][m][1];
                    if (!FIRST) { f32x4 p0, p1; unpack8(*(const u32x4*)(Mo + off), p0, p1); v0 += p0; v1 += p1; }
                    *(u32x4*)(Mo + off) = pack8(v0, v1);
                }
    }
};

__device__ void cvt_job(unsigned char* shm, const float* src, bf16_t* dst, int K, int N, int mode) {
    bf16_t* T = (bf16_t*)shm;
    const int tid = ltid(), bid = lbid(), nkt = K / 64, nnt = N / 256, tot = nkt * nnt;
    for (int t = bid; t < tot; t += gridDim.x) {
        const int nti = t % nnt, kt = t / nnt;
        { const int k = tid >> 3, n8 = (tid & 7) * 8;
          const float* s = src + (size_t)(kt * 64 + k) * N + nti * 256 + n8;
          f32x4 v[8];
#pragma unroll
          for (int q = 0; q < 4; ++q) { v[2 * q] = *(const f32x4*)(s + q * 64); v[2 * q + 1] = *(const f32x4*)(s + q * 64 + 4); }
#pragma unroll
          for (int q = 0; q < 4; ++q)
#pragma unroll
              for (int j = 0; j < 4; ++j) { T[(q * 64 + n8 + j) * 72 + k] = f2bf(v[2 * q][j]); T[(q * 64 + n8 + 4 + j) * 72 + k] = f2bf(v[2 * q + 1][j]); } }
        __syncthreads();
#pragma unroll
        for (int q = 0; q < 4; ++q) { const int n = q * 64 + (tid >> 3), k8 = (tid & 7) * 8; const int nn = nti * 256 + n;
          const int drow = mode == 0 ? nn : ((nn >> 7) * 256 + (nn & 127) + (mode == 2 ? 128 : 0));
          *(u32x4*)(dst + (size_t)drow * K + kt * 64 + k8) = *(const u32x4*)(T + n * 72 + k8); }
        __syncthreads();
    }
}
__device__ void cvt_ffn(const Params& p, unsigned char* shm, int l, int sub) {
    bf16_t* W = (bf16_t*)(p.ws + WS_W); const size_t wo = (size_t)(l * 2 + sub) * DM * DFF;
    cvt_job(shm, p.in[26] + wo, W + W_13, DM, DFF, 1);
    cvt_job(shm, p.in[27] + wo, W + W_13, DM, DFF, 2);
    cvt_job(shm, p.in[28] + wo, W + W_2, DFF, DM, 0);
}
__device__ void cvt_mixer(const Params& p, unsigned char* shm, int l) {
    bf16_t* W = (bf16_t*)(p.ws + WS_W);
    cvt_job(shm, p.in[3] + (size_t)l * DM * 13824, W + W_IN, DM, 13824, 0);
    cvt_job(shm, p.in[19] + (size_t)l * 1024 * 1024, W + W_GLU, 1024, 1024, 0);
    cvt_job(shm, p.in[22] + (size_t)l * 1024 * DM, W + W_BRL, 1024, DM, 0);
    cvt_job(shm, p.in[23] + (size_t)l * 1024 * DM, W + W_BRS, 1024, DM, 0);
    cvt_job(shm, p.in[24] + (size_t)l * 512 * DM, W + W_BRA, 512, DM, 0);
    cvt_job(shm, p.in[25] + (size_t)l * DM * DM, W + W_OUT, DM, DM, 0);
}

__device__ void norm_rows(const Params& p, bool first, const bf16_t* y, float scale, const float* gpost, const float* gpre, bf16_t* h) {
    const int tid = ltid(), bid = lbid(), lane = tid & 63, wid = tid >> 6;
    for (int row = bid * 8 + wid; row < MT; row += gridDim.x * 8) {
        const float* xr = first ? (row < 8192 ? p.in[0] + (size_t)row * DM : p.in[1] + (size_t)(row - 8192) * DM) : p.out + (size_t)row * DM;
        f32x4 xv[8];
#pragma unroll
        for (int c = 0; c < 8; ++c) xv[c] = *(const f32x4*)(xr + (c * 64 + lane) * 4);
        if (y) {
            f32x4 yv[8]; float ss = 0.f;
#pragma unroll
            for (int c = 0; c < 8; ++c) { const u32x2 w = *(const u32x2*)(y + (size_t)row * DM + (c * 64 + lane) * 4);
                yv[c] = (f32x4){bflo(w.x), bfhi(w.x), bflo(w.y), bfhi(w.y)}; ss += yv[c][0] * yv[c][0] + yv[c][1] * yv[c][1] + yv[c][2] * yv[c][2] + yv[c][3] * yv[c][3]; }
            ss = wave_sum(ss);
            const float rs = rsqrtf(ss * (1.0f / DM) + RMS_EPS) * scale;
#pragma unroll
            for (int c = 0; c < 8; ++c) { const f32x4 gp = *(const f32x4*)(gpost + (c * 64 + lane) * 4); xv[c] += yv[c] * gp * rs; }
        }
        if (y || first) {
#pragma unroll
            for (int c = 0; c < 8; ++c) *(f32x4*)(p.out + (size_t)row * DM + (c * 64 + lane) * 4) = xv[c];
        }
        if (gpre) {
            float ss = 0.f;
#pragma unroll
            for (int c = 0; c < 8; ++c) ss += xv[c][0] * xv[c][0] + xv[c][1] * xv[c][1] + xv[c][2] * xv[c][2] + xv[c][3] * xv[c][3];
            ss = wave_sum(ss);
            const float rs = rsqrtf(ss * (1.0f / DM) + RMS_EPS);
#pragma unroll
            for (int c = 0; c < 8; ++c) { const f32x4 gp = *(const f32x4*)(gpre + (c * 64 + lane) * 4); const f32x4 v = xv[c] * gp * rs;
                u32x2 w; w.x = cvt_pk_bf16(v[0], v[1]); w.y = cvt_pk_bf16(v[2], v[3]); *(u32x2*)(h + (size_t)row * DM + (c * 64 + lane) * 4) = w; }
        }
    }
}

__device__ void s5_stage1(const Params& p, int l) {
    float2* Apow = (float2*)(p.ws + SM_APOW); float2* Bbar = (float2*)(p.ws + SM_BBAR);
    for (int idx = lbid() * 512 + ltid(); idx < 8192; idx += gridDim.x * 512) {
        const float lr = p.in[11][l * 8192 + idx], li = p.in[12][l * 8192 + idx], dt = expf(p.in[13][l * 128 + (idx >> 6)]);
        float ar = 1.f, ai = 0.f;
        for (int k = 0; k < 18; ++k) { const float mag = expf((float)k * lr * dt); float s, c; sincosf((float)k * li * dt, &s, &c); Apow[idx * 18 + k] = make_float2(mag * c, mag * s); if (k == 1) { ar = mag * c; ai = mag * s; } }
        const float den = lr * lr + li * li, cr = ((ar - 1.0f) * lr + ai * li) / den, ci = (ai * lr - (ar - 1.0f) * li) / den;
        for (int c = 0; c < 16; ++c) { const float br = p.in[14][(size_t)l * 131072 + idx * 16 + c], bi = p.in[15][(size_t)l * 131072 + idx * 16 + c];
            Bbar[idx * 16 + c] = make_float2(cr * br - ci * bi, cr * bi + ci * br); }
    }
}
__device__ void s5_stage2(const Params& p, int l) {
    const float2* Apow = (const float2*)(p.ws + SM_APOW); const float2* Bbar = (const float2*)(p.ws + SM_BBAR);
    float* Kd = (float*)(p.ws + SM_KD); bf16_t* Gm = (bf16_t*)(p.ws + SM_G); bf16_t* Ym = (bf16_t*)(p.ws + SM_Y); bf16_t* LWT = (bf16_t*)(p.ws + SM_LWT);
    const float* cre = p.in[16] + (size_t)l * 131072; const float* cim = p.in[17] + (size_t)l * 131072;
    const int gs = gridDim.x * 512, t0 = lbid() * 512 + ltid();
    for (int o = t0; o < 524288; o += gs) {
        const int c2 = o & 15, c = (o >> 4) & 15, k = (o >> 8) & 15, dg = o >> 12;
        float acc = 0.f;
        for (int pp = 0; pp < 64; ++pp) { const int sidx = dg * 64 + pp; const float2 A = Apow[sidx * 18 + k], Bb = Bbar[sidx * 16 + c2];
            const float Cr = cre[(dg * 16 + c) * 64 + pp], Ci = cim[(dg * 16 + c) * 64 + pp];
            const float abr = A.x * Bb.x - A.y * Bb.y, abi = A.x * Bb.y + A.y * Bb.x; acc += Cr * abr - Ci * abi; }
        Kd[o] = acc;
    }
    for (int o = t0; o < 64 * 65536; o += gs) {
        const int kk = o & 255, n = (o >> 8) & 255, g = o >> 16;
        { const int d = n >> 7, ri = (n >> 6) & 1, pp = n & 63, s = kk >> 4, c2 = kk & 15, e = d == 0 ? 15 - s : s; const int sidx = (d * 64 + g) * 64 + pp;
          const float2 A = Apow[sidx * 18 + e], Bb = Bbar[sidx * 16 + c2];
          Gm[o] = f2bf(ri ? A.x * Bb.y + A.y * Bb.x : A.x * Bb.x - A.y * Bb.y); }
        { const int tau = n >> 4, c = n & 15, d = kk >> 7, ri = (kk >> 6) & 1, pp = kk & 63, e = d == 0 ? tau + 1 : 16 - tau; const int sidx = (d * 64 + g) * 64 + pp;
          const float2 A = Apow[sidx * 18 + e]; const float Cr = cre[((d * 64 + g) * 16 + c) * 64 + pp], Ci = cim[((d * 64 + g) * 16 + c) * 64 + pp];
          Ym[((size_t)g * 256 + n) * 512 + 256 + kk] = f2bf(ri ? -(Cr * A.y + Ci * A.x) : Cr * A.x - Ci * A.y); }
    }
    for (int o = t0; o < 262144; o += gs) {
        const int i = o & 63, j = (o >> 6) & 63, n = (o >> 12) & 15, gate = (o >> 16) & 1, d = o >> 17;
        const float* src = gate ? p.in[8] : p.in[6];
        LWT[o] = f2bf(src[(size_t)((l * 2 + d) * 16 + n) * 4096 + i * 64 + j]);
    }
}
__device__ void s5_stage3(const Params& p, int l) {
    const float* Kd = (const float*)(p.ws + SM_KD); bf16_t* Ym = (bf16_t*)(p.ws + SM_Y); const float* Dk = p.in[18] + l * 1024;
    for (int o = lbid() * 512 + ltid(); o < 64 * 65536; o += gridDim.x * 512) {
        const int kk = o & 255, n = (o >> 8) & 255, g = o >> 16, s = kk >> 4, c2 = kk & 15, tau = n >> 4, c = n & 15;
        float v = 0.f;
        if (s <= tau) v += Kd[((0 * 64 + g) * 16 + (tau - s)) * 256 + c * 16 + c2];
        if (s >= tau) v += Kd[((1 * 64 + g) * 16 + (s - tau)) * 256 + c * 16 + c2];
        if (s == tau && c == c2) v += Dk[g * 16 + c];
        Ym[((size_t)g * 256 + n) * 512 + kk] = f2bf(v);
    }
}
__device__ void s5_bscan(const Params& p, unsigned char* shm) {
    const float2* Apow = (const float2*)(p.ws + SM_APOW); const float* S = (const float*)(p.ws + B_S); bf16_t* A2 = (bf16_t*)(p.ws + B_A2);
    float2* Es = (float2*)shm;
    const int tid = ltid();
    for (int it = lbid(); it < 192; it += gridDim.x) {
        const bool lng = it < 128;
        const int pp = tid & 63, g = lng ? it >> 1 : it - 128, d = lng ? (it & 1) : ((tid >> 6) & 1), seg = lng ? tid >> 6 : 0, seq = lng ? 4 : tid >> 7;
        const int j0 = lng ? 512 + seg * 128 : seq * 128;
        const float2 A16 = Apow[((d * 64 + g) * 64 + pp) * 18 + 16];
        const float* Sg = S + (size_t)g * NSUB * 256 + d * 128 + pp; bf16_t* Xg = A2 + (size_t)g * NSUB * 512 + 256 + d * 128 + pp;
        float xr = 0.f, xi = 0.f;
        if (lng) {
            for (int jb = 0; jb < 128; jb += 16) {
                float sr[16], si[16];
#pragma unroll
                for (int u = 0; u < 16; ++u) { const int j = d ? (j0 + 127 - (jb + u)) : (j0 + jb + u); sr[u] = Sg[(size_t)j * 256]; si[u] = Sg[(size_t)j * 256 + 64]; }
#pragma unroll
                for (int u = 0; u < 16; ++u) { const float nr = A16.x * xr - A16.y * xi + sr[u], ni = A16.x * xi + A16.y * xr + si[u]; xr = nr; xi = ni; }
            }
            Es[seg * 64 + pp] = make_float2(xr, xi);
            float2 Ab = A16;
#pragma unroll
            for (int q = 0; q < 7; ++q) Ab = make_float2(Ab.x * Ab.x - Ab.y * Ab.y, 2.0f * Ab.x * Ab.y);
            __syncthreads();
            xr = 0.f; xi = 0.f;
            for (int q = 0; q < 8; ++q) { const int sq = d ? 7 - q : q; const bool use = d ? (sq > seg) : (sq < seg);
                if (use) { const float2 E = Es[sq * 64 + pp]; const float nr = Ab.x * xr - Ab.y * xi + E.x, ni = Ab.x * xi + Ab.y * xr + E.y; xr = nr; xi = ni; } }
        }
        for (int jb = 0; jb < 128; jb += 16) {
            float sr[16], si[16];
#pragma unroll
            for (int u = 0; u < 16; ++u) { const int j = d ? (j0 + 127 - (jb + u)) : (j0 + jb + u); sr[u] = Sg[(size_t)j * 256]; si[u] = Sg[(size_t)j * 256 + 64]; }
#pragma unroll
            for (int u = 0; u < 16; ++u) { const int j = d ? (j0 + 127 - (jb + u)) : (j0 + jb + u);
                Xg[(size_t)j * 512] = f2bf(xr); Xg[(size_t)j * 512 + 64] = f2bf(xi);
                const float nr = A16.x * xr - A16.y * xi + sr[u], ni = A16.x * xi + A16.y * xr + si[u]; xr = nr; xi = ni; }
        }
        __syncthreads();
    }
}

template <int PASS>
__device__ void lru_items(const Params& p, unsigned char* shm, int l) {
    bf16_t* xraw = (bf16_t*)shm;
    float* xcf = (float*)(shm + 8704);
    bf16_t* xcb = (bf16_t*)(shm + 25344);
    bf16_t* wt = (bf16_t*)(shm + 34560);
    float* As = (float*)(shm + 71424);
    float* Bs = (float*)(shm + 104192);
    float* Pq = (float*)(shm + 136960);
    float* Hq = (float*)(shm + 139008);
    const bf16_t* XL = (const bf16_t*)(p.ws + B_XL); bf16_t* GL = (bf16_t*)(p.ws + B_GL); const bf16_t* LWT = (const bf16_t*)(p.ws + SM_LWT);
    float* SA = (float*)(p.ws + SM_SA); float* SH = (float*)(p.ws + SM_SH); const float* CIN = (const float*)(p.ws + SM_CIN);
    const float* cw = p.in[4] + l * 4096; const float* cbias = p.in[5] + l * 1024;
    const int tid = ltid(), lane = tid & 63, w = tid >> 6, fr = lane & 15, fq = lane >> 4;
    for (int it = lbid(); it < NCHK * 16; it += gridDim.x) {
        const int ck = it >> 4, n = it & 15, t0 = ck * 64;
        const int s_start = t0 < 8192 ? (t0 & ~2047) : 8192, s_end = t0 < 8192 ? s_start + 2048 : MT;
        for (int e = tid; e < 67 * 8; e += 512) { const int row = e >> 3, c8 = e & 7, tok = t0 - 2 + row;
            u32x4 v = (u32x4){0u, 0u, 0u, 0u}; if (tok >= s_start && tok < s_end) v = *(const u32x4*)(XL + (size_t)tok * 1024 + n * 64 + c8 * 8);
            *(u32x4*)(xraw + row * 64 + c8 * 8) = v; }
#pragma unroll
        for (int i = 0; i < 4; ++i) { const int e = tid + 512 * i, mtx = e >> 9, rem = e & 511, j = rem >> 3, c8 = rem & 7;
            *(u32x4*)(wt + (mtx * 64 + j) * 72 + c8 * 8) = *(const u32x4*)(LWT + ((size_t)(mtx * 16 + n) * 64 + j) * 64 + c8 * 8); }
        __syncthreads();
        { const int j = tid & 63, ch = n * 64 + j; const float c0 = cw[ch], c1 = cw[1024 + ch], c2 = cw[2048 + ch], c3 = cw[3072 + ch], cb = cbias[ch];
#pragma unroll
          for (int i = 0; i < 8; ++i) { const int t = (tid >> 6) + 8 * i;
              const float v = cb + bf2f(xraw[t * 64 + j]) * c0 + bf2f(xraw[(t + 1) * 64 + j]) * c1 + bf2f(xraw[(t + 2) * 64 + j]) * c2 + bf2f(xraw[(t + 3) * 64 + j]) * c3;
              xcf[t * 65 + j] = v; xcb[t * 72 + j] = f2bf(v); } }
        __syncthreads();
        { const int d = w >> 2, tt = w & 3;
          const bf16x8 a0 = *(const bf16x8*)(xcb + (tt * 16 + fr) * 72 + fq * 8), a1 = *(const bf16x8*)(xcb + (tt * 16 + fr) * 72 + 32 + fq * 8);
#pragma unroll
          for (int jt = 0; jt < 4; ++jt) {
              f32x4 accr = (f32x4){0.f, 0.f, 0.f, 0.f}, acci = (f32x4){0.f, 0.f, 0.f, 0.f};
              const bf16_t* wr_ = wt + ((d * 2 + 0) * 64 + jt * 16 + fr) * 72 + fq * 8; const bf16_t* wi_ = wt + ((d * 2 + 1) * 64 + jt * 16 + fr) * 72 + fq * 8;
              accr = __builtin_amdgcn_mfma_f32_16x16x32_bf16(a0, *(const bf16x8*)wr_, accr, 0, 0, 0);
              accr = __builtin_amdgcn_mfma_f32_16x16x32_bf16(a1, *(const bf16x8*)(wr_ + 32), accr, 0, 0, 0);
              acci = __builtin_amdgcn_mfma_f32_16x16x32_bf16(a0, *(const bf16x8*)wi_, acci, 0, 0, 0);
              acci = __builtin_amdgcn_mfma_f32_16x16x32_bf16(a1, *(const bf16x8*)(wi_ + 32), acci, 0, 0, 0);
              const int j = jt * 16 + fr, ch = n * 64 + j; const int pi = (l * 2 + d) * 1024 + ch;
              const float ba = p.in[7][pi], bx = p.in[9][pi], sp = -8.0f * log1pf(__expf(-p.in[10][pi]));
#pragma unroll
              for (int i = 0; i < 4; ++i) { const int t = tt * 16 + fq * 4 + i;
                  const float r = sigm(accr[i] + ba), ig = sigm(acci[i] + bx), a = __expf(r * sp);
                  As[(d * 64 + t) * 64 + j] = a;
                  Bs[(d * 64 + t) * 64 + j] = sqrtf(fmaxf(1.0f - a * a, 0.f)) * ig * xcf[t * 65 + j]; }
          } }
        __syncthreads();
        {
            const int seg = tid >> 7, d = (tid >> 6) & 1, j = tid & 63, ch = n * 64 + j; const size_t so = (size_t)(ck * 2 + d) * 1024 + ch;
            float h = 0.f, P = 1.f;
#pragma unroll
            for (int s = 0; s < 16; ++s) { const int st = seg * 16 + s, t = d ? 63 - st : st; const float a = As[(d * 64 + t) * 64 + j]; h = a * h + Bs[(d * 64 + t) * 64 + j]; P *= a; }
            Pq[seg * 128 + (tid & 127)] = P; Hq[seg * 128 + (tid & 127)] = h;
            __syncthreads();
            if (PASS == 0) {
                if (tid < 128) { float hh = Hq[tid], PP = Pq[tid];
#pragma unroll
                    for (int q = 1; q < 4; ++q) { const float pq = Pq[q * 128 + tid]; hh = pq * hh + Hq[q * 128 + tid]; PP *= pq; }
                    SA[so] = PP; SH[so] = hh; }
            } else {
                float c = CIN[so];
#pragma unroll
                for (int q = 0; q < 3; ++q) if (q < seg) c = Pq[q * 128 + (tid & 127)] * c + Hq[q * 128 + (tid & 127)];
#pragma unroll
                for (int s = 0; s < 16; ++s) { const int st = seg * 16 + s, t = d ? 63 - st : st; c = As[(d * 64 + t) * 64 + j] * c + Bs[(d * 64 + t) * 64 + j]; Bs[(d * 64 + t) * 64 + j] = c; }
                __syncthreads();
                const int t = tid >> 3, c8 = tid & 7; const size_t go = (size_t)(t0 + t) * 1024 + n * 64 + c8 * 8;
                f32x4 g0, g1; unpack8(*(const u32x4*)(GL + go), g0, g1);
                const f32x4 f0 = *(const f32x4*)(Bs + t * 64 + c8 * 8), f1 = *(const f32x4*)(Bs + t * 64 + c8 * 8 + 4), r0 = *(const f32x4*)(Bs + (64 + t) * 64 + c8 * 8), r1 = *(const f32x4*)(Bs + (64 + t) * 64 + c8 * 8 + 4);
                *(u32x4*)(GL + go) = pack8((f0 + r0) * g0, (f1 + r1) * g1);
            }
        }
        __syncthreads();
    }
}
__device__ void lru_carry(const Params& p) {
    const float* SA = (const float*)(p.ws + SM_SA); const float* SH = (const float*)(p.ws + SM_SH); float* CIN = (float*)(p.ws + SM_CIN);
    const int tid_ = ltid();
    for (int it = lbid(); it < 20; it += gridDim.x) {
        const int c = it * 512 + tid_, ch = c & 1023, d = (c >> 10) & 1, seq = c >> 11;
        const int k0 = seq < 4 ? seq * 32 : 128, nk = seq < 4 ? 32 : 256;
        float carry = 0.f;
        for (int kb = 0; kb < nk; kb += 8) {
            float a[8], h[8];
#pragma unroll
            for (int u = 0; u < 8; ++u) { const int k = d ? (k0 + nk - 1 - (kb + u)) : (k0 + kb + u); a[u] = SA[(size_t)(k * 2 + d) * 1024 + ch]; h[u] = SH[(size_t)(k * 2 + d) * 1024 + ch]; }
#pragma unroll
            for (int u = 0; u < 8; ++u) { const int k = d ? (k0 + nk - 1 - (kb + u)) : (k0 + kb + u); CIN[(size_t)(k * 2 + d) * 1024 + ch] = carry; carry = a[u] * carry + h[u]; }
        }
    }
}

__device__ void attn_items(const Params& p, unsigned char* shm) {
    bf16_t* Ks = (bf16_t*)shm;
    bf16_t* Vt = (bf16_t*)(shm + 36864);
    bf16_t* Ps = (bf16_t*)(shm + 72704);
    float* bs = (float*)(shm + 115712);
    bf16_t* Qb = (bf16_t*)(p.ws + B_Q); const bf16_t* Kb = (const bf16_t*)(p.ws + B_K); const bf16_t* Vb = (const bf16_t*)(p.ws + B_V);
    float* LSE = (float*)(p.ws + SM_LSE);
    const int tid = ltid(), lane = tid & 63, w = tid >> 6, fr = lane & 15, fq = lane >> 4;
    for (int it = lbid(); it < 24 * 192; it += gridDim.x) {
        const int hd = it / 192, qt = it % 192;
        int seq_start, T, lt; if (qt < 64) { seq_start = (qt >> 4) * 2048; T = 2048; lt = qt & 15; } else { seq_start = 8192; T = 16384; lt = qt - 64; }
        const int g = hd >> 3, dil = g == 0 ? 1 : (g == 1 ? 4 : 16), n_lat = T / dil, tpr = n_lat >> 7, r = lt / tpr, q0 = (lt % tpr) << 7;
        for (int e = tid; e < 2176; e += 512) { const int kk = e >> 3, c8 = e & 7, lat = q0 - 64 + kk; const bool ok = kk < 256 && lat >= 0 && lat < n_lat;
            u32x4 kv = (u32x4){0u, 0u, 0u, 0u}, vv = (u32x4){0u, 0u, 0u, 0u};
            if (ok) { const size_t go = (size_t)(seq_start + r + dil * lat) * 1536 + hd * 64 + c8 * 8; kv = *(const u32x4*)(Kb + go); vv = *(const u32x4*)(Vb + go); }
            if (kk < 256) *(u32x4*)(Ks + kk * 72 + c8 * 8) = kv;
#pragma unroll
            for (int j = 0; j < 8; ++j) Vt[(c8 * 8 + j) * 280 + kk] = (bf16_t)((vv[j >> 1] >> ((j & 1) * 16)) & 0xffffu); }
        if (tid < 129) bs[tid] = p.in[21][(int)BUCKET[g][tid] * 24 + hd];
        __syncthreads();
        const size_t qo = (size_t)(seq_start + r + dil * (q0 + 16 * w + fr)) * 1536 + hd * 64;
        const bf16x8 aq0 = *(const bf16x8*)(Qb + qo + fq * 8), aq1 = *(const bf16x8*)(Qb + qo + 32 + fq * 8);
        f32x4 s[9];
#pragma unroll
        for (int kt = 0; kt < 9; ++kt) { const bf16_t* kr = Ks + (16 * w + 16 * kt + fr) * 72 + fq * 8;
            f32x4 a = (f32x4){0.f, 0.f, 0.f, 0.f};
            a = __builtin_amdgcn_mfma_f32_16x16x32_bf16(aq0, *(const bf16x8*)kr, a, 0, 0, 0);
            a = __builtin_amdgcn_mfma_f32_16x16x32_bf16(aq1, *(const bf16x8*)(kr + 32), a, 0, 0, 0); s[kt] = a; }
        float mx[4], ls[4];
#pragma unroll
        for (int i = 0; i < 4; ++i) { const int qi = fq * 4 + i; float m = -3.0e38f;
#pragma unroll
            for (int kt = 0; kt < 9; ++kt) { const int rel = 16 * kt + fr - 64 - qi, klat = q0 - 64 + 16 * w + 16 * kt + fr;
                const bool ok = rel >= -64 && rel <= 64 && klat >= 0 && klat < n_lat; const int bi = min(max(rel + 64, 0), 128);
                const float v = ok ? s[kt][i] + bs[bi] : -1.0e30f; s[kt][i] = v; m = fmaxf(m, v); }
            m = fmaxf(m, __shfl_xor(m, 1)); m = fmaxf(m, __shfl_xor(m, 2)); m = fmaxf(m, __shfl_xor(m, 4)); m = fmaxf(m, __shfl_xor(m, 8));
            float sum = 0.f;
#pragma unroll
            for (int kt = 0; kt < 9; ++kt) { const float pv = __expf(s[kt][i] - m); s[kt][i] = pv; sum += pv; }
            sum += __shfl_xor(sum, 1); sum += __shfl_xor(sum, 2); sum += __shfl_xor(sum, 4); sum += __shfl_xor(sum, 8);
            mx[i] = m; ls[i] = sum; }
        bf16_t* Pw = Ps + w * 16 * 168;
#pragma unroll
        for (int i = 0; i < 4; ++i) {
#pragma unroll
            for (int kt = 0; kt < 9; ++kt) Pw[(fq * 4 + i) * 168 + 16 * kt + fr] = f2bf(s[kt][i]);
            Pw[(fq * 4 + i) * 168 + 144 + fr] = 0; }
        __syncthreads();
        f32x4 o[4];
#pragma unroll
        for (int nt = 0; nt < 4; ++nt) o[nt] = (f32x4){0.f, 0.f, 0.f, 0.f};
#pragma unroll
        for (int ks = 0; ks < 5; ++ks) { const bf16x8 ap = *(const bf16x8*)(Pw + fr * 168 + ks * 32 + fq * 8);
#pragma unroll
            for (int nt = 0; nt < 4; ++nt) o[nt] = __builtin_amdgcn_mfma_f32_16x16x32_bf16(ap, *(const bf16x8*)(Vt + (nt * 16 + fr) * 280 + 16 * w + ks * 32 + fq * 8), o[nt], 0, 0, 0); }
#pragma unroll
        for (int i = 0; i < 4; ++i) { const float inv = 1.0f / ls[i]; const int tok = seq_start + r + dil * (q0 + 16 * w + fq * 4 + i);
#pragma unroll
            for (int nt = 0; nt < 4; ++nt) Qb[(size_t)tok * 1536 + hd * 64 + nt * 16 + fr] = f2bf(o[nt][i] * inv);
            if (fr == 0) LSE[(size_t)tok * 24 + hd] = mx[i] + __logf(ls[i]); }
        __syncthreads();
    }
}
__device__ void attn_combine(const Params& p) {
    const bf16_t* Ab = (const bf16_t*)(p.ws + B_Q); const float* LSE = (const float*)(p.ws + SM_LSE); bf16_t* YA = (bf16_t*)(p.ws + B_YATT);
    for (int e = lbid() * 512 + ltid(); e < MT * 64; e += gridDim.x * 512) {
        const int tok = e >> 6, h = (e >> 3) & 7, c8 = e & 7;
        const float l0 = LSE[(size_t)tok * 24 + h], l1 = LSE[(size_t)tok * 24 + 8 + h], l2 = LSE[(size_t)tok * 24 + 16 + h];
        const float m = fmaxf(l0, fmaxf(l1, l2)); float w0 = __expf(l0 - m), w1 = __expf(l1 - m), w2 = __expf(l2 - m); const float inv = 1.0f / (w0 + w1 + w2); w0 *= inv; w1 *= inv; w2 *= inv;
        f32x4 a0, a1, b0, b1, c0, c1;
        unpack8(*(const u32x4*)(Ab + (size_t)tok * 1536 + h * 64 + c8 * 8), a0, a1);
        unpack8(*(const u32x4*)(Ab + (size_t)tok * 1536 + (8 + h) * 64 + c8 * 8), b0, b1);
        unpack8(*(const u32x4*)(Ab + (size_t)tok * 1536 + (16 + h) * 64 + c8 * 8), c0, c1);
        *(u32x4*)(YA + (size_t)tok * 512 + h * 64 + c8 * 8) = pack8(a0 * w0 + b0 * w1 + c0 * w2, a1 * w0 + b1 * w1 + c1 * w2);
    }
}

__device__ __forceinline__ Gemm mk_gemm(const bf16_t* A, int lda, const bf16_t* Bt, int ldb, int K, int nM, int nN, int nb = 1, size_t sA = 0, size_t sB = 0) {
    Gemm g; g.A = A; g.Bt = Bt; g.lda = lda; g.ldb = ldb; g.K = K; g.nM = nM; g.nN = nN; g.nb = nb; g.sA = sA; g.sB = sB; return g; }

__global__ __launch_bounds__(512, 2) void mega(Params p) {
    extern __shared__ __attribute__((aligned(16))) unsigned char shm[];
    LAS unsigned char* lds = (LAS unsigned char*)shm;
    cg::grid_group grid = cg::this_grid();
#pragma nounroll
    for (int ph = p.ph_lo; ph < p.ph_hi; ++ph) {
        unsigned char* ws = p.ws; asm volatile("" : "+s"(ws));
        const int l = ph == 0 ? 0 : (ph - 1) / 14, kind = ph == 0 ? 0 : (ph - 1) % 14 + 1;
        bf16_t* W = (bf16_t*)(ws + WS_W); bf16_t* H = (bf16_t*)(ws + WS_H);
        bf16_t* HID = (bf16_t*)(ws + B_HID); bf16_t* Y = (bf16_t*)(ws + B_Y); bf16_t* A2 = (bf16_t*)(ws + B_A2);
        bf16_t* Y1 = (bf16_t*)(ws + B_Y1); bf16_t* YS5 = (bf16_t*)(ws + B_YS5); bf16_t* Mb = (bf16_t*)(ws + B_M);
        const float* ng = p.in[2]; const float* gl_ = ng + l * 6 * DM;
#ifdef PROBE_MASK
        for (int rep = 0, reps = ((PROBE_MASK >> kind) & 1) ? 2 : 1; rep < reps; ++rep)
#endif
        switch (kind) {
        case 0:
            cvt_ffn(p, shm, 0, 0); s5_stage1(p, 0);
            norm_rows(p, true, nullptr, 0.f, nullptr, ng, H);
            break;
        case 1: case 12: {
            if (kind == 1) s5_stage2(p, l);
            __syncthreads();
            EpiSwiglu e; e.O = HID; gemm_phase(lds, mk_gemm(H, DM, W + W_13, DM, DM, MT / 256, 44), e);
        } break;
        case 2: case 13: {
            if (kind == 2) s5_stage3(p, l);
            __syncthreads();
            EpiBf16 e; e.O = Y; e.ldc = DM; gemm_phase(lds, mk_gemm(HID, DFF, W + W_2, DFF, DFF, MT / 256, 8), e);
        } break;
        case 3:
            cvt_mixer(p, shm, l);
            norm_rows(p, false, Y, 0.5f, gl_ + 1 * DM, gl_ + 2 * DM, H);
            break;
        case 4: {
            EpiWin e; e.ws = ws; gemm_phase(lds, mk_gemm(H, DM, W + W_IN, DM, DM, MT / 256, 54), e);
        } break;
        case 5: {
            { EpiS e; e.S = (float*)(ws + B_S); gemm_phase(lds, mk_gemm(A2, 512, (const bf16_t*)(ws + SM_G), 256, 256, NSUB / 256, 1, 64, (size_t)NSUB * 512, 65536), e); }
            __syncthreads();
            lru_items<0>(p, shm, l);
            attn_items(p, shm);
        } break;
        case 6:
            lru_carry(p); s5_bscan(p, shm); attn_combine(p);
            break;
        case 7: {
            { EpiY e; e.Y1 = Y1; gemm_phase(lds, mk_gemm(A2, 512, (const bf16_t*)(ws + SM_Y), 512, 512, NSUB / 256, 1, 64, (size_t)NSUB * 512, 131072), e); }
            __syncthreads();
            lru_items<1>(p, shm, l);
        } break;
        case 8: {
            EpiGlu e; e.Y1 = Y1; e.O = YS5; e.bias = p.in[20] + l * 1024; gemm_phase(lds, mk_gemm(Y1, 1024, W + W_GLU, 1024, 1024, MT / 256, 4), e);
        } break;
        case 9: {
            { EpiMerge<true> e; e.Gt = (const bf16_t*)(ws + B_GA); e.Mo = Mb; gemm_phase(lds, mk_gemm((const bf16_t*)(ws + B_GL), 1024, W + W_BRL, 1024, 1024, MT / 256, 8), e); }
            { EpiMerge<false> e; e.Gt = (const bf16_t*)(ws + B_GB); e.Mo = Mb; gemm_phase(lds, mk_gemm(YS5, 1024, W + W_BRS, 1024, 1024, MT / 256, 8), e); }
            { EpiMerge<false> e; e.Gt = (const bf16_t*)(ws + B_GC); e.Mo = Mb; gemm_phase(lds, mk_gemm((const bf16_t*)(ws + B_YATT), 512, W + W_BRA, 512, 512, MT / 256, 8), e); }
        } break;
        case 10: {
            EpiBf16 e; e.O = Y; e.ldc = DM; gemm_phase(lds, mk_gemm(Mb, DM, W + W_OUT, DM, DM, MT / 256, 8), e);
        } break;
        case 11:
            cvt_ffn(p, shm, l, 1);
            norm_rows(p, false, Y, 1.0f, gl_ + 3 * DM, gl_ + 4 * DM, H);
            break;
        default:
            if (l == 0) { cvt_ffn(p, shm, 1, 0); s5_stage1(p, 1); }
            norm_rows(p, false, Y, 0.5f, gl_ + 5 * DM, l == 0 ? ng + 6 * DM : nullptr, H);
            break;
        }
        if (ph + 1 < p.ph_hi) grid.sync();
    }
}
constexpr int N_PHASES = 1 + 2 * 14;

extern "C" void kernel_launch(void* const* d_in, const int* in_sizes, int n_in, void* d_out, int out_size, void* d_ws, size_t ws_size, hipStream_t stream) {
    static int grid = 0;
    if (grid == 0) {
        if (n_in != 29 || ws_size < WS_END) { fprintf(stderr, "kernel_launch: need 29 inputs and %zu bytes of workspace (got %d, %zu)\n", (size_t)WS_END, n_in, ws_size); grid = -1; return; }
        if (hipFuncSetAttribute((const void*)mega, hipFuncAttributeMaxDynamicSharedMemorySize, LDS_BYTES) != hipSuccess) { fprintf(stderr, "hipFuncSetAttribute failed\n"); grid = -1; return; }
        int dev = 0, cus = 0, per_cu = 0;
        (void)hipGetDevice(&dev); (void)hipDeviceGetAttribute(&cus, hipDeviceAttributeMultiprocessorCount, dev);
        (void)hipOccupancyMaxActiveBlocksPerMultiprocessor(&per_cu, (const void*)mega, 512, LDS_BYTES);
        if (per_cu < 1) per_cu = 1;
        (void)hipGetLastError();
        grid = cus * 1;
    }
    if (grid < 0) return;
    Params p{};
    for (int i = 0; i < 29; ++i) p.in[i] = (const float*)d_in[i];
    p.out = (float*)d_out; p.ws = (unsigned char*)d_ws;
#if ONE_LAUNCH
    p.ph_lo = 0; p.ph_hi = N_PHASES;
    void* args[] = {&p};
    hipError_t e = hipLaunchCooperativeKernel((void*)mega, dim3(grid), dim3(512), args, LDS_BYTES, stream);
    if (e != hipSuccess) fprintf(stderr, "cooperative launch failed: %s (grid %d)\n", hipGetErrorString(e), grid);
#else
    for (int ph = 0; ph < N_PHASES; ++ph) { p.ph_lo = ph; p.ph_hi = ph + 1; hipLaunchKernelGGL(mega, dim3(grid), dim3(512), LDS_BYTES, stream, p); }
#endif
}
```

```cpp
#include <hip/hip_runtime.h>
#include <hip/hip_cooperative_groups.h>
#include <cstdio>
namespace cg = cooperative_groups;

#ifndef PROBE2
#define PROBE2 0
#endif
#define PREP(bit) for (int _r = 0; _r < (((PROBE2 >> (bit)) & 1) ? 2 : 1); ++_r)
#ifndef ONE_LAUNCH
#define ONE_LAUNCH 1
#endif

#define LAS __attribute__((address_space(3)))
typedef unsigned short bf16_t;
typedef short bf16x8 __attribute__((ext_vector_type(8)));
typedef float f32x4 __attribute__((ext_vector_type(4)));
typedef unsigned u32x4 __attribute__((ext_vector_type(4)));
typedef unsigned u32x2 __attribute__((ext_vector_type(2)));

constexpr int DM = 2048, MT = 24576, DFF = 5632, NSUB = MT / 16, NCHK = MT / 64;
constexpr float RMS_EPS = 1e-6f;
constexpr int LDS_BYTES = 147456;

constexpr size_t MiB = (size_t)1 << 20;
constexpr size_t SM_G = 0, SM_Y = 8 * MiB, SM_APOW = 24 * MiB, SM_BBAR = 26 * MiB, SM_KD = 27 * MiB, SM_LWT = 29 * MiB,
                 SM_SA = 30 * MiB, SM_SH = 33 * MiB, SM_CIN = 36 * MiB, SM_LSE = 39 * MiB, SM_RS = 41 * MiB + 512 * 1024, SM_BAR = 41 * MiB + 768 * 1024;
constexpr size_t WS_W = 42 * MiB, WS_H = 116 * MiB, WS_BIG = 212 * MiB, WS_END = 908 * MiB;
constexpr size_t B_XL = WS_BIG, B_GL = WS_BIG + 48 * MiB, B_A2 = WS_BIG + 96 * MiB, B_Q = WS_BIG + 192 * MiB, B_K = WS_BIG + 264 * MiB,
                 B_V = WS_BIG + 336 * MiB, B_GA = WS_BIG + 408 * MiB, B_GB = WS_BIG + 504 * MiB, B_GC = WS_BIG + 600 * MiB;
constexpr size_t B_HID = WS_BIG, B_Y = B_GA, B_Y1 = B_K, B_YATT = B_K + 48 * MiB, B_M = B_A2;
constexpr size_t O_S = 0, O_YS5 = 96 * MiB;
constexpr size_t W_13 = 0, W_2 = (size_t)11264 * 2048;
constexpr size_t W_IN = 0, W_GLU = 28311552, W_BRL = 29360128, W_BRS = 31457280, W_BRA = 33554432, W_OUT = 34603008;

struct Params { const float* in[29]; float* out; unsigned char* ws; int ph_lo, ph_hi; };

__device__ const unsigned char BUCKET[3][132] = {
 {11,11,11,11,11,11,11,11,11,11,11,11,11,11,11,10,10,10,10,10,10,10,10,10,10,10,10,10,10,10,10,10,10,10,10,10,10,10,9,9,9,9,9,9,9,9,9,9,9,9,8,8,8,8,8,8,8,7,6,5,4,3,2,1,0,17,18,19,20,21,22,23,24,24,24,24,24,24,24,25,25,25,25,25,25,25,25,25,25,25,25,26,26,26,26,26,26,26,26,26,26,26,26,26,26,26,26,26,26,26,26,26,26,26,27,27,27,27,27,27,27,27,27,27,27,27,27,27,27,0,0,0},
 {13,13,13,13,13,13,13,13,13,13,13,13,13,13,13,13,13,13,13,13,13,13,13,12,12,12,12,12,12,12,12,12,12,12,12,12,12,12,12,12,12,12,11,11,11,11,11,11,11,11,11,11,10,10,10,10,10,10,9,9,9,8,8,4,0,20,24,24,25,25,25,26,26,26,26,26,26,27,27,27,27,27,27,27,27,27,27,28,28,28,28,28,28,28,28,28,28,28,28,28,28,28,28,28,28,28,29,29,29,29,29,29,29,29,29,29,29,29,29,29,29,29,29,29,29,29,29,29,29,0,0,0},
 {15,15,15,15,15,15,15,15,15,15,15,15,15,15,15,15,15,15,15,15,15,15,15,15,15,15,15,15,15,15,14,14,14,14,14,14,14,14,14,14,14,14,14,14,14,13,13,13,13,13,13,13,13,13,12,12,12,12,12,11,11,10,10,9,0,25,26,26,27,27,28,28,28,28,28,29,29,29,29,29,29,29,29,29,30,30,30,30,30,30,30,30,30,30,30,30,30,30,30,31,31,31,31,31,31,31,31,31,31,31,31,31,31,31,31,31,31,31,31,31,31,31,31,31,31,31,31,31,31,0,0,0}};

__device__ __forceinline__ unsigned cvt_pk_bf16(float lo, float hi) { unsigned r; asm("v_cvt_pk_bf16_f32 %0, %1, %2" : "=v"(r) : "v"(lo), "v"(hi)); return r; }
__device__ __forceinline__ bf16_t f2bf(float f) { return (bf16_t)(cvt_pk_bf16(f, 0.f) & 0xffffu); }
__device__ __forceinline__ float bf2f(bf16_t b) { return __uint_as_float(((unsigned)b) << 16); }
__device__ __forceinline__ float bflo(unsigned w) { return __uint_as_float(w << 16); }
__device__ __forceinline__ float bfhi(unsigned w) { return __uint_as_float(w & 0xffff0000u); }
__device__ __forceinline__ float sigm(float x) { return __builtin_amdgcn_rcpf(1.0f + __expf(-x)); }
__device__ __forceinline__ float silu(float x) { return x * sigm(x); }
__device__ __forceinline__ float gelu_t(float x) { return x * sigm(1.5957691216057308f * (x + 0.044715f * x * x * x)); }
__device__ __forceinline__ float wave_sum(float v) {
#pragma unroll
    for (int o = 32; o >= 1; o >>= 1) v += __shfl_xor(v, o);
    return v;
}

__device__ __forceinline__ int ltid() { int t = threadIdx.x; asm volatile("" : "+v"(t)); return t; }
__device__ __forceinline__ int lbid() { int b = blockIdx.x; asm volatile("" : "+s"(b)); return b; }

constexpr int BM = 256, BK = 64, HALF = 128, HTB = HALF * BK * 2, NXCD = 8, WGM = 8;
__device__ __forceinline__ int lds_byte(int r, int c) { const int st = (r >> 4) * 2 + (c >> 5), rr = r & 15, cc = c & 31, ob = rr * 64 + cc * 2; return st * 1024 + (ob ^ (((ob >> 9) & 1) << 5)); }
__device__ __forceinline__ void stage_rc(int b, int& R, int& C) { const int st = b / 1024, sb = b % 1024, swz = sb ^ (((sb >> 9) & 1) << 5); R = (st >> 1) * 16 + swz / 64; C = (st & 1) * 32 + (swz % 64) / 2; }
__device__ __forceinline__ int perm32(int rho) { const int n = rho >> 4, i = rho & 15; return 8 * (i >> 2) + 4 * n + (i & 3); }

struct Unit { int pm, pn, b; };
struct Gemm { const bf16_t* A; const bf16_t* Bt; int lda, ldb, K, nM, nN, nb; size_t sA, sB; };
struct Order {
    int nM, nN, nwg, tot, G, c, nb;
    __device__ void init(const Gemm& g, int G_, int c_) { nM = g.nM; nN = g.nN; nwg = nM * nN; nb = g.nb; tot = nwg * nb; G = G_; c = c_; }
    __device__ bool next(int i, Unit& u) const {
        const long L = (long)i * G + c; if (L >= tot) return false;
        if (nb > 1) { const int b = (int)(L / nwg), rem = (int)(L % nwg); u.b = b; u.pm = rem % nM; u.pn = rem / nM; return true; }
        int wgid = (int)L; { const int q = nwg / NXCD, r = nwg % NXCD, xcd = wgid % NXCD, off = wgid / NXCD; wgid = (xcd < r ? xcd * (q + 1) : r * (q + 1) + (xcd - r) * q) + off; }
        const int nig = WGM * nN, gid = wgid / nig, fm = gid * WGM, gsz = (nM - fm) < WGM ? (nM - fm) : WGM;
        u.pm = fm + ((wgid % nig) % gsz); u.pn = (wgid % nig) / gsz; u.b = 0; return true;
    }
};

template <class Epi>
__device__ __forceinline__ void gemm_phase(LAS unsigned char* lds, const Gemm g, const Epi& E) {
    Order S; S.init(g, (int)gridDim.x, lbid());
    const int tid = ltid(), wid = __builtin_amdgcn_readfirstlane(tid >> 6), lane = tid & 63, wr = wid >> 2, wc = wid & 3, fr = lane & 15, fq = lane >> 4;
    const int K = g.K, nt = K / BK;
    unsigned voffA[2], voffB[2];
#pragma unroll
    for (int i = 0; i < 2; ++i) { int R, C; stage_rc(tid * 16 + i * 8192, R, C); const int Rb = Epi::PERM ? ((R & ~31) + perm32(R & 31)) : R;
        voffA[i] = (unsigned)(R * g.lda + C) * 2u; voffB[i] = (unsigned)(Rb * g.ldb + C) * 2u; }
    const size_t kstep = (size_t)(BK * 2);
    const size_t hstepA = (size_t)HALF * g.lda * 2, hstepB = (size_t)HALF * g.ldb * 2;
    const size_t tstepA = 2 * hstepA, tstepB = 2 * hstepB;
    const unsigned ldsw = (unsigned)wid * 1024u;
    const int aoff = lds_byte(wr * 64 + fr, fq * 8), boff = lds_byte(wc * 32 + fr, fq * 8);
#define PG8_SA(b, h) (((b) * 2 + (h)) * HTB)
#define PG8_SB(b, h) ((4 + (b) * 2 + (h)) * HTB)
#define PG8_STAGE(bufoff, gbase, voff) do { _Pragma("unroll") for (int _i = 0; _i < 2; ++_i) \
        __builtin_amdgcn_global_load_lds((const unsigned*)((const char*)(gbase) + (voff)[_i]), (LAS unsigned*)(lds + (bufoff) + ldsw + _i * 8192), 16, 0, 0); } while (0)
#define PG8_LDA(dst, b, h) do { _Pragma("unroll") for (int m = 0; m < 4; ++m) _Pragma("unroll") for (int k = 0; k < 2; ++k) dst[m][k] = *(const LAS bf16x8*)(lds + PG8_SA(b, h) + aoff + m * 2048 + k * 1024); } while (0)
#define PG8_LDB(dst, b, h) do { _Pragma("unroll") for (int n = 0; n < 2; ++n) _Pragma("unroll") for (int k = 0; k < 2; ++k) dst[n][k] = *(const LAS bf16x8*)(lds + PG8_SB(b, h) + boff + n * 2048 + k * 1024); } while (0)
#define PG8_MMA(ai, bj, At, Bt) do { __builtin_amdgcn_s_setprio(1); _Pragma("unroll") for (int m = 0; m < 4; ++m) _Pragma("unroll") for (int n = 0; n < 2; ++n) _Pragma("unroll") for (int k = 0; k < 2; ++k) \
        acc[ai][bj][m][n] = __builtin_amdgcn_mfma_f32_16x16x32_bf16(Bt[n][k], At[m][k], acc[ai][bj][m][n], 0, 0, 0); __builtin_amdgcn_s_setprio(0); } while (0)
#define PG8_WAIT_V(n) asm volatile("s_waitcnt vmcnt(" #n ")" ::: "memory")
#define PG8_WAIT_L(n) asm volatile("s_waitcnt lgkmcnt(" #n ")" ::: "memory")
#define PG8_BAR __builtin_amdgcn_s_barrier()
#define PG8_SCHED __builtin_amdgcn_sched_barrier(0)
    Unit cur, nxt; int ui = 0;
    if (!S.next(0, cur)) return;
    f32x4 acc[2][2][4][2];
#pragma unroll
    for (int a = 0; a < 2; ++a)
#pragma unroll
        for (int b = 0; b < 2; ++b)
#pragma unroll
            for (int m = 0; m < 4; ++m)
#pragma unroll
                for (int n = 0; n < 2; ++n) acc[a][b][m][n] = (f32x4){0.f, 0.f, 0.f, 0.f};
    bf16x8 At[4][2], B0[2][2], B1[2][2];
    const char* cA = (const char*)(g.A + (size_t)cur.b * g.sA) + (size_t)cur.pm * tstepA; const char* cB = (const char*)(g.Bt + (size_t)cur.b * g.sB) + (size_t)cur.pn * tstepB;
    PG8_STAGE(PG8_SB(0, 0), cB, voffB); PG8_STAGE(PG8_SA(0, 0), cA, voffA); PG8_STAGE(PG8_SB(0, 1), cB + hstepB, voffB); PG8_STAGE(PG8_SA(0, 1), cA + hstepA, voffA);
    if (wr == 1) PG8_BAR;
    PG8_WAIT_V(4); PG8_BAR;
    PG8_STAGE(PG8_SB(1, 0), cB + kstep, voffB); PG8_STAGE(PG8_SA(1, 0), cA + kstep, voffA); PG8_STAGE(PG8_SB(1, 1), cB + hstepB + kstep, voffB);
    PG8_WAIT_V(6); PG8_BAR;
    for (;;) {
        const bool has_next = S.next(ui + 1, nxt);
        const char* nA = has_next ? (const char*)(g.A + (size_t)nxt.b * g.sA) + (size_t)nxt.pm * tstepA : cA; const char* nB = has_next ? (const char*)(g.Bt + (size_t)nxt.b * g.sB) + (size_t)nxt.pn * tstepB : cB;
        for (int t = 0; t < nt; t += 2) {
            const bool last = (t == nt - 2);
            const char* a1 = cA + (size_t)(t + 1) * kstep;
            const char* a2 = last ? nA : cA + (size_t)(t + 2) * kstep; const char* b2 = last ? nB : cB + (size_t)(t + 2) * kstep;
            const char* a3 = a2 + kstep; const char* b3 = b2 + kstep;
            PG8_LDB(B0, 0, 0); PG8_SCHED; PG8_LDA(At, 0, 0); PG8_STAGE(PG8_SA(1, 1), a1 + hstepA, voffA);
            PG8_WAIT_L(8); PG8_BAR; PG8_WAIT_L(0); PG8_MMA(0, 0, At, B0); PG8_BAR; PG8_SCHED;
            PG8_LDB(B1, 0, 1); PG8_STAGE(PG8_SB(0, 0), b2, voffB);
            PG8_BAR; PG8_WAIT_L(0); PG8_MMA(0, 1, At, B1); PG8_BAR;
            PG8_LDA(At, 0, 1); PG8_STAGE(PG8_SA(0, 0), a2, voffA);
            PG8_BAR; PG8_WAIT_L(0); PG8_MMA(1, 0, At, B0); PG8_BAR; PG8_SCHED;
            PG8_STAGE(PG8_SB(0, 1), b2 + hstepB, voffB);
            PG8_WAIT_V(6); PG8_BAR; PG8_MMA(1, 1, At, B1); PG8_BAR;
            PG8_LDB(B0, 1, 0); PG8_SCHED; PG8_LDA(At, 1, 0); PG8_STAGE(PG8_SA(0, 1), a2 + hstepA, voffA);
            PG8_WAIT_L(8); PG8_BAR; PG8_WAIT_L(0); PG8_MMA(0, 0, At, B0); PG8_BAR; PG8_SCHED;
            PG8_LDB(B1, 1, 1); PG8_STAGE(PG8_SB(1, 0), b3, voffB);
            PG8_BAR; PG8_WAIT_L(0); PG8_MMA(0, 1, At, B1); PG8_BAR;
            PG8_LDA(At, 1, 1); PG8_STAGE(PG8_SA(1, 0), a3, voffA);
            PG8_BAR; PG8_WAIT_L(0); PG8_MMA(1, 0, At, B0); PG8_BAR; PG8_SCHED;
            PG8_STAGE(PG8_SB(1, 1), b3 + hstepB, voffB);
            PG8_WAIT_V(6); PG8_BAR; PG8_MMA(1, 1, At, B1); PG8_BAR;
        }
        E(acc, cur, wr, wc, fr, fq);
        if (!has_next) break;
#pragma unroll
        for (int a = 0; a < 2; ++a)
#pragma unroll
            for (int b = 0; b < 2; ++b)
#pragma unroll
                for (int m = 0; m < 4; ++m)
#pragma unroll
                    for (int n = 0; n < 2; ++n) acc[a][b][m][n] = (f32x4){0.f, 0.f, 0.f, 0.f};
        cur = nxt; cA = nA; cB = nB; ++ui;
    }
    PG8_WAIT_V(0);
    if (wr == 0) PG8_BAR;
    PG8_BAR;
#undef PG8_SA
#undef PG8_SB
#undef PG8_STAGE
#undef PG8_LDA
#undef PG8_LDB
#undef PG8_MMA
#undef PG8_WAIT_V
#undef PG8_WAIT_L
#undef PG8_BAR
#undef PG8_SCHED
}

typedef const f32x4 (&AccRef)[2][2][4][2];
__device__ __forceinline__ u32x4 pack8(f32x4 v0, f32x4 v1) { u32x4 w; w.x = cvt_pk_bf16(v0[0], v0[1]); w.y = cvt_pk_bf16(v0[2], v0[3]); w.z = cvt_pk_bf16(v1[0], v1[1]); w.w = cvt_pk_bf16(v1[2], v1[3]); return w; }
__device__ __forceinline__ void unpack8(u32x4 w, f32x4& v0, f32x4& v1) { v0 = (f32x4){bflo(w.x), bfhi(w.x), bflo(w.y), bfhi(w.y)}; v1 = (f32x4){bflo(w.z), bfhi(w.z), bflo(w.w), bfhi(w.w)}; }

struct EpiSwiglu {
    static constexpr bool PERM = true; bf16_t* O; const float* rs;
    __device__ __forceinline__ void operator()(AccRef acc, const Unit& u, int wr, int wc, int fr, int fq) const {
        const int row0 = u.pm * BM + wr * 64 + fr, col = u.pn * 128 + wc * 32 + 8 * fq;
#pragma unroll
        for (int ai = 0; ai < 2; ++ai)
#pragma unroll
            for (int m = 0; m < 4; ++m) {
                f32x4 v0, v1; const float r = rs[row0 + ai * HALF + m * 16];
#pragma unroll
                for (int j = 0; j < 4; ++j) { v0[j] = silu(acc[ai][0][m][0][j] * r) * (acc[ai][1][m][0][j] * r); v1[j] = silu(acc[ai][0][m][1][j] * r) * (acc[ai][1][m][1][j] * r); }
                *(u32x4*)(O + (size_t)(row0 + ai * HALF + m * 16) * DFF + col) = pack8(v0, v1);
            }
    }
};
struct EpiBf16 {
    static constexpr bool PERM = true; bf16_t* O; int ldc;
    __device__ __forceinline__ void operator()(AccRef acc, const Unit& u, int wr, int wc, int fr, int fq) const {
        const int row0 = u.pm * BM + wr * 64 + fr, col0 = u.pn * BM + wc * 32 + 8 * fq;
#pragma unroll
        for (int ai = 0; ai < 2; ++ai)
#pragma unroll
            for (int m = 0; m < 4; ++m)
#pragma unroll
                for (int bj = 0; bj < 2; ++bj)
                    *(u32x4*)(O + (size_t)(row0 + ai * HALF + m * 16) * ldc + col0 + bj * HALF) = pack8(acc[ai][bj][m][0], acc[ai][bj][m][1]);
    }
};
struct EpiWin {
    static constexpr bool PERM = true; unsigned char* ws; const float* rs;
    __device__ __forceinline__ void operator()(AccRef acc, const Unit& u, int wr, int wc, int fr, int fq) const {
        const int pn = u.pn; int act, ld, cb; size_t base;
        if (pn < 4) { act = 0; ld = 1024; cb = pn * 256; base = B_XL; }
        else if (pn < 8) { act = 1; ld = 1024; cb = (pn - 4) * 256; base = B_GL; }
        else if (pn < 12) { act = 2; ld = 0; cb = (pn - 8) * 256; base = B_A2; }
        else if (pn < 18) { act = 3; ld = 1536; cb = (pn - 12) * 256; base = B_Q; }
        else if (pn < 24) { act = 0; ld = 1536; cb = (pn - 18) * 256; base = B_K; }
        else if (pn < 30) { act = 0; ld = 1536; cb = (pn - 24) * 256; base = B_V; }
        else if (pn < 38) { act = 4; ld = 2048; cb = (pn - 30) * 256; base = B_GA; }
        else if (pn < 46) { act = 4; ld = 2048; cb = (pn - 38) * 256; base = B_GB; }
        else { act = 4; ld = 2048; cb = (pn - 46) * 256; base = B_GC; }
        bf16_t* O = (bf16_t*)(ws + base);
        const int row0 = u.pm * BM + wr * 64 + fr, col0 = cb + wc * 32 + 8 * fq;
#pragma unroll
        for (int ai = 0; ai < 2; ++ai)
#pragma unroll
            for (int m = 0; m < 4; ++m)
#pragma unroll
                for (int bj = 0; bj < 2; ++bj) {
                    const int row = row0 + ai * HALF + m * 16, col = col0 + bj * HALF;
                    const float r = rs[row]; f32x4 v0 = acc[ai][bj][m][0] * r, v1 = acc[ai][bj][m][1] * r;
                    if (act == 1) {
#pragma unroll
                        for (int j = 0; j < 4; ++j) { v0[j] = gelu_t(v0[j]); v1[j] = gelu_t(v1[j]); } }
                    else if (act == 3) { v0 *= 0.125f; v1 *= 0.125f; }
                    else if (act == 4) {
#pragma unroll
                        for (int j = 0; j < 4; ++j) { v0[j] = sigm(v0[j]); v1[j] = sigm(v1[j]); } }
                    size_t off;
                    if (act == 2) off = ((size_t)(col >> 4) * NSUB + (row >> 4)) * 512 + (row & 15) * 16 + (col & 15);
                    else off = (size_t)row * ld + col;
                    *(u32x4*)(O + off) = pack8(v0, v1);
                }
    }
};
struct EpiS {
    static constexpr bool PERM = false; float* S;
    __device__ __forceinline__ void operator()(AccRef acc, const Unit& u, int wr, int wc, int fr, int fq) const {
        const int row0 = u.pm * BM + wr * 64 + fr, col0 = wc * 32 + 4 * fq;
        float* base = S + (size_t)u.b * NSUB * 256;
#pragma unroll
        for (int ai = 0; ai < 2; ++ai)
#pragma unroll
            for (int m = 0; m < 4; ++m)
#pragma unroll
                for (int bj = 0; bj < 2; ++bj)
#pragma unroll
                    for (int n = 0; n < 2; ++n)
                        *(f32x4*)(base + (size_t)(row0 + ai * HALF + m * 16) * 256 + col0 + bj * HALF + n * 16) = acc[ai][bj][m][n];
    }
};
struct EpiY {
    static constexpr bool PERM = true; bf16_t* Y1;
    __device__ __forceinline__ void operator()(AccRef acc, const Unit& u, int wr, int wc, int fr, int fq) const {
        const int row0 = u.pm * BM + wr * 64 + fr, n0 = wc * 32 + 8 * fq;
#pragma unroll
        for (int ai = 0; ai < 2; ++ai)
#pragma unroll
            for (int m = 0; m < 4; ++m)
#pragma unroll
                for (int bj = 0; bj < 2; ++bj) {
                    const int j = row0 + ai * HALF + m * 16, nn = n0 + bj * HALF, tok = j * 16 + (nn >> 4);
                    f32x4 v0 = acc[ai][bj][m][0], v1 = acc[ai][bj][m][1];
#pragma unroll
                    for (int q = 0; q < 4; ++q) { v0[q] = gelu_t(v0[q]); v1[q] = gelu_t(v1[q]); }
                    *(u32x4*)(Y1 + (size_t)tok * 1024 + u.b * 16 + (nn & 15)) = pack8(v0, v1);
                }
    }
};
struct EpiGlu {
    static constexpr bool PERM = true; const bf16_t* Y1; bf16_t* O; const float* bias;
    __device__ __forceinline__ void operator()(AccRef acc, const Unit& u, int wr, int wc, int fr, int fq) const {
        const int row0 = u.pm * BM + wr * 64 + fr, col0 = u.pn * BM + wc * 32 + 8 * fq;
#pragma unroll
        for (int bj = 0; bj < 2; ++bj) {
            const int col = col0 + bj * HALF;
            const f32x4 b0 = *(const f32x4*)(bias + col), b1 = *(const f32x4*)(bias + col + 4);
#pragma unroll
            for (int ai = 0; ai < 2; ++ai)
#pragma unroll
                for (int m = 0; m < 4; ++m) {
                    const size_t off = (size_t)(row0 + ai * HALF + m * 16) * 1024 + col;
                    f32x4 y0, y1v; unpack8(*(const u32x4*)(Y1 + off), y0, y1v);
                    f32x4 v0 = acc[ai][bj][m][0] + b0, v1 = acc[ai][bj][m][1] + b1;
#pragma unroll
                    for (int q = 0; q < 4; ++q) { v0[q] = y0[q] * sigm(v0[q]); v1[q] = y1v[q] * sigm(v1[q]); }
                    *(u32x4*)(O + off) = pack8(v0, v1);
                }
        }
    }
};
template <bool FIRST> struct EpiMerge {
    static constexpr bool PERM = true; const bf16_t* Gt; bf16_t* Mo;
    __device__ __forceinline__ void operator()(AccRef acc, const Unit& u, int wr, int wc, int fr, int fq) const {
        const int row0 = u.pm * BM + wr * 64 + fr, col0 = u.pn * BM + wc * 32 + 8 * fq;
#pragma unroll
        for (int ai = 0; ai < 2; ++ai)
#pragma unroll
            for (int m = 0; m < 4; ++m)
#pragma unroll
                for (int bj = 0; bj < 2; ++bj) {
                    const size_t off = (size_t)(row0 + ai * HALF + m * 16) * 2048 + col0 + bj * HALF;
                    f32x4 g0, g1; unpack8(*(const u32x4*)(Gt + off), g0, g1);
                    f32x4 v0 = g0 * acc[ai][bj][m][0], v1 = g1 * acc[ai][bj][m][1];
                    if (!FIRST) { f32x4 p0, p1; unpack8(*(const u32x4*)(Mo + off), p0, p1); v0 += p0; v1 += p1; }
                    *(u32x4*)(Mo + off) = pack8(v0, v1);
                }
    }
};

__device__ void cvt_job(unsigned char* shm, const float* src, bf16_t* dst, int K, int N, int mode, const float* kscale = nullptr) {
    bf16_t* T = (bf16_t*)shm;
    const int tid = ltid(), bid = lbid(), nkt = K / 64, nnt = N / 256, tot = nkt * nnt;
    for (int t = bid; t < tot; t += gridDim.x) {
        const int nti = t % nnt, kt = t / nnt;
        { const int k = tid >> 3, n8 = (tid & 7) * 8;
          const float* s = src + (size_t)(kt * 64 + k) * N + nti * 256 + n8; const float ks = kscale ? kscale[kt * 64 + k] : 1.0f;
          f32x4 v[8];
#pragma unroll
          for (int q = 0; q < 4; ++q) { v[2 * q] = *(const f32x4*)(s + q * 64); v[2 * q + 1] = *(const f32x4*)(s + q * 64 + 4); }
#pragma unroll
          for (int q = 0; q < 4; ++q)
#pragma unroll
              for (int j = 0; j < 4; ++j) { T[(q * 64 + n8 + j) * 72 + k] = f2bf(v[2 * q][j] * ks); T[(q * 64 + n8 + 4 + j) * 72 + k] = f2bf(v[2 * q + 1][j] * ks); } }
        __syncthreads();
#pragma unroll
        for (int q = 0; q < 4; ++q) { const int n = q * 64 + (tid >> 3), k8 = (tid & 7) * 8; const int nn = nti * 256 + n;
          const int drow = mode == 0 ? nn : ((nn >> 7) * 256 + (nn & 127) + (mode == 2 ? 128 : 0));
          *(u32x4*)(dst + (size_t)drow * K + kt * 64 + k8) = *(const u32x4*)(T + n * 72 + k8); }
        __syncthreads();
    }
}
__device__ void cvt_ffn(const Params& p, unsigned char* shm, int l, int sub) {
    bf16_t* W = (bf16_t*)(p.ws + WS_W); const size_t wo = (size_t)(l * 2 + sub) * DM * DFF;
    const float* gk = p.in[2] + (l * 6 + (sub ? 4 : 0)) * DM;
    cvt_job(shm, p.in[26] + wo, W + W_13, DM, DFF, 1, gk);
    cvt_job(shm, p.in[27] + wo, W + W_13, DM, DFF, 2, gk);
    cvt_job(shm, p.in[28] + wo, W + W_2, DFF, DM, 0);
}
__device__ void cvt_mixer(const Params& p, unsigned char* shm, int l) {
    bf16_t* W = (bf16_t*)(p.ws + WS_W);
    cvt_job(shm, p.in[3] + (size_t)l * DM * 13824, W + W_IN, DM, 13824, 0, p.in[2] + (l * 6 + 2) * DM);
    cvt_job(shm, p.in[19] + (size_t)l * 1024 * 1024, W + W_GLU, 1024, 1024, 0);
    cvt_job(shm, p.in[22] + (size_t)l * 1024 * DM, W + W_BRL, 1024, DM, 0);
    cvt_job(shm, p.in[23] + (size_t)l * 1024 * DM, W + W_BRS, 1024, DM, 0);
    cvt_job(shm, p.in[24] + (size_t)l * 512 * DM, W + W_BRA, 512, DM, 0);
    cvt_job(shm, p.in[25] + (size_t)l * DM * DM, W + W_OUT, DM, DM, 0);
}

__device__ void norm_rows(const Params& p, int mode, float scale, const float* gpost) {
    const int tid = ltid(), bid = lbid(), lane = tid & 63, wid = tid >> 6;
    bf16_t* X = (bf16_t*)(p.ws + WS_H); const bf16_t* Y = (const bf16_t*)(p.ws + B_Y); float* RS = (float*)(p.ws + SM_RS);
    for (int row = bid * 8 + wid; row < MT; row += gridDim.x * 8) {
        f32x4 xv[8];
        if (mode == 0) {
            const float* xr = row < 8192 ? p.in[0] + (size_t)row * DM : p.in[1] + (size_t)(row - 8192) * DM;
#pragma unroll
            for (int c = 0; c < 4; ++c) { xv[2 * c] = *(const f32x4*)(xr + (c * 64 + lane) * 8); xv[2 * c + 1] = *(const f32x4*)(xr + (c * 64 + lane) * 8 + 4); }
        } else {
            f32x4 yv[8]; float ss = 0.f;
#pragma unroll
            for (int c = 0; c < 4; ++c) { unpack8(*(const u32x4*)(X + (size_t)row * DM + (c * 64 + lane) * 8), xv[2 * c], xv[2 * c + 1]); unpack8(*(const u32x4*)(Y + (size_t)row * DM + (c * 64 + lane) * 8), yv[2 * c], yv[2 * c + 1]); }
#pragma unroll
            for (int c = 0; c < 8; ++c) ss += yv[c][0] * yv[c][0] + yv[c][1] * yv[c][1] + yv[c][2] * yv[c][2] + yv[c][3] * yv[c][3];
            ss = wave_sum(ss);
            const float rs = rsqrtf(ss * (1.0f / DM) + RMS_EPS) * scale;
#pragma unroll
            for (int c = 0; c < 4; ++c) { const f32x4 g0 = *(const f32x4*)(gpost + (c * 64 + lane) * 8), g1 = *(const f32x4*)(gpost + (c * 64 + lane) * 8 + 4);
                xv[2 * c] += yv[2 * c] * g0 * rs; xv[2 * c + 1] += yv[2 * c + 1] * g1 * rs; }
        }
        if (mode == 2) {
#pragma unroll
            for (int c = 0; c < 4; ++c) { *(f32x4*)(p.out + (size_t)row * DM + (c * 64 + lane) * 8) = xv[2 * c]; *(f32x4*)(p.out + (size_t)row * DM + (c * 64 + lane) * 8 + 4) = xv[2 * c + 1]; }
        } else {
            float ss = 0.f;
#pragma unroll
            for (int c = 0; c < 8; ++c) ss += xv[c][0] * xv[c][0] + xv[c][1] * xv[c][1] + xv[c][2] * xv[c][2] + xv[c][3] * xv[c][3];
            ss = wave_sum(ss);
#pragma unroll
            for (int c = 0; c < 4; ++c) *(u32x4*)(X + (size_t)row * DM + (c * 64 + lane) * 8) = pack8(xv[2 * c], xv[2 * c + 1]);
            if (lane == 0) RS[row] = rsqrtf(ss * (1.0f / DM) + RMS_EPS);
        }
    }
}

__device__ void s5_stage1(const Params& p, int l) {
    float2* Apow = (float2*)(p.ws + SM_APOW); float2* Bbar = (float2*)(p.ws + SM_BBAR);
    for (int idx = lbid() * 512 + ltid(); idx < 8192; idx += gridDim.x * 512) {
        const float lr = p.in[11][l * 8192 + idx], li = p.in[12][l * 8192 + idx], dt = expf(p.in[13][l * 128 + (idx >> 6)]);
        float ar = 1.f, ai = 0.f;
        for (int k = 0; k < 18; ++k) { const float mag = expf((float)k * lr * dt); float s, c; sincosf((float)k * li * dt, &s, &c); Apow[idx * 18 + k] = make_float2(mag * c, mag * s); if (k == 1) { ar = mag * c; ai = mag * s; } }
        const float den = lr * lr + li * li, cr = ((ar - 1.0f) * lr + ai * li) / den, ci = (ai * lr - (ar - 1.0f) * li) / den;
        for (int c = 0; c < 16; ++c) { const float br = p.in[14][(size_t)l * 131072 + idx * 16 + c], bi = p.in[15][(size_t)l * 131072 + idx * 16 + c];
            Bbar[idx * 16 + c] = make_float2(cr * br - ci * bi, cr * bi + ci * br); }
    }
}
__device__ void s5_stage2(const Params& p, int l) {
    const float2* Apow = (const float2*)(p.ws + SM_APOW); const float2* Bbar = (const float2*)(p.ws + SM_BBAR);
    float* Kd = (float*)(p.ws + SM_KD); bf16_t* Gm = (bf16_t*)(p.ws + SM_G); bf16_t* Ym = (bf16_t*)(p.ws + SM_Y); bf16_t* LWT = (bf16_t*)(p.ws + SM_LWT);
    const float* cre = p.in[16] + (size_t)l * 131072; const float* cim = p.in[17] + (size_t)l * 131072;
    const int gs = gridDim.x * 512, t0 = lbid() * 512 + ltid();
    for (int o = t0; o < 524288; o += gs) {
        const int c2 = o & 15, c = (o >> 4) & 15, k = (o >> 8) & 15, dg = o >> 12;
        float acc = 0.f;
        for (int pp = 0; pp < 64; ++pp) { const int sidx = dg * 64 + pp; const float2 A = Apow[sidx * 18 + k], Bb = Bbar[sidx * 16 + c2];
            const float Cr = cre[(dg * 16 + c) * 64 + pp], Ci = cim[(dg * 16 + c) * 64 + pp];
            const float abr = A.x * Bb.x - A.y * Bb.y, abi = A.x * Bb.y + A.y * Bb.x; acc += Cr * abr - Ci * abi; }
        Kd[o] = acc;
    }
    for (int o = t0; o < 64 * 65536; o += gs) {
        const int kk = o & 255, n = (o >> 8) & 255, g = o >> 16;
        { const int d = n >> 7, ri = (n >> 6) & 1, pp = n & 63, s = kk >> 4, c2 = kk & 15, e = d == 0 ? 15 - s : s; const int sidx = (d * 64 + g) * 64 + pp;
          const float2 A = Apow[sidx * 18 + e], Bb = Bbar[sidx * 16 + c2];
          Gm[o] = f2bf(ri ? A.x * Bb.y + A.y * Bb.x : A.x * Bb.x - A.y * Bb.y); }
        { const int tau = n >> 4, c = n & 15, d = kk >> 7, ri = (kk >> 6) & 1, pp = kk & 63, e = d == 0 ? tau + 1 : 16 - tau; const int sidx = (d * 64 + g) * 64 + pp;
          const float2 A = Apow[sidx * 18 + e]; const float Cr = cre[((d * 64 + g) * 16 + c) * 64 + pp], Ci = cim[((d * 64 + g) * 16 + c) * 64 + pp];
          Ym[((size_t)g * 256 + n) * 512 + 256 + kk] = f2bf(ri ? -(Cr * A.y + Ci * A.x) : Cr * A.x - Ci * A.y); }
    }
    for (int o = t0; o < 262144; o += gs) {
        const int i = o & 63, j = (o >> 6) & 63, n = (o >> 12) & 15, gate = (o >> 16) & 1, d = o >> 17;
        const float* src = gate ? p.in[8] : p.in[6];
        LWT[o] = f2bf(src[(size_t)((l * 2 + d) * 16 + n) * 4096 + i * 64 + j]);
    }
}
__device__ void s5_stage3(const Params& p, int l) {
    const float* Kd = (const float*)(p.ws + SM_KD); bf16_t* Ym = (bf16_t*)(p.ws + SM_Y); const float* Dk = p.in[18] + l * 1024;
    for (int o = lbid() * 512 + ltid(); o < 64 * 65536; o += gridDim.x * 512) {
        const int kk = o & 255, n = (o >> 8) & 255, g = o >> 16, s = kk >> 4, c2 = kk & 15, tau = n >> 4, c = n & 15;
        float v = 0.f;
        if (s <= tau) v += Kd[((0 * 64 + g) * 16 + (tau - s)) * 256 + c * 16 + c2];
        if (s >= tau) v += Kd[((1 * 64 + g) * 16 + (s - tau)) * 256 + c * 16 + c2];
        if (s == tau && c == c2) v += Dk[g * 16 + c];
        Ym[((size_t)g * 256 + n) * 512 + kk] = f2bf(v);
    }
}
__device__ void s5_bscan(const Params& p, unsigned char* shm) {
    const float2* Apow = (const float2*)(p.ws + SM_APOW); const float* S = (const float*)((const unsigned char*)p.out + O_S); bf16_t* A2 = (bf16_t*)(p.ws + B_A2);
    float2* Es = (float2*)shm;
    const int tid = ltid();
    for (int it = lbid(); it < 192; it += gridDim.x) {
        const bool lng = it < 128;
        const int pp = tid & 63, g = lng ? it >> 1 : it - 128, d = lng ? (it & 1) : ((tid >> 6) & 1), seg = lng ? tid >> 6 : 0, seq = lng ? 4 : tid >> 7;
        const int j0 = lng ? 512 + seg * 128 : seq * 128;
        const float2 A16 = Apow[((d * 64 + g) * 64 + pp) * 18 + 16];
        const float* Sg = S + (size_t)g * NSUB * 256 + d * 128 + pp; bf16_t* Xg = A2 + (size_t)g * NSUB * 512 + 256 + d * 128 + pp;
        float xr = 0.f, xi = 0.f;
        if (lng) {
            for (int jb = 0; jb < 128; jb += 16) {
                float sr[16], si[16];
#pragma unroll
                for (int u = 0; u < 16; ++u) { const int j = d ? (j0 + 127 - (jb + u)) : (j0 + jb + u); sr[u] = Sg[(size_t)j * 256]; si[u] = Sg[(size_t)j * 256 + 64]; }
#pragma unroll
                for (int u = 0; u < 16; ++u) { const float nr = A16.x * xr - A16.y * xi + sr[u], ni = A16.x * xi + A16.y * xr + si[u]; xr = nr; xi = ni; }
            }
            Es[seg * 64 + pp] = make_float2(xr, xi);
            float2 Ab = A16;
#pragma unroll
            for (int q = 0; q < 7; ++q) Ab = make_float2(Ab.x * Ab.x - Ab.y * Ab.y, 2.0f * Ab.x * Ab.y);
            __syncthreads();
            xr = 0.f; xi = 0.f;
            for (int q = 0; q < 8; ++q) { const int sq = d ? 7 - q : q; const bool use = d ? (sq > seg) : (sq < seg);
                if (use) { const float2 E = Es[sq * 64 + pp]; const float nr = Ab.x * xr - Ab.y * xi + E.x, ni = Ab.x * xi + Ab.y * xr + E.y; xr = nr; xi = ni; } }
        }
        for (int jb = 0; jb < 128; jb += 16) {
            float sr[16], si[16];
#pragma unroll
            for (int u = 0; u < 16; ++u) { const int j = d ? (j0 + 127 - (jb + u)) : (j0 + jb + u); sr[u] = Sg[(size_t)j * 256]; si[u] = Sg[(size_t)j * 256 + 64]; }
#pragma unroll
            for (int u = 0; u < 16; ++u) { const int j = d ? (j0 + 127 - (jb + u)) : (j0 + jb + u);
                Xg[(size_t)j * 512] = f2bf(xr); Xg[(size_t)j * 512 + 64] = f2bf(xi);
                const float nr = A16.x * xr - A16.y * xi + sr[u], ni = A16.x * xi + A16.y * xr + si[u]; xr = nr; xi = ni; }
        }
        __syncthreads();
    }
}

template <int PASS>
__device__ void lru_items(const Params& p, unsigned char* shm, int l) {
    bf16_t* xraw = (bf16_t*)shm;
    float* xcf = (float*)(shm + 8704);
    bf16_t* xcb = (bf16_t*)(shm + 25344);
    bf16_t* wt = (bf16_t*)(shm + 34560);
    float* As = (float*)(shm + 71424);
    float* Bs = (float*)(shm + 104192);
    float* Pq = (float*)(shm + 136960);
    float* Hq = (float*)(shm + 139008);
    const bf16_t* XL = (const bf16_t*)(p.ws + B_XL); bf16_t* GL = (bf16_t*)(p.ws + B_GL); const bf16_t* LWT = (const bf16_t*)(p.ws + SM_LWT);
    float* SA = (float*)(p.ws + SM_SA); float* SH = (float*)(p.ws + SM_SH); const float* CIN = (const float*)(p.ws + SM_CIN);
    const float* cw = p.in[4] + l * 4096; const float* cbias = p.in[5] + l * 1024;
    const int tid = ltid(), lane = tid & 63, w = tid >> 6, fr = lane & 15, fq = lane >> 4;
    for (int it = lbid(); it < NCHK * 16; it += gridDim.x) {
        const int ck = it >> 4, n = it & 15, t0 = ck * 64;
        const int s_start = t0 < 8192 ? (t0 & ~2047) : 8192, s_end = t0 < 8192 ? s_start + 2048 : MT;
        for (int e = tid; e < 67 * 8; e += 512) { const int row = e >> 3, c8 = e & 7, tok = t0 - 2 + row;
            u32x4 v = (u32x4){0u, 0u, 0u, 0u}; if (tok >= s_start && tok < s_end) v = *(const u32x4*)(XL + (size_t)tok * 1024 + n * 64 + c8 * 8);
            *(u32x4*)(xraw + row * 64 + c8 * 8) = v; }
#pragma unroll
        for (int i = 0; i < 4; ++i) { const int e = tid + 512 * i, mtx = e >> 9, rem = e & 511, j = rem >> 3, c8 = rem & 7;
            *(u32x4*)(wt + (mtx * 64 + j) * 72 + c8 * 8) = *(const u32x4*)(LWT + ((size_t)(mtx * 16 + n) * 64 + j) * 64 + c8 * 8); }
        __syncthreads();
        { const int j = tid & 63, ch = n * 64 + j; const float c0 = cw[ch], c1 = cw[1024 + ch], c2 = cw[2048 + ch], c3 = cw[3072 + ch], cb = cbias[ch];
#pragma unroll
          for (int i = 0; i < 8; ++i) { const int t = (tid >> 6) + 8 * i;
              const float v = cb + bf2f(xraw[t * 64 + j]) * c0 + bf2f(xraw[(t + 1) * 64 + j]) * c1 + bf2f(xraw[(t + 2) * 64 + j]) * c2 + bf2f(xraw[(t + 3) * 64 + j]) * c3;
              xcf[t * 65 + j] = v; xcb[t * 72 + j] = f2bf(v); } }
        __syncthreads();
        { const int d = w >> 2, tt = w & 3;
          const bf16x8 a0 = *(const bf16x8*)(xcb + (tt * 16 + fr) * 72 + fq * 8), a1 = *(const bf16x8*)(xcb + (tt * 16 + fr) * 72 + 32 + fq * 8);
#pragma unroll
          for (int jt = 0; jt < 4; ++jt) {
              f32x4 accr = (f32x4){0.f, 0.f, 0.f, 0.f}, acci = (f32x4){0.f, 0.f, 0.f, 0.f};
              const bf16_t* wr_ = wt + ((d * 2 + 0) * 64 + jt * 16 + fr) * 72 + fq * 8; const bf16_t* wi_ = wt + ((d * 2 + 1) * 64 + jt * 16 + fr) * 72 + fq * 8;
              accr = __builtin_amdgcn_mfma_f32_16x16x32_bf16(a0, *(const bf16x8*)wr_, accr, 0, 0, 0);
              accr = __builtin_amdgcn_mfma_f32_16x16x32_bf16(a1, *(const bf16x8*)(wr_ + 32), accr, 0, 0, 0);
              acci = __builtin_amdgcn_mfma_f32_16x16x32_bf16(a0, *(const bf16x8*)wi_, acci, 0, 0, 0);
              acci = __builtin_amdgcn_mfma_f32_16x16x32_bf16(a1, *(const bf16x8*)(wi_ + 32), acci, 0, 0, 0);
              const int j = jt * 16 + fr, ch = n * 64 + j; const int pi = (l * 2 + d) * 1024 + ch;
              const float ba = p.in[7][pi], bx = p.in[9][pi], sp = -8.0f * log1pf(__expf(-p.in[10][pi]));
#pragma unroll
              for (int i = 0; i < 4; ++i) { const int t = tt * 16 + fq * 4 + i;
                  const float r = sigm(accr[i] + ba), ig = sigm(acci[i] + bx), a = __expf(r * sp);
                  As[(d * 64 + t) * 64 + j] = a;
                  Bs[(d * 64 + t) * 64 + j] = sqrtf(fmaxf(1.0f - a * a, 0.f)) * ig * xcf[t * 65 + j]; }
          } }
        __syncthreads();
        {
            const int seg = tid >> 7, d = (tid >> 6) & 1, j = tid & 63, ch = n * 64 + j; const size_t so = (size_t)(ck * 2 + d) * 1024 + ch;
            float h = 0.f, P = 1.f;
#pragma unroll
            for (int s = 0; s < 16; ++s) { const int st = seg * 16 + s, t = d ? 63 - st : st; const float a = As[(d * 64 + t) * 64 + j]; h = a * h + Bs[(d * 64 + t) * 64 + j]; P *= a; }
            Pq[seg * 128 + (tid & 127)] = P; Hq[seg * 128 + (tid & 127)] = h;
            __syncthreads();
            if (PASS == 0) {
                if (tid < 128) { float hh = Hq[tid], PP = Pq[tid];
#pragma unroll
                    for (int q = 1; q < 4; ++q) { const float pq = Pq[q * 128 + tid]; hh = pq * hh + Hq[q * 128 + tid]; PP *= pq; }
                    SA[so] = PP; SH[so] = hh; }
            } else {
                float c = CIN[so];
#pragma unroll
                for (int q = 0; q < 3; ++q) if (q < seg) c = Pq[q * 128 + (tid & 127)] * c + Hq[q * 128 + (tid & 127)];
#pragma unroll
                for (int s = 0; s < 16; ++s) { const int st = seg * 16 + s, t = d ? 63 - st : st; c = As[(d * 64 + t) * 64 + j] * c + Bs[(d * 64 + t) * 64 + j]; Bs[(d * 64 + t) * 64 + j] = c; }
                __syncthreads();
                const int t = tid >> 3, c8 = tid & 7; const size_t go = (size_t)(t0 + t) * 1024 + n * 64 + c8 * 8;
                f32x4 g0, g1; unpack8(*(const u32x4*)(GL + go), g0, g1);
                const f32x4 f0 = *(const f32x4*)(Bs + t * 64 + c8 * 8), f1 = *(const f32x4*)(Bs + t * 64 + c8 * 8 + 4), r0 = *(const f32x4*)(Bs + (64 + t) * 64 + c8 * 8), r1 = *(const f32x4*)(Bs + (64 + t) * 64 + c8 * 8 + 4);
                *(u32x4*)(GL + go) = pack8((f0 + r0) * g0, (f1 + r1) * g1);
            }
        }
        __syncthreads();
    }
}
__device__ void lru_carry(const Params& p) {
    const float* SA = (const float*)(p.ws + SM_SA); const float* SH = (const float*)(p.ws + SM_SH); float* CIN = (float*)(p.ws + SM_CIN);
    const int tid_ = ltid();
    for (int it = lbid(); it < 20; it += gridDim.x) {
        const int c = it * 512 + tid_, ch = c & 1023, d = (c >> 10) & 1, seq = c >> 11;
        const int k0 = seq < 4 ? seq * 32 : 128, nk = seq < 4 ? 32 : 256;
        float carry = 0.f;
        for (int kb = 0; kb < nk; kb += 8) {
            float a[8], h[8];
#pragma unroll
            for (int u = 0; u < 8; ++u) { const int k = d ? (k0 + nk - 1 - (kb + u)) : (k0 + kb + u); a[u] = SA[(size_t)(k * 2 + d) * 1024 + ch]; h[u] = SH[(size_t)(k * 2 + d) * 1024 + ch]; }
#pragma unroll
            for (int u = 0; u < 8; ++u) { const int k = d ? (k0 + nk - 1 - (kb + u)) : (k0 + kb + u); CIN[(size_t)(k * 2 + d) * 1024 + ch] = carry; carry = a[u] * carry + h[u]; }
        }
    }
}

struct AttnGeom { int hd, seq_start, dil, n_lat, r, q0; };
__device__ __forceinline__ AttnGeom attn_geom(int it) {
    AttnGeom G; G.hd = it / 192; const int qt = it % 192;
    int T, lt; if (qt < 64) { G.seq_start = (qt >> 4) * 2048; T = 2048; lt = qt & 15; } else { G.seq_start = 8192; T = 16384; lt = qt - 64; }
    const int g = G.hd >> 3; G.dil = g == 0 ? 1 : (g == 1 ? 4 : 16); G.n_lat = T / G.dil; const int tpr = G.n_lat >> 7; G.r = lt / tpr; G.q0 = (lt % tpr) << 7; return G;
}
__device__ void attn_items(const Params& p, unsigned char* shm) {
    bf16_t* Ks = (bf16_t*)shm;
    bf16_t* Vt = (bf16_t*)(shm + 36864);
    bf16_t* Ps = (bf16_t*)(shm + 77824);
    float* BT = (float*)(shm + 120832);
    bf16_t* Qb = (bf16_t*)(p.ws + B_Q); const bf16_t* Kb = (const bf16_t*)(p.ws + B_K); const bf16_t* Vb = (const bf16_t*)(p.ws + B_V);
    float* LSE = (float*)(p.ws + SM_LSE);
    const int tid = ltid(), lane = tid & 63, w = tid >> 6, fr = lane & 15, fq = lane >> 4, G_ = gridDim.x;
    for (int i = tid; i < 24 * 129; i += 512) { const int hd = i / 129, j = i % 129; BT[hd * 132 + j] = p.in[21][(int)BUCKET[hd >> 3][j] * 24 + hd]; }
    u32x4 kreg[5], vreg[5]; bf16x8 q0r, q1r;
    const int total = 24 * 192;
    int it = lbid();
#define ATT_LOAD(IT) do { const AttnGeom G = attn_geom(IT); \
        _Pragma("unroll") for (int i = 0; i < 5; ++i) { const int e = tid + 512 * i, kk = e >> 3, c8 = e & 7, lat = G.q0 - 64 + kk; const bool ok = e < 2176 && kk < 256 && lat >= 0 && lat < G.n_lat; \
            kreg[i] = (u32x4){0u, 0u, 0u, 0u}; vreg[i] = (u32x4){0u, 0u, 0u, 0u}; \
            if (ok) { const size_t go = (size_t)(G.seq_start + G.r + G.dil * lat) * 1536 + G.hd * 64 + c8 * 8; kreg[i] = *(const u32x4*)(Kb + go); vreg[i] = *(const u32x4*)(Vb + go); } } \
        const size_t qo = (size_t)(G.seq_start + G.r + G.dil * (G.q0 + 16 * w + fr)) * 1536 + G.hd * 64; \
        q0r = *(const bf16x8*)(Qb + qo + fq * 8); q1r = *(const bf16x8*)(Qb + qo + 32 + fq * 8); } while (0)
    if (it < total) ATT_LOAD(it);
    for (; it < total; it += G_) {
        const AttnGeom G = attn_geom(it);
#pragma unroll
        for (int i = 0; i < 5; ++i) { const int e = tid + 512 * i, kk = e >> 3, c8 = e & 7;
            if (e < 2176) {
                if (kk < 256) *(u32x4*)(Ks + kk * 72 + c8 * 8) = kreg[i];
#pragma unroll
                for (int j = 0; j < 8; ++j) Vt[(c8 * 8 + j) * 320 + (kk ^ (c8 << 3))] = (bf16_t)((vreg[i][j >> 1] >> ((j & 1) * 16)) & 0xffffu); } }
        const bf16x8 aq0 = q0r, aq1 = q1r;
        __syncthreads();
        if (it + G_ < total) ATT_LOAD(it + G_);
        const float* bs = BT + G.hd * 132;
        f32x4 s[9];
#pragma unroll
        for (int kt = 0; kt < 9; ++kt) { const bf16_t* kr = Ks + (16 * w + 16 * kt + fr) * 72 + fq * 8;
            f32x4 a = (f32x4){0.f, 0.f, 0.f, 0.f};
            a = __builtin_amdgcn_mfma_f32_16x16x32_bf16(aq0, *(const bf16x8*)kr, a, 0, 0, 0);
            a = __builtin_amdgcn_mfma_f32_16x16x32_bf16(aq1, *(const bf16x8*)(kr + 32), a, 0, 0, 0); s[kt] = a; }
        float mx[4], ls[4];
#pragma unroll
        for (int i = 0; i < 4; ++i) { const int qi = fq * 4 + i; float m = -3.0e38f;
#pragma unroll
            for (int kt = 0; kt < 9; ++kt) { const int rel = 16 * kt + fr - 64 - qi, klat = G.q0 - 64 + 16 * w + 16 * kt + fr;
                const bool ok = rel >= -64 && rel <= 64 && klat >= 0 && klat < G.n_lat; const int bi = min(max(rel + 64, 0), 128);
                const float v = ok ? s[kt][i] + bs[bi] : -1.0e30f; s[kt][i] = v; m = fmaxf(m, v); }
            m = fmaxf(m, __shfl_xor(m, 1)); m = fmaxf(m, __shfl_xor(m, 2)); m = fmaxf(m, __shfl_xor(m, 4)); m = fmaxf(m, __shfl_xor(m, 8));
            float sum = 0.f;
#pragma unroll
            for (int kt = 0; kt < 9; ++kt) { const float pv = __expf(s[kt][i] - m); s[kt][i] = pv; sum += pv; }
            sum += __shfl_xor(sum, 1); sum += __shfl_xor(sum, 2); sum += __shfl_xor(sum, 4); sum += __shfl_xor(sum, 8);
            mx[i] = m; ls[i] = sum; }
        bf16_t* Pw = Ps + w * 16 * 168;
#pragma unroll
        for (int i = 0; i < 4; ++i) {
#pragma unroll
            for (int kt = 0; kt < 9; ++kt) Pw[(fq * 4 + i) * 168 + 16 * kt + fr] = f2bf(s[kt][i]);
            Pw[(fq * 4 + i) * 168 + 144 + fr] = 0; }
        __syncthreads();
        f32x4 o[4];
#pragma unroll
        for (int nt = 0; nt < 4; ++nt) o[nt] = (f32x4){0.f, 0.f, 0.f, 0.f};
#pragma unroll
        for (int ks = 0; ks < 5; ++ks) { const bf16x8 ap = *(const bf16x8*)(Pw + fr * 168 + ks * 32 + fq * 8);
#pragma unroll
            for (int nt = 0; nt < 4; ++nt) { const int dim = nt * 16 + fr; o[nt] = __builtin_amdgcn_mfma_f32_16x16x32_bf16(ap, *(const bf16x8*)(Vt + dim * 320 + ((16 * w + ks * 32 + fq * 8) ^ ((dim >> 3) << 3))), o[nt], 0, 0, 0); } }
        __syncthreads();
#pragma unroll
        for (int i = 0; i < 4; ++i) { const float inv = 1.0f / ls[i];
#pragma unroll
            for (int nt = 0; nt < 4; ++nt) Pw[(fq * 4 + i) * 168 + nt * 16 + fr] = f2bf(o[nt][i] * inv);
            if (fr == 0) LSE[(size_t)(G.seq_start + G.r + G.dil * (G.q0 + 16 * w + fq * 4 + i)) * 24 + G.hd] = mx[i] + __logf(ls[i]); }
        __syncthreads();
#pragma unroll
        for (int h = 0; h < 2; ++h) { const int c = lane + 64 * h, row = c >> 3, c8 = c & 7;
            *(u32x4*)(Qb + (size_t)(G.seq_start + G.r + G.dil * (G.q0 + 16 * w + row)) * 1536 + G.hd * 64 + c8 * 8) = *(const u32x4*)(Pw + row * 168 + c8 * 8); }
        __syncthreads();
    }
#undef ATT_LOAD
}
__device__ void attn_combine(const Params& p) {
    const bf16_t* Ab = (const bf16_t*)(p.ws + B_Q); const float* LSE = (const float*)(p.ws + SM_LSE); bf16_t* YA = (bf16_t*)(p.ws + B_YATT);
    for (int e = lbid() * 512 + ltid(); e < MT * 64; e += gridDim.x * 512) {
        const int tok = e >> 6, h = (e >> 3) & 7, c8 = e & 7;
        const float l0 = LSE[(size_t)tok * 24 + h], l1 = LSE[(size_t)tok * 24 + 8 + h], l2 = LSE[(size_t)tok * 24 + 16 + h];
        const float m = fmaxf(l0, fmaxf(l1, l2)); float w0 = __expf(l0 - m), w1 = __expf(l1 - m), w2 = __expf(l2 - m); const float inv = 1.0f / (w0 + w1 + w2); w0 *= inv; w1 *= inv; w2 *= inv;
        f32x4 a0, a1, b0, b1, c0, c1;
        unpack8(*(const u32x4*)(Ab + (size_t)tok * 1536 + h * 64 + c8 * 8), a0, a1);
        unpack8(*(const u32x4*)(Ab + (size_t)tok * 1536 + (8 + h) * 64 + c8 * 8), b0, b1);
        unpack8(*(const u32x4*)(Ab + (size_t)tok * 1536 + (16 + h) * 64 + c8 * 8), c0, c1);
        *(u32x4*)(YA + (size_t)tok * 512 + h * 64 + c8 * 8) = pack8(a0 * w0 + b0 * w1 + c0 * w2, a1 * w0 + b1 * w1 + c1 * w2);
    }
}


#define XB_TMO      128
#define XB_XCNT(j)  (256  + 64 * (j))
#define XB_XSUB(j)  (1280 + 64 * (j))
#define XB_XGEN(j)  (2304 + 64 * (j))
#define XB_TOP      3328
#define XB_TOPGEN   3392
#define XCD_BAR_WORDS 3456
#define XB_SPIN_CAP (1u << 18)
__device__ __forceinline__ unsigned xb_ld(unsigned* p)              { return __hip_atomic_load(p, __ATOMIC_RELAXED, __HIP_MEMORY_SCOPE_AGENT); }
__device__ __forceinline__ unsigned xb_add(unsigned* p, unsigned v) { return __hip_atomic_fetch_add(p, v, __ATOMIC_RELAXED, __HIP_MEMORY_SCOPE_AGENT); }
__device__ __forceinline__ unsigned xb_xcc_id() { return (unsigned)__builtin_amdgcn_s_getreg((3 << 11) | 20) & 0xFu; }
#define XB_SPIN(cond, bar) do { unsigned _sp = 0; while (cond) { __builtin_amdgcn_s_sleep(1); \
    if ((++_sp & 255u) == 0u) { if (xb_ld(&(bar)[XB_TMO])) break; if (_sp > XB_SPIN_CAP) { atomicAdd(&(bar)[XB_TMO], 1u); break; } } } } while (0)
struct XcdBarrier { unsigned* bar; unsigned x; volatile LAS unsigned* st; };
__device__ __forceinline__ XcdBarrier xcd_barrier_post(unsigned* bar, volatile LAS unsigned* st) {
    XcdBarrier b; b.bar = bar; b.x = xb_xcc_id(); b.st = st;
    if (threadIdx.x == 0) (void)xb_add(&bar[XB_XCNT(b.x)], 1u);
    return b;
}
__device__ __forceinline__ void xcd_barrier_complete(unsigned* bar, unsigned x, unsigned& nloc, unsigned& nx) {
    const unsigned G = gridDim.x * gridDim.y * gridDim.z;
    unsigned sum, cnt, mine, sp = 0u;
    for (;;) {
        sum = 0u; cnt = 0u; mine = 0u;
#pragma unroll
        for (unsigned j = 0; j < 16; ++j) { const unsigned c = xb_ld(&bar[XB_XCNT(j)]); sum += c; cnt += (c > 0u) ? 1u : 0u; mine = (j == x) ? c : mine; }
        if (sum == G) break;
        __builtin_amdgcn_s_sleep(1);
        if ((++sp & 255u) == 0u) { if (xb_ld(&bar[XB_TMO])) break; if (sp > XB_SPIN_CAP) { atomicAdd(&bar[XB_TMO], 1u); break; } }
    }
    nloc = mine > 0u ? mine : 1u; nx = cnt > 0u ? cnt : 1u;
}
__device__ __forceinline__ void xcd_barrier(const XcdBarrier& b) {
    asm volatile("s_waitcnt vmcnt(0)" ::: "memory");
    __syncthreads();
    if (threadIdx.x == 0) {
        unsigned* bar = b.bar;
        __builtin_amdgcn_s_waitcnt(0);
        unsigned nloc = b.st[0], nx = b.st[1];
        if (nloc == 0u) { xcd_barrier_complete(bar, b.x, nloc, nx); b.st[0] = nloc; b.st[1] = nx; }
        const unsigned old = xb_add(&bar[XB_XSUB(b.x)], 1u);
        const unsigned gen = old / nloc;
        if (old + 1u == (gen + 1u) * nloc) {
            __builtin_amdgcn_fence(__ATOMIC_RELEASE, "agent");
            asm volatile("s_waitcnt vmcnt(0)" ::: "memory");
            const unsigned og = xb_add(&bar[XB_TOP], 1u);
            const unsigned tg = og / nx;
            if (og + 1u == (tg + 1u) * nx) xb_add(&bar[XB_TOPGEN], 1u);
            else XB_SPIN(xb_ld(&bar[XB_TOPGEN]) == tg, bar);
            __builtin_amdgcn_fence(__ATOMIC_ACQUIRE, "agent");
            xb_add(&bar[XB_XGEN(b.x)], 1u);
            asm volatile("s_waitcnt vmcnt(0)" ::: "memory");
        } else {
            XB_SPIN(xb_ld(&bar[XB_XGEN(b.x)]) == gen, bar);
            __builtin_amdgcn_fence(__ATOMIC_ACQUIRE, "agent");
            asm volatile("s_waitcnt vmcnt(0)" ::: "memory");
        }
    }
    __syncthreads();
}

__device__ __forceinline__ Gemm mk_gemm(const bf16_t* A, int lda, const bf16_t* Bt, int ldb, int K, int nM, int nN, int nb = 1, size_t sA = 0, size_t sB = 0) {
    Gemm g; g.A = A; g.Bt = Bt; g.lda = lda; g.ldb = ldb; g.K = K; g.nM = nM; g.nN = nN; g.nb = nb; g.sA = sA; g.sB = sB; return g; }

__global__ __launch_bounds__(512, 2) void mega(Params p) {
    extern __shared__ __attribute__((aligned(16))) unsigned char shm[];
    LAS unsigned char* lds = (LAS unsigned char*)shm;
    cg::grid_group grid = cg::this_grid();
    volatile LAS unsigned* xst = (volatile LAS unsigned*)(lds + LDS_BYTES - 16);
    XcdBarrier xb; xb.bar = (unsigned*)(p.ws + SM_BAR); xb.x = 0; xb.st = xst;
    if (p.ph_hi - p.ph_lo > 1) { if (threadIdx.x == 0) { xst[0] = 0u; xst[1] = 0u; } __syncthreads(); xb = xcd_barrier_post((unsigned*)(p.ws + SM_BAR), xst); }
#pragma nounroll
    for (int ph = p.ph_lo; ph < p.ph_hi; ++ph) {
        unsigned char* ws = p.ws; asm volatile("" : "+s"(ws));
        const int l = ph == 0 ? 0 : (ph - 1) / 14, kind = ph == 0 ? 0 : (ph - 1) % 14 + 1;
        bf16_t* W = (bf16_t*)(ws + WS_W); bf16_t* H = (bf16_t*)(ws + WS_H);
        bf16_t* HID = (bf16_t*)(ws + B_HID); bf16_t* Y = (bf16_t*)(ws + B_Y); bf16_t* A2 = (bf16_t*)(ws + B_A2);
        bf16_t* Y1 = (bf16_t*)(ws + B_Y1); bf16_t* Mb = (bf16_t*)(ws + B_M);
        unsigned char* ob = (unsigned char*)p.out; asm volatile("" : "+s"(ob));
        bf16_t* YS5 = (bf16_t*)(ob + O_YS5); const float* RSp = (const float*)(ws + SM_RS);
        const float* ng = p.in[2]; const float* gl_ = ng + l * 6 * DM;
#ifdef PROBE_MASK
        for (int rep = 0, reps = ((PROBE_MASK >> kind) & 1) ? 2 : 1; rep < reps; ++rep)
#endif
        switch (kind) {
        case 0:
            PREP(0) cvt_ffn(p, shm, 0, 0); s5_stage1(p, 0);
            PREP(1) norm_rows(p, 0, 0.f, nullptr);
            break;
        case 1: case 12: {
            EpiSwiglu e; e.O = HID; e.rs = RSp; gemm_phase(lds, mk_gemm(H, DM, W + W_13, DM, DM, MT / 256, 44), e);
        } break;
        case 2: case 13: {
            EpiBf16 e; e.O = Y; e.ldc = DM; gemm_phase(lds, mk_gemm(HID, DFF, W + W_2, DFF, DFF, MT / 256, 8), e);
        } break;
        case 3:
            PREP(0) cvt_mixer(p, shm, l);
            s5_stage2(p, l);
            norm_rows(p, 1, 0.5f, gl_ + 1 * DM);
            if ((PROBE2 >> 1) & 1) norm_rows(p, 1, 0.0f, gl_ + 1 * DM);
            break;
        case 4: {
            EpiWin e; e.ws = ws; e.rs = RSp; gemm_phase(lds, mk_gemm(H, DM, W + W_IN, DM, DM, MT / 256, 54), e);
        } break;
        case 5: {
            PREP(3) { EpiS e; e.S = (float*)(ob + O_S); gemm_phase(lds, mk_gemm(A2, 512, (const bf16_t*)(ws + SM_G), 256, 256, NSUB / 256, 1, 64, (size_t)NSUB * 512, 65536), e); }
            __syncthreads();
            PREP(4) lru_items<0>(p, shm, l);
            attn_items(p, shm);
        } break;
        case 6:
            PREP(5) { lru_carry(p); s5_bscan(p, shm); attn_combine(p); }
            s5_stage3(p, l);
            break;
        case 7: {
            PREP(3) { EpiY e; e.Y1 = Y1; gemm_phase(lds, mk_gemm(A2, 512, (const bf16_t*)(ws + SM_Y), 512, 512, NSUB / 256, 1, 64, (size_t)NSUB * 512, 131072), e); }
            __syncthreads();
            lru_items<1>(p, shm, l);
        } break;
        case 8: {
            EpiGlu e; e.Y1 = Y1; e.O = YS5; e.bias = p.in[20] + l * 1024; gemm_phase(lds, mk_gemm(Y1, 1024, W + W_GLU, 1024, 1024, MT / 256, 4), e);
        } break;
        case 9: {
            { EpiMerge<true> e; e.Gt = (const bf16_t*)(ws + B_GA); e.Mo = Mb; gemm_phase(lds, mk_gemm((const bf16_t*)(ws + B_GL), 1024, W + W_BRL, 1024, 1024, MT / 256, 8), e); }
            { EpiMerge<false> e; e.Gt = (const bf16_t*)(ws + B_GB); e.Mo = Mb; gemm_phase(lds, mk_gemm(YS5, 1024, W + W_BRS, 1024, 1024, MT / 256, 8), e); }
            { EpiMerge<false> e; e.Gt = (const bf16_t*)(ws + B_GC); e.Mo = Mb; gemm_phase(lds, mk_gemm((const bf16_t*)(ws + B_YATT), 512, W + W_BRA, 512, 512, MT / 256, 8), e); }
        } break;
        case 10: {
            EpiBf16 e; e.O = Y; e.ldc = DM; gemm_phase(lds, mk_gemm(Mb, DM, W + W_OUT, DM, DM, MT / 256, 8), e);
        } break;
        case 11:
            PREP(0) cvt_ffn(p, shm, l, 1);
            norm_rows(p, 1, 1.0f, gl_ + 3 * DM);
            if ((PROBE2 >> 1) & 1) norm_rows(p, 1, 0.0f, gl_ + 3 * DM);
            break;
        default:
            if (l == 0) { PREP(0) cvt_ffn(p, shm, 1, 0); s5_stage1(p, 1); }
            norm_rows(p, l == 0 ? 1 : 2, 0.5f, gl_ + 5 * DM);
            break;
        }
        if (ph + 1 < p.ph_hi) { if (ph == p.ph_lo) grid.sync(); else xcd_barrier(xb); }
    }
}
constexpr int N_PHASES = 1 + 2 * 14;

extern "C" void kernel_launch(void* const* d_in, const int* in_sizes, int n_in, void* d_out, int out_size, void* d_ws, size_t ws_size, hipStream_t stream) {
    static int grid = 0;
    if (grid == 0) {
        if (n_in != 29 || ws_size < WS_END) { fprintf(stderr, "kernel_launch: need 29 inputs and %zu bytes of workspace (got %d, %zu)\n", (size_t)WS_END, n_in, ws_size); grid = -1; return; }
        if (hipFuncSetAttribute((const void*)mega, hipFuncAttributeMaxDynamicSharedMemorySize, LDS_BYTES) != hipSuccess) { fprintf(stderr, "hipFuncSetAttribute failed\n"); grid = -1; return; }
        int dev = 0, cus = 0, per_cu = 0;
        (void)hipGetDevice(&dev); (void)hipDeviceGetAttribute(&cus, hipDeviceAttributeMultiprocessorCount, dev);
        (void)hipOccupancyMaxActiveBlocksPerMultiprocessor(&per_cu, (const void*)mega, 512, LDS_BYTES);
        if (per_cu < 1) per_cu = 1;
        (void)hipGetLastError();
        grid = cus * 1;
    }
    if (grid < 0) return;
    Params p{};
    for (int i = 0; i < 29; ++i) p.in[i] = (const float*)d_in[i];
    p.out = (float*)d_out; p.ws = (unsigned char*)d_ws;
#if ONE_LAUNCH
    p.ph_lo = 0; p.ph_hi = N_PHASES;
    if (hipMemsetAsync((char*)d_ws + SM_BAR, 0, XCD_BAR_WORDS * sizeof(unsigned), stream) != hipSuccess) { fprintf(stderr, "memset of the barrier words failed\n"); return; }
    void* args[] = {&p};
    hipError_t e = hipLaunchCooperativeKernel((void*)mega, dim3(grid), dim3(512), args, LDS_BYTES, stream);
    if (e != hipSuccess) fprintf(stderr, "cooperative launch failed: %s (grid %d)\n", hipGetErrorString(e), grid);
#else
    for (int ph = 0; ph < N_PHASES; ++ph) { p.ph_lo = ph; p.ph_hi = ph + 1; hipLaunchKernelGGL(mega, dim3(grid), dim3(512), LDS_BYTES, stream, p); }
#endif
}
```

```cpp
#include <hip/hip_runtime.h>
#include <hip/hip_cooperative_groups.h>
#include <cstdio>
namespace cg = cooperative_groups;

#ifndef PROBE2
#define PROBE2 0
#endif
#define PREP(bit) for (int _r = 0; _r < (((PROBE2 >> (bit)) & 1) ? 2 : 1); ++_r)
#ifndef ONE_LAUNCH
#define ONE_LAUNCH 1
#endif

#define LAS __attribute__((address_space(3)))
typedef unsigned short bf16_t;
typedef short bf16x8 __attribute__((ext_vector_type(8)));
typedef float f32x4 __attribute__((ext_vector_type(4)));
typedef unsigned u32x4 __attribute__((ext_vector_type(4)));
typedef unsigned u32x2 __attribute__((ext_vector_type(2)));

constexpr int DM = 2048, MT = 24576, DFF = 5632, NSUB = MT / 16, NCHK = MT / 64;
constexpr float RMS_EPS = 1e-6f;
constexpr int LDS_BYTES = 147456;
constexpr int LDX = 2048 + 64;

constexpr size_t MiB = (size_t)1 << 20;
constexpr size_t SM_G = 0, SM_Y = 8 * MiB, SM_APOW = 24 * MiB, SM_BBAR = 26 * MiB, SM_KD = 27 * MiB, SM_LWT = 29 * MiB,
                 SM_SA = 30 * MiB, SM_SH = 33 * MiB, SM_CIN = 36 * MiB, SM_LSE = 39 * MiB, SM_RS = 41 * MiB + 512 * 1024, SM_BAR = 41 * MiB + 768 * 1024;
constexpr size_t WS_W = 42 * MiB, WS_H = 122 * MiB, WS_BIG = 222 * MiB, WS_END = 918 * MiB;
constexpr size_t B_XL = WS_BIG, B_GL = WS_BIG + 48 * MiB, B_A2 = WS_BIG + 96 * MiB, B_Q = WS_BIG + 192 * MiB, B_K = WS_BIG + 264 * MiB,
                 B_V = WS_BIG + 336 * MiB, B_GA = WS_BIG + 408 * MiB, B_GB = WS_BIG + 504 * MiB, B_GC = WS_BIG + 600 * MiB;
constexpr size_t B_HID = WS_BIG, B_Y = B_GA, B_Y1 = B_K, B_YATT = B_K + 48 * MiB, B_M = B_A2;
constexpr size_t O_S = 0, O_YS5 = 96 * MiB;
constexpr size_t W_13 = 0, W_2 = (size_t)11264 * LDX;
constexpr size_t W_IN = 0, W_GLU = (size_t)13824 * LDX, W_BRL = W_GLU + 1048576, W_BRS = W_BRL + 2097152, W_BRA = W_BRS + 2097152, W_OUT = W_BRA + 1048576;

struct Params { const float* in[29]; float* out; unsigned char* ws; int ph_lo, ph_hi; };

__device__ const unsigned char BUCKET[3][132] = {
 {11,11,11,11,11,11,11,11,11,11,11,11,11,11,11,10,10,10,10,10,10,10,10,10,10,10,10,10,10,10,10,10,10,10,10,10,10,10,9,9,9,9,9,9,9,9,9,9,9,9,8,8,8,8,8,8,8,7,6,5,4,3,2,1,0,17,18,19,20,21,22,23,24,24,24,24,24,24,24,25,25,25,25,25,25,25,25,25,25,25,25,26,26,26,26,26,26,26,26,26,26,26,26,26,26,26,26,26,26,26,26,26,26,26,27,27,27,27,27,27,27,27,27,27,27,27,27,27,27,0,0,0},
 {13,13,13,13,13,13,13,13,13,13,13,13,13,13,13,13,13,13,13,13,13,13,13,12,12,12,12,12,12,12,12,12,12,12,12,12,12,12,12,12,12,12,11,11,11,11,11,11,11,11,11,11,10,10,10,10,10,10,9,9,9,8,8,4,0,20,24,24,25,25,25,26,26,26,26,26,26,27,27,27,27,27,27,27,27,27,27,28,28,28,28,28,28,28,28,28,28,28,28,28,28,28,28,28,28,28,29,29,29,29,29,29,29,29,29,29,29,29,29,29,29,29,29,29,29,29,29,29,29,0,0,0},
 {15,15,15,15,15,15,15,15,15,15,15,15,15,15,15,15,15,15,15,15,15,15,15,15,15,15,15,15,15,15,14,14,14,14,14,14,14,14,14,14,14,14,14,14,14,13,13,13,13,13,13,13,13,13,12,12,12,12,12,11,11,10,10,9,0,25,26,26,27,27,28,28,28,28,28,29,29,29,29,29,29,29,29,29,30,30,30,30,30,30,30,30,30,30,30,30,30,30,30,31,31,31,31,31,31,31,31,31,31,31,31,31,31,31,31,31,31,31,31,31,31,31,31,31,31,31,31,31,31,0,0,0}};

__device__ __forceinline__ unsigned cvt_pk_bf16(float lo, float hi) { unsigned r; asm("v_cvt_pk_bf16_f32 %0, %1, %2" : "=v"(r) : "v"(lo), "v"(hi)); return r; }
__device__ __forceinline__ bf16_t f2bf(float f) { return (bf16_t)(cvt_pk_bf16(f, 0.f) & 0xffffu); }
__device__ __forceinline__ float bf2f(bf16_t b) { return __uint_as_float(((unsigned)b) << 16); }
__device__ __forceinline__ float bflo(unsigned w) { return __uint_as_float(w << 16); }
__device__ __forceinline__ float bfhi(unsigned w) { return __uint_as_float(w & 0xffff0000u); }
__device__ __forceinline__ float sigm(float x) { return __builtin_amdgcn_rcpf(1.0f + __expf(-x)); }
__device__ __forceinline__ float silu(float x) { return x * sigm(x); }
__device__ __forceinline__ float gelu_t(float x) { return x * sigm(1.5957691216057308f * (x + 0.044715f * x * x * x)); }
__device__ __forceinline__ float wave_sum(float v) {
#pragma unroll
    for (int o = 32; o >= 1; o >>= 1) v += __shfl_xor(v, o);
    return v;
}

__device__ __forceinline__ int ltid() { int t = threadIdx.x; asm volatile("" : "+v"(t)); return t; }
__device__ __forceinline__ int lbid() { int b = blockIdx.x; asm volatile("" : "+s"(b)); return b; }

typedef float f32x2 __attribute__((ext_vector_type(2)));
__device__ __forceinline__ f32x2 exp2_2(f32x2 v) { f32x2 r; r.x = __builtin_amdgcn_exp2f(v.x); r.y = __builtin_amdgcn_exp2f(v.y); return r; }
__device__ __forceinline__ f32x2 rcp_2(f32x2 v) { f32x2 r; r.x = __builtin_amdgcn_rcpf(v.x); r.y = __builtin_amdgcn_rcpf(v.y); return r; }
__device__ __forceinline__ f32x2 swiglu2(f32x2 a, f32x2 b, float rn, float r2) { const f32x2 q = rcp_2(exp2_2(a * rn) + 1.0f); return (a * b) * (q * r2); }
__device__ __forceinline__ f32x2 gelu2(f32x2 v) { const f32x2 z = v * ((v * v) * (-0.10294324f) + (-2.3022082f)); return v * rcp_2(exp2_2(z) + 1.0f); }
__device__ __forceinline__ f32x2 sigm2(f32x2 a, float rn) { return rcp_2(exp2_2(a * rn) + 1.0f); }

constexpr int BM = 256, BK = 64, HALF = 128, HTB = HALF * BK * 2, NXCD = 8, WGM = 8;
__device__ __forceinline__ int lds_byte(int r, int c) { const int st = (r >> 4) * 2 + (c >> 5), rr = r & 15, cc = c & 31, ob = rr * 64 + cc * 2; return st * 1024 + (ob ^ (((ob >> 9) & 1) << 5)); }
__device__ __forceinline__ void stage_rc(int b, int& R, int& C) { const int st = b / 1024, sb = b % 1024, swz = sb ^ (((sb >> 9) & 1) << 5); R = (st >> 1) * 16 + swz / 64; C = (st & 1) * 32 + (swz % 64) / 2; }
__device__ __forceinline__ int perm32(int rho) { const int n = rho >> 4, i = rho & 15; return 8 * (i >> 2) + 4 * n + (i & 3); }

struct Unit { int pm, pn, b; };
struct Gemm { const bf16_t* A; const bf16_t* Bt; int lda, ldb, K, nM, nN, nb; size_t sA, sB; };
struct Order {
    int nM, nN, nwg, tot, G, c, nb;
    __device__ void init(const Gemm& g, int G_, int c_) { nM = g.nM; nN = g.nN; nwg = nM * nN; nb = g.nb; tot = nwg * nb; G = G_; c = c_; }
    __device__ bool next(int i, Unit& u) const {
        const long L = (long)i * G + c; if (L >= tot) return false;
        if (nb > 1) { const int b = (int)(L / nwg), rem = (int)(L % nwg); u.b = b; u.pm = rem % nM; u.pn = rem / nM; return true; }
        int wgid = (int)L; { const int q = nwg / NXCD, r = nwg % NXCD, xcd = wgid % NXCD, off = wgid / NXCD; wgid = (xcd < r ? xcd * (q + 1) : r * (q + 1) + (xcd - r) * q) + off; }
        const int nig = WGM * nN, gid = wgid / nig, fm = gid * WGM, gsz = (nM - fm) < WGM ? (nM - fm) : WGM;
        u.pm = fm + ((wgid % nig) % gsz); u.pn = (wgid % nig) / gsz; u.b = 0; return true;
    }
};

template <class Epi>
__device__ __forceinline__ void gemm_phase(LAS unsigned char* lds, const Gemm g, const Epi& E) {
    Order S; S.init(g, (int)gridDim.x, lbid());
    const int tid = ltid(), wid = __builtin_amdgcn_readfirstlane(tid >> 6), lane = tid & 63, wr = wid >> 2, wc = wid & 3, fr = lane & 15, fq = lane >> 4;
    const int K = g.K, nt = K / BK;
    unsigned voffA[2], voffB[2];
#pragma unroll
    for (int i = 0; i < 2; ++i) { int R, C; stage_rc(tid * 16 + i * 8192, R, C); const int Rb = Epi::PERM ? ((R & ~31) + perm32(R & 31)) : R;
        voffA[i] = (unsigned)(R * g.lda + C) * 2u; voffB[i] = (unsigned)(Rb * g.ldb + C) * 2u; }
    const size_t kstep = (size_t)(BK * 2);
    const size_t hstepA = (size_t)HALF * g.lda * 2, hstepB = (size_t)HALF * g.ldb * 2;
    const size_t tstepA = 2 * hstepA, tstepB = 2 * hstepB;
    const unsigned ldsw = (unsigned)wid * 1024u;
    const int aoff = lds_byte(wr * 64 + fr, fq * 8), boff = lds_byte(wc * 32 + fr, fq * 8);
#define PG8_SA(b, h) (((b) * 2 + (h)) * HTB)
#define PG8_SB(b, h) ((4 + (b) * 2 + (h)) * HTB)
#define PG8_STAGE(bufoff, gbase, voff) do { _Pragma("unroll") for (int _i = 0; _i < 2; ++_i) \
        __builtin_amdgcn_global_load_lds((const unsigned*)((const char*)(gbase) + (voff)[_i]), (LAS unsigned*)(lds + (bufoff) + ldsw + _i * 8192), 16, 0, 0); } while (0)
#define PG8_LDA(dst, b, h) do { _Pragma("unroll") for (int m = 0; m < 4; ++m) _Pragma("unroll") for (int k = 0; k < 2; ++k) dst[m][k] = *(const LAS bf16x8*)(lds + PG8_SA(b, h) + aoff + m * 2048 + k * 1024); } while (0)
#define PG8_LDB(dst, b, h) do { _Pragma("unroll") for (int n = 0; n < 2; ++n) _Pragma("unroll") for (int k = 0; k < 2; ++k) dst[n][k] = *(const LAS bf16x8*)(lds + PG8_SB(b, h) + boff + n * 2048 + k * 1024); } while (0)
#define PG8_MMA(ai, bj, At, Bt) do { __builtin_amdgcn_s_setprio(1); _Pragma("unroll") for (int m = 0; m < 4; ++m) _Pragma("unroll") for (int n = 0; n < 2; ++n) _Pragma("unroll") for (int k = 0; k < 2; ++k) \
        acc[ai][bj][m][n] = __builtin_amdgcn_mfma_f32_16x16x32_bf16(Bt[n][k], At[m][k], acc[ai][bj][m][n], 0, 0, 0); __builtin_amdgcn_s_setprio(0); } while (0)
#define PG8_WAIT_V(n) asm volatile("s_waitcnt vmcnt(" #n ")" ::: "memory")
#define PG8_WAIT_L(n) asm volatile("s_waitcnt lgkmcnt(" #n ")" ::: "memory")
#define PG8_BAR __builtin_amdgcn_s_barrier()
#define PG8_SCHED __builtin_amdgcn_sched_barrier(0)
    Unit cur, nxt; int ui = 0;
    if (!S.next(0, cur)) return;
    f32x4 acc[2][2][4][2];
#pragma unroll
    for (int a = 0; a < 2; ++a)
#pragma unroll
        for (int b = 0; b < 2; ++b)
#pragma unroll
            for (int m = 0; m < 4; ++m)
#pragma unroll
                for (int n = 0; n < 2; ++n) acc[a][b][m][n] = (f32x4){0.f, 0.f, 0.f, 0.f};
    bf16x8 At[4][2], B0[2][2], B1[2][2];
    const char* cA = (const char*)(g.A + (size_t)cur.b * g.sA) + (size_t)cur.pm * tstepA; const char* cB = (const char*)(g.Bt + (size_t)cur.b * g.sB) + (size_t)cur.pn * tstepB;
    PG8_STAGE(PG8_SB(0, 0), cB, voffB); PG8_STAGE(PG8_SA(0, 0), cA, voffA); PG8_STAGE(PG8_SB(0, 1), cB + hstepB, voffB); PG8_STAGE(PG8_SA(0, 1), cA + hstepA, voffA);
    if (wr == 1) PG8_BAR;
    PG8_WAIT_V(4); PG8_BAR;
    PG8_STAGE(PG8_SB(1, 0), cB + kstep, voffB); PG8_STAGE(PG8_SA(1, 0), cA + kstep, voffA); PG8_STAGE(PG8_SB(1, 1), cB + hstepB + kstep, voffB);
    PG8_WAIT_V(6); PG8_BAR;
    for (;;) {
        const bool has_next = S.next(ui + 1, nxt);
        const char* nA = has_next ? (const char*)(g.A + (size_t)nxt.b * g.sA) + (size_t)nxt.pm * tstepA : cA; const char* nB = has_next ? (const char*)(g.Bt + (size_t)nxt.b * g.sB) + (size_t)nxt.pn * tstepB : cB;
        for (int t = 0; t < nt; t += 2) {
            const bool last = (t == nt - 2);
            const char* a1 = cA + (size_t)(t + 1) * kstep;
            const char* a2 = last ? nA : cA + (size_t)(t + 2) * kstep; const char* b2 = last ? nB : cB + (size_t)(t + 2) * kstep;
            const char* a3 = a2 + kstep; const char* b3 = b2 + kstep;
            PG8_LDB(B0, 0, 0); PG8_SCHED; PG8_LDA(At, 0, 0); PG8_STAGE(PG8_SA(1, 1), a1 + hstepA, voffA);
            PG8_WAIT_L(8); PG8_BAR; PG8_WAIT_L(0); PG8_MMA(0, 0, At, B0); PG8_BAR; PG8_SCHED;
            PG8_LDB(B1, 0, 1); PG8_STAGE(PG8_SB(0, 0), b2, voffB);
            PG8_BAR; PG8_WAIT_L(0); PG8_MMA(0, 1, At, B1); PG8_BAR;
            PG8_LDA(At, 0, 1); PG8_STAGE(PG8_SA(0, 0), a2, voffA);
            PG8_BAR; PG8_WAIT_L(0); PG8_MMA(1, 0, At, B0); PG8_BAR; PG8_SCHED;
            PG8_STAGE(PG8_SB(0, 1), b2 + hstepB, voffB);
            PG8_WAIT_V(6); PG8_BAR; PG8_MMA(1, 1, At, B1); PG8_BAR;
            PG8_LDB(B0, 1, 0); PG8_SCHED; PG8_LDA(At, 1, 0); PG8_STAGE(PG8_SA(0, 1), a2 + hstepA, voffA);
            PG8_WAIT_L(8); PG8_BAR; PG8_WAIT_L(0); PG8_MMA(0, 0, At, B0); PG8_BAR; PG8_SCHED;
            PG8_LDB(B1, 1, 1); PG8_STAGE(PG8_SB(1, 0), b3, voffB);
            PG8_BAR; PG8_WAIT_L(0); PG8_MMA(0, 1, At, B1); PG8_BAR;
            PG8_LDA(At, 1, 1); PG8_STAGE(PG8_SA(1, 0), a3, voffA);
            PG8_BAR; PG8_WAIT_L(0); PG8_MMA(1, 0, At, B0); PG8_BAR; PG8_SCHED;
            PG8_STAGE(PG8_SB(1, 1), b3 + hstepB, voffB);
            PG8_WAIT_V(6); PG8_BAR; PG8_MMA(1, 1, At, B1); PG8_BAR;
        }
        E(acc, cur, wr, wc, fr, fq);
        if (!has_next) break;
#pragma unroll
        for (int a = 0; a < 2; ++a)
#pragma unroll
            for (int b = 0; b < 2; ++b)
#pragma unroll
                for (int m = 0; m < 4; ++m)
#pragma unroll
                    for (int n = 0; n < 2; ++n) acc[a][b][m][n] = (f32x4){0.f, 0.f, 0.f, 0.f};
        cur = nxt; cA = nA; cB = nB; ++ui;
    }
    PG8_WAIT_V(0);
    if (wr == 0) PG8_BAR;
    PG8_BAR;
#undef PG8_SA
#undef PG8_SB
#undef PG8_STAGE
#undef PG8_LDA
#undef PG8_LDB
#undef PG8_MMA
#undef PG8_WAIT_V
#undef PG8_WAIT_L
#undef PG8_BAR
#undef PG8_SCHED
}

typedef const f32x4 (&AccRef)[2][2][4][2];
__device__ __forceinline__ u32x4 pack8(f32x4 v0, f32x4 v1) { u32x4 w; w.x = cvt_pk_bf16(v0[0], v0[1]); w.y = cvt_pk_bf16(v0[2], v0[3]); w.z = cvt_pk_bf16(v1[0], v1[1]); w.w = cvt_pk_bf16(v1[2], v1[3]); return w; }
__device__ __forceinline__ void unpack8(u32x4 w, f32x4& v0, f32x4& v1) { v0 = (f32x4){bflo(w.x), bfhi(w.x), bflo(w.y), bfhi(w.y)}; v1 = (f32x4){bflo(w.z), bfhi(w.z), bflo(w.w), bfhi(w.w)}; }

struct EpiSwiglu {
    static constexpr bool PERM = true; bf16_t* O; const float* rs;
    __device__ __forceinline__ void operator()(AccRef acc, const Unit& u, int wr, int wc, int fr, int fq) const {
        const int row0 = u.pm * BM + wr * 64 + fr, col = u.pn * 128 + wc * 32 + 8 * fq;
#pragma unroll
        for (int ai = 0; ai < 2; ++ai)
#pragma unroll
            for (int m = 0; m < 4; ++m) {
                f32x4 v0, v1; const float r = rs[row0 + ai * HALF + m * 16], rn = r * -1.4426950408889634f, r2 = r * r;
                { const f32x4 a0 = acc[ai][0][m][0], a1 = acc[ai][0][m][1], b0 = acc[ai][1][m][0], b1 = acc[ai][1][m][1];
                  const f32x2 o0 = swiglu2((f32x2){a0[0], a0[1]}, (f32x2){b0[0], b0[1]}, rn, r2), o1 = swiglu2((f32x2){a0[2], a0[3]}, (f32x2){b0[2], b0[3]}, rn, r2);
                  const f32x2 o2 = swiglu2((f32x2){a1[0], a1[1]}, (f32x2){b1[0], b1[1]}, rn, r2), o3 = swiglu2((f32x2){a1[2], a1[3]}, (f32x2){b1[2], b1[3]}, rn, r2);
                  v0 = (f32x4){o0.x, o0.y, o1.x, o1.y}; v1 = (f32x4){o2.x, o2.y, o3.x, o3.y}; }
                *(u32x4*)(O + (size_t)(row0 + ai * HALF + m * 16) * DFF + col) = pack8(v0, v1);
            }
    }
};
struct EpiBf16 {
    static constexpr bool PERM = true; bf16_t* O; int ldc;
    __device__ __forceinline__ void operator()(AccRef acc, const Unit& u, int wr, int wc, int fr, int fq) const {
        const int row0 = u.pm * BM + wr * 64 + fr, col0 = u.pn * BM + wc * 32 + 8 * fq;
#pragma unroll
        for (int ai = 0; ai < 2; ++ai)
#pragma unroll
            for (int m = 0; m < 4; ++m)
#pragma unroll
                for (int bj = 0; bj < 2; ++bj)
                    *(u32x4*)(O + (size_t)(row0 + ai * HALF + m * 16) * ldc + col0 + bj * HALF) = pack8(acc[ai][bj][m][0], acc[ai][bj][m][1]);
    }
};
struct EpiWin {
    static constexpr bool PERM = true; unsigned char* ws; const float* rs;
    __device__ __forceinline__ void operator()(AccRef acc, const Unit& u, int wr, int wc, int fr, int fq) const {
        const int pn = u.pn; int act, ld, cb; size_t base;
        if (pn < 4) { act = 0; ld = 1024; cb = pn * 256; base = B_XL; }
        else if (pn < 8) { act = 1; ld = 1024; cb = (pn - 4) * 256; base = B_GL; }
        else if (pn < 12) { act = 2; ld = 0; cb = (pn - 8) * 256; base = B_A2; }
        else if (pn < 18) { act = 3; ld = 1536; cb = (pn - 12) * 256; base = B_Q; }
        else if (pn < 24) { act = 0; ld = 1536; cb = (pn - 18) * 256; base = B_K; }
        else if (pn < 30) { act = 0; ld = 1536; cb = (pn - 24) * 256; base = B_V; }
        else if (pn < 38) { act = 4; ld = 2048; cb = (pn - 30) * 256; base = B_GA; }
        else if (pn < 46) { act = 4; ld = 2048; cb = (pn - 38) * 256; base = B_GB; }
        else { act = 4; ld = 2048; cb = (pn - 46) * 256; base = B_GC; }
        bf16_t* O = (bf16_t*)(ws + base);
        const int row0 = u.pm * BM + wr * 64 + fr, col0 = cb + wc * 32 + 8 * fq;
#pragma unroll
        for (int ai = 0; ai < 2; ++ai)
#pragma unroll
            for (int m = 0; m < 4; ++m)
#pragma unroll
                for (int bj = 0; bj < 2; ++bj) {
                    const int row = row0 + ai * HALF + m * 16, col = col0 + bj * HALF;
                    const float r = rs[row]; f32x4 v0 = acc[ai][bj][m][0], v1 = acc[ai][bj][m][1];
                    if (act == 1) { v0 *= r; v1 *= r;
                        const f32x2 o0 = gelu2((f32x2){v0[0], v0[1]}), o1 = gelu2((f32x2){v0[2], v0[3]}), o2 = gelu2((f32x2){v1[0], v1[1]}), o3 = gelu2((f32x2){v1[2], v1[3]});
                        v0 = (f32x4){o0.x, o0.y, o1.x, o1.y}; v1 = (f32x4){o2.x, o2.y, o3.x, o3.y}; }
                    else if (act == 4) { const float rn = r * -1.4426950408889634f;
                        const f32x2 o0 = sigm2((f32x2){v0[0], v0[1]}, rn), o1 = sigm2((f32x2){v0[2], v0[3]}, rn), o2 = sigm2((f32x2){v1[0], v1[1]}, rn), o3 = sigm2((f32x2){v1[2], v1[3]}, rn);
                        v0 = (f32x4){o0.x, o0.y, o1.x, o1.y}; v1 = (f32x4){o2.x, o2.y, o3.x, o3.y}; }
                    else { const float rr = act == 3 ? r * 0.125f : r; v0 *= rr; v1 *= rr; }
                    size_t off;
                    if (act == 2) off = ((size_t)(col >> 4) * NSUB + (row >> 4)) * 512 + (row & 15) * 16 + (col & 15);
                    else off = (size_t)row * ld + col;
                    *(u32x4*)(O + off) = pack8(v0, v1);
                }
    }
};
struct EpiS {
    static constexpr bool PERM = false; float* S;
    __device__ __forceinline__ void operator()(AccRef acc, const Unit& u, int wr, int wc, int fr, int fq) const {
        const int row0 = u.pm * BM + wr * 64 + fr, col0 = wc * 32 + 4 * fq;
        float* base = S + (size_t)u.b * NSUB * 256;
#pragma unroll
        for (int ai = 0; ai < 2; ++ai)
#pragma unroll
            for (int m = 0; m < 4; ++m)
#pragma unroll
                for (int bj = 0; bj < 2; ++bj)
#pragma unroll
                    for (int n = 0; n < 2; ++n)
                        *(f32x4*)(base + (size_t)(row0 + ai * HALF + m * 16) * 256 + col0 + bj * HALF + n * 16) = acc[ai][bj][m][n];
    }
};
struct EpiY {
    static constexpr bool PERM = true; bf16_t* Y1;
    __device__ __forceinline__ void operator()(AccRef acc, const Unit& u, int wr, int wc, int fr, int fq) const {
        const int row0 = u.pm * BM + wr * 64 + fr, n0 = wc * 32 + 8 * fq;
#pragma unroll
        for (int ai = 0; ai < 2; ++ai)
#pragma unroll
            for (int m = 0; m < 4; ++m)
#pragma unroll
                for (int bj = 0; bj < 2; ++bj) {
                    const int j = row0 + ai * HALF + m * 16, nn = n0 + bj * HALF, tok = j * 16 + (nn >> 4);
                    f32x4 v0 = acc[ai][bj][m][0], v1 = acc[ai][bj][m][1];
#pragma unroll
                    for (int q = 0; q < 4; ++q) { v0[q] = gelu_t(v0[q]); v1[q] = gelu_t(v1[q]); }
                    *(u32x4*)(Y1 + (size_t)tok * 1024 + u.b * 16 + (nn & 15)) = pack8(v0, v1);
                }
    }
};
struct EpiGlu {
    static constexpr bool PERM = true; const bf16_t* Y1; bf16_t* O; const float* bias;
    __device__ __forceinline__ void operator()(AccRef acc, const Unit& u, int wr, int wc, int fr, int fq) const {
        const int row0 = u.pm * BM + wr * 64 + fr, col0 = u.pn * BM + wc * 32 + 8 * fq;
#pragma unroll
        for (int bj = 0; bj < 2; ++bj) {
            const int col = col0 + bj * HALF;
            const f32x4 b0 = *(const f32x4*)(bias + col), b1 = *(const f32x4*)(bias + col + 4);
#pragma unroll
            for (int ai = 0; ai < 2; ++ai)
#pragma unroll
                for (int m = 0; m < 4; ++m) {
                    const size_t off = (size_t)(row0 + ai * HALF + m * 16) * 1024 + col;
                    f32x4 y0, y1v; unpack8(*(const u32x4*)(Y1 + off), y0, y1v);
                    f32x4 v0 = acc[ai][bj][m][0] + b0, v1 = acc[ai][bj][m][1] + b1;
#pragma unroll
                    for (int q = 0; q < 4; ++q) { v0[q] = y0[q] * sigm(v0[q]); v1[q] = y1v[q] * sigm(v1[q]); }
                    *(u32x4*)(O + off) = pack8(v0, v1);
                }
        }
    }
};
template <bool FIRST> struct EpiMerge {
    static constexpr bool PERM = true; const bf16_t* Gt; bf16_t* Mo;
    __device__ __forceinline__ void operator()(AccRef acc, const Unit& u, int wr, int wc, int fr, int fq) const {
        const int row0 = u.pm * BM + wr * 64 + fr, col0 = u.pn * BM + wc * 32 + 8 * fq;
#pragma unroll
        for (int ai = 0; ai < 2; ++ai)
#pragma unroll
            for (int m = 0; m < 4; ++m)
#pragma unroll
                for (int bj = 0; bj < 2; ++bj) {
                    const size_t off = (size_t)(row0 + ai * HALF + m * 16) * 2048 + col0 + bj * HALF;
                    f32x4 g0, g1; unpack8(*(const u32x4*)(Gt + off), g0, g1);
                    f32x4 v0 = g0 * acc[ai][bj][m][0], v1 = g1 * acc[ai][bj][m][1];
                    if (!FIRST) { f32x4 p0, p1; unpack8(*(const u32x4*)(Mo + off), p0, p1); v0 += p0; v1 += p1; }
                    *(u32x4*)(Mo + off) = pack8(v0, v1);
                }
    }
};

__device__ void cvt_job(unsigned char* shm, const float* src, bf16_t* dst, int K, int N, int mode, const float* kscale = nullptr, int ldd = 0) {
    if (ldd == 0) ldd = K;
    bf16_t* T = (bf16_t*)shm;
    const int tid = ltid(), bid = lbid(), nkt = K / 64, nnt = N / 256, tot = nkt * nnt;
    for (int t = bid; t < tot; t += gridDim.x) {
        const int nti = t % nnt, kt = t / nnt;
        { const int k = tid >> 3, n8 = (tid & 7) * 8;
          const float* s = src + (size_t)(kt * 64 + k) * N + nti * 256 + n8; const float ks = kscale ? kscale[kt * 64 + k] : 1.0f;
          f32x4 v[8];
#pragma unroll
          for (int q = 0; q < 4; ++q) { v[2 * q] = *(const f32x4*)(s + q * 64); v[2 * q + 1] = *(const f32x4*)(s + q * 64 + 4); }
#pragma unroll
          for (int q = 0; q < 4; ++q)
#pragma unroll
              for (int j = 0; j < 4; ++j) { T[(q * 64 + n8 + j) * 72 + k] = f2bf(v[2 * q][j] * ks); T[(q * 64 + n8 + 4 + j) * 72 + k] = f2bf(v[2 * q + 1][j] * ks); } }
        __syncthreads();
#pragma unroll
        for (int q = 0; q < 4; ++q) { const int n = q * 64 + (tid >> 3), k8 = (tid & 7) * 8; const int nn = nti * 256 + n;
          const int drow = mode == 0 ? nn : ((nn >> 7) * 256 + (nn & 127) + (mode == 2 ? 128 : 0));
          *(u32x4*)(dst + (size_t)drow * ldd + kt * 64 + k8) = *(const u32x4*)(T + n * 72 + k8); }
        __syncthreads();
    }
}
__device__ void cvt_ffn(const Params& p, unsigned char* shm, int l, int sub) {
    bf16_t* W = (bf16_t*)(p.ws + WS_W); const size_t wo = (size_t)(l * 2 + sub) * DM * DFF;
    const float* gk = p.in[2] + (l * 6 + (sub ? 4 : 0)) * DM;
    cvt_job(shm, p.in[26] + wo, W + W_13, DM, DFF, 1, gk, LDX);
    cvt_job(shm, p.in[27] + wo, W + W_13, DM, DFF, 2, gk, LDX);
    cvt_job(shm, p.in[28] + wo, W + W_2, DFF, DM, 0);
}
__device__ void cvt_mixer(const Params& p, unsigned char* shm, int l) {
    bf16_t* W = (bf16_t*)(p.ws + WS_W);
    cvt_job(shm, p.in[3] + (size_t)l * DM * 13824, W + W_IN, DM, 13824, 0, p.in[2] + (l * 6 + 2) * DM, LDX);
    cvt_job(shm, p.in[19] + (size_t)l * 1024 * 1024, W + W_GLU, 1024, 1024, 0);
    cvt_job(shm, p.in[22] + (size_t)l * 1024 * DM, W + W_BRL, 1024, DM, 0);
    cvt_job(shm, p.in[23] + (size_t)l * 1024 * DM, W + W_BRS, 1024, DM, 0);
    cvt_job(shm, p.in[24] + (size_t)l * 512 * DM, W + W_BRA, 512, DM, 0);
    cvt_job(shm, p.in[25] + (size_t)l * DM * DM, W + W_OUT, DM, DM, 0);
}

__device__ void norm_rows(const Params& p, int mode, float scale, const float* gpost) {
    const int tid = ltid(), bid = lbid(), lane = tid & 63, wid = tid >> 6;
    bf16_t* X = (bf16_t*)(p.ws + WS_H); const bf16_t* Y = (const bf16_t*)(p.ws + B_Y); float* RS = (float*)(p.ws + SM_RS);
    for (int row = bid * 8 + wid; row < MT; row += gridDim.x * 8) {
        f32x4 xv[8];
        if (mode == 0) {
            const float* xr = row < 8192 ? p.in[0] + (size_t)row * DM : p.in[1] + (size_t)(row - 8192) * DM;
#pragma unroll
            for (int c = 0; c < 4; ++c) { xv[2 * c] = *(const f32x4*)(xr + (c * 64 + lane) * 8); xv[2 * c + 1] = *(const f32x4*)(xr + (c * 64 + lane) * 8 + 4); }
        } else {
            f32x4 yv[8]; float ss = 0.f;
#pragma unroll
            for (int c = 0; c < 4; ++c) { unpack8(*(const u32x4*)(X + (size_t)row * LDX + (c * 64 + lane) * 8), xv[2 * c], xv[2 * c + 1]); unpack8(*(const u32x4*)(Y + (size_t)row * DM + (c * 64 + lane) * 8), yv[2 * c], yv[2 * c + 1]); }
#pragma unroll
            for (int c = 0; c < 8; ++c) ss += yv[c][0] * yv[c][0] + yv[c][1] * yv[c][1] + yv[c][2] * yv[c][2] + yv[c][3] * yv[c][3];
            ss = wave_sum(ss);
            const float rs = rsqrtf(ss * (1.0f / DM) + RMS_EPS) * scale;
#pragma unroll
            for (int c = 0; c < 4; ++c) { const f32x4 g0 = *(const f32x4*)(gpost + (c * 64 + lane) * 8), g1 = *(const f32x4*)(gpost + (c * 64 + lane) * 8 + 4);
                xv[2 * c] += yv[2 * c] * g0 * rs; xv[2 * c + 1] += yv[2 * c + 1] * g1 * rs; }
        }
        if (mode == 2) {
#pragma unroll
            for (int c = 0; c < 4; ++c) { *(f32x4*)(p.out + (size_t)row * DM + (c * 64 + lane) * 8) = xv[2 * c]; *(f32x4*)(p.out + (size_t)row * DM + (c * 64 + lane) * 8 + 4) = xv[2 * c + 1]; }
        } else {
            float ss = 0.f;
#pragma unroll
            for (int c = 0; c < 8; ++c) ss += xv[c][0] * xv[c][0] + xv[c][1] * xv[c][1] + xv[c][2] * xv[c][2] + xv[c][3] * xv[c][3];
            ss = wave_sum(ss);
#pragma unroll
            for (int c = 0; c < 4; ++c) *(u32x4*)(X + (size_t)row * LDX + (c * 64 + lane) * 8) = pack8(xv[2 * c], xv[2 * c + 1]);
            if (lane == 0) RS[row] = rsqrtf(ss * (1.0f / DM) + RMS_EPS);
        }
    }
}

__device__ void s5_stage1(const Params& p, int l) {
    float2* Apow = (float2*)(p.ws + SM_APOW); float2* Bbar = (float2*)(p.ws + SM_BBAR);
    for (int idx = lbid() * 512 + ltid(); idx < 8192; idx += gridDim.x * 512) {
        const float lr = p.in[11][l * 8192 + idx], li = p.in[12][l * 8192 + idx], dt = expf(p.in[13][l * 128 + (idx >> 6)]);
        float ar = 1.f, ai = 0.f;
        for (int k = 0; k < 18; ++k) { const float mag = expf((float)k * lr * dt); float s, c; sincosf((float)k * li * dt, &s, &c); Apow[idx * 18 + k] = make_float2(mag * c, mag * s); if (k == 1) { ar = mag * c; ai = mag * s; } }
        const float den = lr * lr + li * li, cr = ((ar - 1.0f) * lr + ai * li) / den, ci = (ai * lr - (ar - 1.0f) * li) / den;
        for (int c = 0; c < 16; ++c) { const float br = p.in[14][(size_t)l * 131072 + idx * 16 + c], bi = p.in[15][(size_t)l * 131072 + idx * 16 + c];
            Bbar[idx * 16 + c] = make_float2(cr * br - ci * bi, cr * bi + ci * br); }
    }
}
__device__ void s5_stage2(const Params& p, int l) {
    const float2* Apow = (const float2*)(p.ws + SM_APOW); const float2* Bbar = (const float2*)(p.ws + SM_BBAR);
    float* Kd = (float*)(p.ws + SM_KD); bf16_t* Gm = (bf16_t*)(p.ws + SM_G); bf16_t* Ym = (bf16_t*)(p.ws + SM_Y); bf16_t* LWT = (bf16_t*)(p.ws + SM_LWT);
    const float* cre = p.in[16] + (size_t)l * 131072; const float* cim = p.in[17] + (size_t)l * 131072;
    const int gs = gridDim.x * 512, t0 = lbid() * 512 + ltid();
    for (int o = t0; o < 524288; o += gs) {
        const int c2 = o & 15, c = (o >> 4) & 15, k = (o >> 8) & 15, dg = o >> 12;
        float acc = 0.f;
        for (int pp = 0; pp < 64; ++pp) { const int sidx = dg * 64 + pp; const float2 A = Apow[sidx * 18 + k], Bb = Bbar[sidx * 16 + c2];
            const float Cr = cre[(dg * 16 + c) * 64 + pp], Ci = cim[(dg * 16 + c) * 64 + pp];
            const float abr = A.x * Bb.x - A.y * Bb.y, abi = A.x * Bb.y + A.y * Bb.x; acc += Cr * abr - Ci * abi; }
        Kd[o] = acc;
    }
    for (int o = t0; o < 64 * 65536; o += gs) {
        const int kk = o & 255, n = (o >> 8) & 255, g = o >> 16;
        { const int d = n >> 7, ri = (n >> 6) & 1, pp = n & 63, s = kk >> 4, c2 = kk & 15, e = d == 0 ? 15 - s : s; const int sidx = (d * 64 + g) * 64 + pp;
          const float2 A = Apow[sidx * 18 + e], Bb = Bbar[sidx * 16 + c2];
          Gm[o] = f2bf(ri ? A.x * Bb.y + A.y * Bb.x : A.x * Bb.x - A.y * Bb.y); }
        { const int tau = n >> 4, c = n & 15, d = kk >> 7, ri = (kk >> 6) & 1, pp = kk & 63, e = d == 0 ? tau + 1 : 16 - tau; const int sidx = (d * 64 + g) * 64 + pp;
          const float2 A = Apow[sidx * 18 + e]; const float Cr = cre[((d * 64 + g) * 16 + c) * 64 + pp], Ci = cim[((d * 64 + g) * 16 + c) * 64 + pp];
          Ym[((size_t)g * 256 + n) * 512 + 256 + kk] = f2bf(ri ? -(Cr * A.y + Ci * A.x) : Cr * A.x - Ci * A.y); }
    }
    for (int o = t0; o < 262144; o += gs) {
        const int i = o & 63, j = (o >> 6) & 63, n = (o >> 12) & 15, gate = (o >> 16) & 1, d = o >> 17;
        const float* src = gate ? p.in[8] : p.in[6];
        LWT[o] = f2bf(src[(size_t)((l * 2 + d) * 16 + n) * 4096 + i * 64 + j]);
    }
}
__device__ void s5_stage3(const Params& p, int l) {
    const float* Kd = (const float*)(p.ws + SM_KD); bf16_t* Ym = (bf16_t*)(p.ws + SM_Y); const float* Dk = p.in[18] + l * 1024;
    for (int o = lbid() * 512 + ltid(); o < 64 * 65536; o += gridDim.x * 512) {
        const int kk = o & 255, n = (o >> 8) & 255, g = o >> 16, s = kk >> 4, c2 = kk & 15, tau = n >> 4, c = n & 15;
        float v = 0.f;
        if (s <= tau) v += Kd[((0 * 64 + g) * 16 + (tau - s)) * 256 + c * 16 + c2];
        if (s >= tau) v += Kd[((1 * 64 + g) * 16 + (s - tau)) * 256 + c * 16 + c2];
        if (s == tau && c == c2) v += Dk[g * 16 + c];
        Ym[((size_t)g * 256 + n) * 512 + kk] = f2bf(v);
    }
}
__device__ void s5_bscan(const Params& p, unsigned char* shm) {
    const float2* Apow = (const float2*)(p.ws + SM_APOW); const float* S = (const float*)((const unsigned char*)p.out + O_S); bf16_t* A2 = (bf16_t*)(p.ws + B_A2);
    float2* Es = (float2*)shm;
    const int tid = ltid();
    for (int it = lbid(); it < 192; it += gridDim.x) {
        const bool lng = it < 128;
        const int pp = tid & 63, g = lng ? it >> 1 : it - 128, d = lng ? (it & 1) : ((tid >> 6) & 1), seg = lng ? tid >> 6 : 0, seq = lng ? 4 : tid >> 7;
        const int j0 = lng ? 512 + seg * 128 : seq * 128;
        const float2 A16 = Apow[((d * 64 + g) * 64 + pp) * 18 + 16];
        const float* Sg = S + (size_t)g * NSUB * 256 + d * 128 + pp; bf16_t* Xg = A2 + (size_t)g * NSUB * 512 + 256 + d * 128 + pp;
        float xr = 0.f, xi = 0.f;
        if (lng) {
            for (int jb = 0; jb < 128; jb += 16) {
                float sr[16], si[16];
#pragma unroll
                for (int u = 0; u < 16; ++u) { const int j = d ? (j0 + 127 - (jb + u)) : (j0 + jb + u); sr[u] = Sg[(size_t)j * 256]; si[u] = Sg[(size_t)j * 256 + 64]; }
#pragma unroll
                for (int u = 0; u < 16; ++u) { const float nr = A16.x * xr - A16.y * xi + sr[u], ni = A16.x * xi + A16.y * xr + si[u]; xr = nr; xi = ni; }
            }
            Es[seg * 64 + pp] = make_float2(xr, xi);
            float2 Ab = A16;
#pragma unroll
            for (int q = 0; q < 7; ++q) Ab = make_float2(Ab.x * Ab.x - Ab.y * Ab.y, 2.0f * Ab.x * Ab.y);
            __syncthreads();
            xr = 0.f; xi = 0.f;
            for (int q = 0; q < 8; ++q) { const int sq = d ? 7 - q : q; const bool use = d ? (sq > seg) : (sq < seg);
                if (use) { const float2 E = Es[sq * 64 + pp]; const float nr = Ab.x * xr - Ab.y * xi + E.x, ni = Ab.x * xi + Ab.y * xr + E.y; xr = nr; xi = ni; } }
        }
        for (int jb = 0; jb < 128; jb += 16) {
            float sr[16], si[16];
#pragma unroll
            for (int u = 0; u < 16; ++u) { const int j = d ? (j0 + 127 - (jb + u)) : (j0 + jb + u); sr[u] = Sg[(size_t)j * 256]; si[u] = Sg[(size_t)j * 256 + 64]; }
#pragma unroll
            for (int u = 0; u < 16; ++u) { const int j = d ? (j0 + 127 - (jb + u)) : (j0 + jb + u);
                Xg[(size_t)j * 512] = f2bf(xr); Xg[(size_t)j * 512 + 64] = f2bf(xi);
                const float nr = A16.x * xr - A16.y * xi + sr[u], ni = A16.x * xi + A16.y * xr + si[u]; xr = nr; xi = ni; }
        }
        __syncthreads();
    }
}

template <int PASS>
__device__ void lru_items(const Params& p, unsigned char* shm, int l) {
    bf16_t* xraw = (bf16_t*)shm;
    float* xcf = (float*)(shm + 8704);
    bf16_t* xcb = (bf16_t*)(shm + 25344);
    bf16_t* wt = (bf16_t*)(shm + 34560);
    float* As = (float*)(shm + 71424);
    float* Bs = (float*)(shm + 104192);
    float* Pq = (float*)(shm + 136960);
    float* Hq = (float*)(shm + 139008);
    const bf16_t* XL = (const bf16_t*)(p.ws + B_XL); bf16_t* GL = (bf16_t*)(p.ws + B_GL); const bf16_t* LWT = (const bf16_t*)(p.ws + SM_LWT);
    float* SA = (float*)(p.ws + SM_SA); float* SH = (float*)(p.ws + SM_SH); const float* CIN = (const float*)(p.ws + SM_CIN);
    const float* cw = p.in[4] + l * 4096; const float* cbias = p.in[5] + l * 1024;
    const int tid = ltid(), lane = tid & 63, w = tid >> 6, fr = lane & 15, fq = lane >> 4, G_ = gridDim.x, total = NCHK * 16;
    int n_loaded = -1;
    float c0 = 0.f, c1 = 0.f, c2 = 0.f, c3 = 0.f, cb = 0.f, gba[4], gbx[4], gsp[4];
#pragma unroll
    for (int jt = 0; jt < 4; ++jt) { gba[jt] = 0.f; gbx[jt] = 0.f; gsp[jt] = 0.f; }
    u32x4 xr0 = (u32x4){0u, 0u, 0u, 0u}, xr1 = (u32x4){0u, 0u, 0u, 0u};
#define LRU_LOAD(IT) do { const int ck_ = (IT) >> 4, n_ = (IT) & 15, t0_ = ck_ * 64; const int ss_ = t0_ < 8192 ? (t0_ & ~2047) : 8192, se_ = t0_ < 8192 ? ss_ + 2048 : MT; \
        { const int row = tid >> 3, c8 = tid & 7, tok = t0_ - 2 + row; xr0 = (u32x4){0u, 0u, 0u, 0u}; if (tok >= ss_ && tok < se_) xr0 = *(const u32x4*)(XL + (size_t)tok * 1024 + n_ * 64 + c8 * 8); } \
        if (tid < 24) { const int row = 64 + (tid >> 3), c8 = tid & 7, tok = t0_ - 2 + row; xr1 = (u32x4){0u, 0u, 0u, 0u}; if (tok >= ss_ && tok < se_) xr1 = *(const u32x4*)(XL + (size_t)tok * 1024 + n_ * 64 + c8 * 8); } } while (0)
    int it = lbid();
    if (it < total) LRU_LOAD(it);
    for (; it < total; it += G_) {
        const int ck = it >> 4, n = it & 15, t0 = ck * 64;
        *(u32x4*)(xraw + (tid >> 3) * 64 + (tid & 7) * 8) = xr0;
        if (tid < 24) *(u32x4*)(xraw + (64 + (tid >> 3)) * 64 + (tid & 7) * 8) = xr1;
        if (n != n_loaded) {
            n_loaded = n;
#pragma unroll
            for (int i = 0; i < 4; ++i) { const int e = tid + 512 * i, mtx = e >> 9, rem = e & 511, j = rem >> 3, c8 = rem & 7;
                *(u32x4*)(wt + (mtx * 64 + j) * 72 + c8 * 8) = *(const u32x4*)(LWT + ((size_t)(mtx * 16 + n) * 64 + j) * 64 + c8 * 8); }
            { const int ch = n * 64 + (tid & 63); c0 = cw[ch]; c1 = cw[1024 + ch]; c2 = cw[2048 + ch]; c3 = cw[3072 + ch]; cb = cbias[ch]; }
#pragma unroll
            for (int jt = 0; jt < 4; ++jt) { const int pi = (l * 2 + (w >> 2)) * 1024 + n * 64 + jt * 16 + fr; gba[jt] = p.in[7][pi]; gbx[jt] = p.in[9][pi]; gsp[jt] = -8.0f * log1pf(__expf(-p.in[10][pi])); }
        }
        u32x4 glv = (u32x4){0u, 0u, 0u, 0u}; float cin = 0.f;
        const size_t go = (size_t)(t0 + (tid >> 3)) * 1024 + n * 64 + (tid & 7) * 8;
        const size_t so = (size_t)(ck * 2 + ((tid >> 6) & 1)) * 1024 + n * 64 + (tid & 63);
        if (PASS == 1) { glv = *(const u32x4*)(GL + go); cin = CIN[so]; }
        __syncthreads();
        if (it + G_ < total) LRU_LOAD(it + G_);
        { const int j = tid & 63;
#pragma unroll
          for (int i = 0; i < 8; ++i) { const int t = (tid >> 6) + 8 * i;
              const float v = cb + bf2f(xraw[t * 64 + j]) * c0 + bf2f(xraw[(t + 1) * 64 + j]) * c1 + bf2f(xraw[(t + 2) * 64 + j]) * c2 + bf2f(xraw[(t + 3) * 64 + j]) * c3;
              xcf[t * 65 + j] = v; xcb[t * 72 + j] = f2bf(v); } }
        __syncthreads();
        { const int d = w >> 2, tt = w & 3;
          const bf16x8 a0 = *(const bf16x8*)(xcb + (tt * 16 + fr) * 72 + fq * 8), a1 = *(const bf16x8*)(xcb + (tt * 16 + fr) * 72 + 32 + fq * 8);
#pragma unroll
          for (int jt = 0; jt < 4; ++jt) {
              f32x4 accr = (f32x4){0.f, 0.f, 0.f, 0.f}, acci = (f32x4){0.f, 0.f, 0.f, 0.f};
              const bf16_t* wr_ = wt + ((d * 2 + 0) * 64 + jt * 16 + fr) * 72 + fq * 8; const bf16_t* wi_ = wt + ((d * 2 + 1) * 64 + jt * 16 + fr) * 72 + fq * 8;
              accr = __builtin_amdgcn_mfma_f32_16x16x32_bf16(a0, *(const bf16x8*)wr_, accr, 0, 0, 0);
              accr = __builtin_amdgcn_mfma_f32_16x16x32_bf16(a1, *(const bf16x8*)(wr_ + 32), accr, 0, 0, 0);
              acci = __builtin_amdgcn_mfma_f32_16x16x32_bf16(a0, *(const bf16x8*)wi_, acci, 0, 0, 0);
              acci = __builtin_amdgcn_mfma_f32_16x16x32_bf16(a1, *(const bf16x8*)(wi_ + 32), acci, 0, 0, 0);
              const int j = jt * 16 + fr;
#pragma unroll
              for (int i = 0; i < 4; ++i) { const int t = tt * 16 + fq * 4 + i;
                  const float r = sigm(accr[i] + gba[jt]), ig = sigm(acci[i] + gbx[jt]), a = __expf(r * gsp[jt]);
                  As[(d * 64 + t) * 64 + j] = a;
                  Bs[(d * 64 + t) * 64 + j] = sqrtf(fmaxf(1.0f - a * a, 0.f)) * ig * xcf[t * 65 + j]; }
          } }
        __syncthreads();
        {
            const int seg = tid >> 7, d = (tid >> 6) & 1, j = tid & 63;
            float h = 0.f, P = 1.f;
#pragma unroll
            for (int s = 0; s < 16; ++s) { const int st = seg * 16 + s, t = d ? 63 - st : st; const float a = As[(d * 64 + t) * 64 + j]; h = a * h + Bs[(d * 64 + t) * 64 + j]; P *= a; }
            Pq[seg * 128 + (tid & 127)] = P; Hq[seg * 128 + (tid & 127)] = h;
            __syncthreads();
            if (PASS == 0) {
                if (tid < 128) { float hh = Hq[tid], PP = Pq[tid];
#pragma unroll
                    for (int q = 1; q < 4; ++q) { const float pq = Pq[q * 128 + tid]; hh = pq * hh + Hq[q * 128 + tid]; PP *= pq; }
                    SA[so] = PP; SH[so] = hh; }
            } else {
                float c = cin;
#pragma unroll
                for (int q = 0; q < 3; ++q) if (q < seg) c = Pq[q * 128 + (tid & 127)] * c + Hq[q * 128 + (tid & 127)];
#pragma unroll
                for (int s = 0; s < 16; ++s) { const int st = seg * 16 + s, t = d ? 63 - st : st; c = As[(d * 64 + t) * 64 + j] * c + Bs[(d * 64 + t) * 64 + j]; Bs[(d * 64 + t) * 64 + j] = c; }
                __syncthreads();
                const int t = tid >> 3, c8 = tid & 7;
                f32x4 g0, g1; unpack8(glv, g0, g1);
                const f32x4 f0 = *(const f32x4*)(Bs + t * 64 + c8 * 8), f1 = *(const f32x4*)(Bs + t * 64 + c8 * 8 + 4), r0 = *(const f32x4*)(Bs + (64 + t) * 64 + c8 * 8), r1 = *(const f32x4*)(Bs + (64 + t) * 64 + c8 * 8 + 4);
                *(u32x4*)(GL + go) = pack8((f0 + r0) * g0, (f1 + r1) * g1);
            }
        }
        __syncthreads();
    }
#undef LRU_LOAD
}
__device__ void lru_carry(const Params& p) {
    const float* SA = (const float*)(p.ws + SM_SA); const float* SH = (const float*)(p.ws + SM_SH); float* CIN = (float*)(p.ws + SM_CIN);
    const int tid_ = ltid();
    for (int it = lbid(); it < 20; it += gridDim.x) {
        const int c = it * 512 + tid_, ch = c & 1023, d = (c >> 10) & 1, seq = c >> 11;
        const int k0 = seq < 4 ? seq * 32 : 128, nk = seq < 4 ? 32 : 256;
        float carry = 0.f;
        for (int kb = 0; kb < nk; kb += 8) {
            float a[8], h[8];
#pragma unroll
            for (int u = 0; u < 8; ++u) { const int k = d ? (k0 + nk - 1 - (kb + u)) : (k0 + kb + u); a[u] = SA[(size_t)(k * 2 + d) * 1024 + ch]; h[u] = SH[(size_t)(k * 2 + d) * 1024 + ch]; }
#pragma unroll
            for (int u = 0; u < 8; ++u) { const int k = d ? (k0 + nk - 1 - (kb + u)) : (k0 + kb + u); CIN[(size_t)(k * 2 + d) * 1024 + ch] = carry; carry = a[u] * carry + h[u]; }
        }
    }
}

struct AttnGeom { int hd, seq_start, dil, n_lat, r, q0; };
__device__ __forceinline__ AttnGeom attn_geom(int it) {
    AttnGeom G; G.hd = it / 192; const int qt = it % 192;
    int T, lt; if (qt < 64) { G.seq_start = (qt >> 4) * 2048; T = 2048; lt = qt & 15; } else { G.seq_start = 8192; T = 16384; lt = qt - 64; }
    const int g = G.hd >> 3; G.dil = g == 0 ? 1 : (g == 1 ? 4 : 16); G.n_lat = T / G.dil; const int tpr = G.n_lat >> 7; G.r = lt / tpr; G.q0 = (lt % tpr) << 7; return G;
}
__device__ void attn_items(const Params& p, unsigned char* shm) {
    bf16_t* Ks = (bf16_t*)shm;
    bf16_t* Vt = (bf16_t*)(shm + 36864);
    bf16_t* Ps = (bf16_t*)(shm + 77824);
    float* BT = (float*)(shm + 120832);
    bf16_t* Qb = (bf16_t*)(p.ws + B_Q); const bf16_t* Kb = (const bf16_t*)(p.ws + B_K); const bf16_t* Vb = (const bf16_t*)(p.ws + B_V);
    float* LSE = (float*)(p.ws + SM_LSE);
    const int tid = ltid(), lane = tid & 63, w = tid >> 6, fr = lane & 15, fq = lane >> 4, G_ = gridDim.x;
    for (int i = tid; i < 24 * 129; i += 512) { const int hd = i / 129, j = i % 129; BT[hd * 132 + j] = p.in[21][(int)BUCKET[hd >> 3][j] * 24 + hd]; }
    u32x4 kreg[5], vreg[5]; bf16x8 q0r, q1r;
    const int total = 24 * 192;
    int it = lbid();
#define ATT_LOAD(IT) do { const AttnGeom G = attn_geom(IT); \
        _Pragma("unroll") for (int i = 0; i < 5; ++i) { const int e = tid + 512 * i, kk = e >> 3, c8 = e & 7, lat = G.q0 - 64 + kk; const bool ok = e < 2176 && kk < 256 && lat >= 0 && lat < G.n_lat; \
            kreg[i] = (u32x4){0u, 0u, 0u, 0u}; vreg[i] = (u32x4){0u, 0u, 0u, 0u}; \
            if (ok) { const size_t go = (size_t)(G.seq_start + G.r + G.dil * lat) * 1536 + G.hd * 64 + c8 * 8; kreg[i] = *(const u32x4*)(Kb + go); vreg[i] = *(const u32x4*)(Vb + go); } } \
        const size_t qo = (size_t)(G.seq_start + G.r + G.dil * (G.q0 + 16 * w + fr)) * 1536 + G.hd * 64; \
        q0r = *(const bf16x8*)(Qb + qo + fq * 8); q1r = *(const bf16x8*)(Qb + qo + 32 + fq * 8); } while (0)
    if (it < total) ATT_LOAD(it);
    for (; it < total; it += G_) {
        const AttnGeom G = attn_geom(it);
#pragma unroll
        for (int i = 0; i < 5; ++i) { const int e = tid + 512 * i, kk = e >> 3, c8 = e & 7;
            if (e < 2176) {
                if (kk < 256) *(u32x4*)(Ks + kk * 72 + c8 * 8) = kreg[i];
#pragma unroll
                for (int j = 0; j < 8; ++j) Vt[(c8 * 8 + j) * 320 + (kk ^ (c8 << 3))] = (bf16_t)((vreg[i][j >> 1] >> ((j & 1) * 16)) & 0xffffu); } }
        const bf16x8 aq0 = q0r, aq1 = q1r;
        __syncthreads();
        if (it + G_ < total) ATT_LOAD(it + G_);
        const float* bs = BT + G.hd * 132;
        f32x4 s[9];
#pragma unroll
        for (int kt = 0; kt < 9; ++kt) { const bf16_t* kr = Ks + (16 * w + 16 * kt + fr) * 72 + fq * 8;
            f32x4 a = (f32x4){0.f, 0.f, 0.f, 0.f};
            a = __builtin_amdgcn_mfma_f32_16x16x32_bf16(aq0, *(const bf16x8*)kr, a, 0, 0, 0);
            a = __builtin_amdgcn_mfma_f32_16x16x32_bf16(aq1, *(const bf16x8*)(kr + 32), a, 0, 0, 0); s[kt] = a; }
        float mx[4], ls[4];
#pragma unroll
        for (int i = 0; i < 4; ++i) { const int qi = fq * 4 + i; float m = -3.0e38f;
#pragma unroll
            for (int kt = 0; kt < 9; ++kt) { const int rel = 16 * kt + fr - 64 - qi, klat = G.q0 - 64 + 16 * w + 16 * kt + fr;
                const bool ok = rel >= -64 && rel <= 64 && klat >= 0 && klat < G.n_lat; const int bi = min(max(rel + 64, 0), 128);
                const float v = ok ? s[kt][i] + bs[bi] : -1.0e30f; s[kt][i] = v; m = fmaxf(m, v); }
            m = fmaxf(m, __shfl_xor(m, 1)); m = fmaxf(m, __shfl_xor(m, 2)); m = fmaxf(m, __shfl_xor(m, 4)); m = fmaxf(m, __shfl_xor(m, 8));
            float sum = 0.f;
#pragma unroll
            for (int kt = 0; kt < 9; ++kt) { const float pv = __expf(s[kt][i] - m); s[kt][i] = pv; sum += pv; }
            sum += __shfl_xor(sum, 1); sum += __shfl_xor(sum, 2); sum += __shfl_xor(sum, 4); sum += __shfl_xor(sum, 8);
            mx[i] = m; ls[i] = sum; }
        bf16_t* Pw = Ps + w * 16 * 168;
#pragma unroll
        for (int i = 0; i < 4; ++i) {
#pragma unroll
            for (int kt = 0; kt < 9; ++kt) Pw[(fq * 4 + i) * 168 + 16 * kt + fr] = f2bf(s[kt][i]);
            Pw[(fq * 4 + i) * 168 + 144 + fr] = 0; }
        __syncthreads();
        f32x4 o[4];
#pragma unroll
        for (int nt = 0; nt < 4; ++nt) o[nt] = (f32x4){0.f, 0.f, 0.f, 0.f};
#pragma unroll
        for (int ks = 0; ks < 5; ++ks) { const bf16x8 ap = *(const bf16x8*)(Pw + fr * 168 + ks * 32 + fq * 8);
#pragma unroll
            for (int nt = 0; nt < 4; ++nt) { const int dim = nt * 16 + fr; o[nt] = __builtin_amdgcn_mfma_f32_16x16x32_bf16(ap, *(const bf16x8*)(Vt + dim * 320 + ((16 * w + ks * 32 + fq * 8) ^ ((dim >> 3) << 3))), o[nt], 0, 0, 0); } }
        __syncthreads();
#pragma unroll
        for (int i = 0; i < 4; ++i) { const float inv = 1.0f / ls[i];
#pragma unroll
            for (int nt = 0; nt < 4; ++nt) Pw[(fq * 4 + i) * 168 + nt * 16 + fr] = f2bf(o[nt][i] * inv);
            if (fr == 0) LSE[(size_t)(G.seq_start + G.r + G.dil * (G.q0 + 16 * w + fq * 4 + i)) * 24 + G.hd] = mx[i] + __logf(ls[i]); }
        __syncthreads();
#pragma unroll
        for (int h = 0; h < 2; ++h) { const int c = lane + 64 * h, row = c >> 3, c8 = c & 7;
            *(u32x4*)(Qb + (size_t)(G.seq_start + G.r + G.dil * (G.q0 + 16 * w + row)) * 1536 + G.hd * 64 + c8 * 8) = *(const u32x4*)(Pw + row * 168 + c8 * 8); }
        __syncthreads();
    }
#undef ATT_LOAD
}
__device__ void attn_combine(const Params& p) {
    const bf16_t* Ab = (const bf16_t*)(p.ws + B_Q); const float* LSE = (const float*)(p.ws + SM_LSE); bf16_t* YA = (bf16_t*)(p.ws + B_YATT);
    for (int e = lbid() * 512 + ltid(); e < MT * 64; e += gridDim.x * 512) {
        const int tok = e >> 6, h = (e >> 3) & 7, c8 = e & 7;
        const float l0 = LSE[(size_t)tok * 24 + h], l1 = LSE[(size_t)tok * 24 + 8 + h], l2 = LSE[(size_t)tok * 24 + 16 + h];
        const float m = fmaxf(l0, fmaxf(l1, l2)); float w0 = __expf(l0 - m), w1 = __expf(l1 - m), w2 = __expf(l2 - m); const float inv = 1.0f / (w0 + w1 + w2); w0 *= inv; w1 *= inv; w2 *= inv;
        f32x4 a0, a1, b0, b1, c0, c1;
        unpack8(*(const u32x4*)(Ab + (size_t)tok * 1536 + h * 64 + c8 * 8), a0, a1);
        unpack8(*(const u32x4*)(Ab + (size_t)tok * 1536 + (8 + h) * 64 + c8 * 8), b0, b1);
        unpack8(*(const u32x4*)(Ab + (size_t)tok * 1536 + (16 + h) * 64 + c8 * 8), c0, c1);
        *(u32x4*)(YA + (size_t)tok * 512 + h * 64 + c8 * 8) = pack8(a0 * w0 + b0 * w1 + c0 * w2, a1 * w0 + b1 * w1 + c1 * w2);
    }
}


#define XB_TMO      128
#define XB_XCNT(j)  (256  + 64 * (j))
#define XB_XSUB(j)  (1280 + 64 * (j))
#define XB_XGEN(j)  (2304 + 64 * (j))
#define XB_TOP      3328
#define XB_TOPGEN   3392
#define XCD_BAR_WORDS 3456
#define XB_SPIN_CAP (1u << 18)
__device__ __forceinline__ unsigned xb_ld(unsigned* p)              { return __hip_atomic_load(p, __ATOMIC_RELAXED, __HIP_MEMORY_SCOPE_AGENT); }
__device__ __forceinline__ unsigned xb_add(unsigned* p, unsigned v) { return __hip_atomic_fetch_add(p, v, __ATOMIC_RELAXED, __HIP_MEMORY_SCOPE_AGENT); }
__device__ __forceinline__ unsigned xb_xcc_id() { return (unsigned)__builtin_amdgcn_s_getreg((3 << 11) | 20) & 0xFu; }
#define XB_SPIN(cond, bar) do { unsigned _sp = 0; while (cond) { __builtin_amdgcn_s_sleep(1); \
    if ((++_sp & 255u) == 0u) { if (xb_ld(&(bar)[XB_TMO])) break; if (_sp > XB_SPIN_CAP) { atomicAdd(&(bar)[XB_TMO], 1u); break; } } } } while (0)
struct XcdBarrier { unsigned* bar; unsigned x; volatile LAS unsigned* st; };
__device__ __forceinline__ XcdBarrier xcd_barrier_post(unsigned* bar, volatile LAS unsigned* st) {
    XcdBarrier b; b.bar = bar; b.x = xb_xcc_id(); b.st = st;
    if (threadIdx.x == 0) (void)xb_add(&bar[XB_XCNT(b.x)], 1u);
    return b;
}
__device__ __forceinline__ void xcd_barrier_complete(unsigned* bar, unsigned x, unsigned& nloc, unsigned& nx) {
    const unsigned G = gridDim.x * gridDim.y * gridDim.z;
    unsigned sum, cnt, mine, sp = 0u;
    for (;;) {
        sum = 0u; cnt = 0u; mine = 0u;
#pragma unroll
        for (unsigned j = 0; j < 16; ++j) { const unsigned c = xb_ld(&bar[XB_XCNT(j)]); sum += c; cnt += (c > 0u) ? 1u : 0u; mine = (j == x) ? c : mine; }
        if (sum == G) break;
        __builtin_amdgcn_s_sleep(1);
        if ((++sp & 255u) == 0u) { if (xb_ld(&bar[XB_TMO])) break; if (sp > XB_SPIN_CAP) { atomicAdd(&bar[XB_TMO], 1u); break; } }
    }
    nloc = mine > 0u ? mine : 1u; nx = cnt > 0u ? cnt : 1u;
}
__device__ __forceinline__ void xcd_barrier(const XcdBarrier& b) {
    asm volatile("s_waitcnt vmcnt(0)" ::: "memory");
    __syncthreads();
    if (threadIdx.x == 0) {
        unsigned* bar = b.bar;
        __builtin_amdgcn_s_waitcnt(0);
        unsigned nloc = b.st[0], nx = b.st[1];
        if (nloc == 0u) { xcd_barrier_complete(bar, b.x, nloc, nx); b.st[0] = nloc; b.st[1] = nx; }
        const unsigned old = xb_add(&bar[XB_XSUB(b.x)], 1u);
        const unsigned gen = old / nloc;
        if (old + 1u == (gen + 1u) * nloc) {
            __builtin_amdgcn_fence(__ATOMIC_RELEASE, "agent");
            asm volatile("s_waitcnt vmcnt(0)" ::: "memory");
            const unsigned og = xb_add(&bar[XB_TOP], 1u);
            const unsigned tg = og / nx;
            if (og + 1u == (tg + 1u) * nx) xb_add(&bar[XB_TOPGEN], 1u);
            else XB_SPIN(xb_ld(&bar[XB_TOPGEN]) == tg, bar);
            __builtin_amdgcn_fence(__ATOMIC_ACQUIRE, "agent");
            xb_add(&bar[XB_XGEN(b.x)], 1u);
            asm volatile("s_waitcnt vmcnt(0)" ::: "memory");
        } else {
            XB_SPIN(xb_ld(&bar[XB_XGEN(b.x)]) == gen, bar);
            __builtin_amdgcn_fence(__ATOMIC_ACQUIRE, "agent");
            asm volatile("s_waitcnt vmcnt(0)" ::: "memory");
        }
    }
    __syncthreads();
}

__device__ __forceinline__ Gemm mk_gemm(const bf16_t* A, int lda, const bf16_t* Bt, int ldb, int K, int nM, int nN, int nb = 1, size_t sA = 0, size_t sB = 0) {
    Gemm g; g.A = A; g.Bt = Bt; g.lda = lda; g.ldb = ldb; g.K = K; g.nM = nM; g.nN = nN; g.nb = nb; g.sA = sA; g.sB = sB; return g; }

__global__ __launch_bounds__(512, 2) void mega(Params p) {
    extern __shared__ __attribute__((aligned(16))) unsigned char shm[];
    LAS unsigned char* lds = (LAS unsigned char*)shm;
    cg::grid_group grid = cg::this_grid();
    volatile LAS unsigned* xst = (volatile LAS unsigned*)(lds + LDS_BYTES - 16);
    XcdBarrier xb; xb.bar = (unsigned*)(p.ws + SM_BAR); xb.x = 0; xb.st = xst;
    if (p.ph_hi - p.ph_lo > 1) { if (threadIdx.x == 0) { xst[0] = 0u; xst[1] = 0u; } __syncthreads(); xb = xcd_barrier_post((unsigned*)(p.ws + SM_BAR), xst); }
#pragma nounroll
    for (int ph = p.ph_lo; ph < p.ph_hi; ++ph) {
        unsigned char* ws = p.ws; asm volatile("" : "+s"(ws));
        const int l = ph == 0 ? 0 : (ph - 1) / 14, kind = ph == 0 ? 0 : (ph - 1) % 14 + 1;
        bf16_t* W = (bf16_t*)(ws + WS_W); bf16_t* H = (bf16_t*)(ws + WS_H);
        bf16_t* HID = (bf16_t*)(ws + B_HID); bf16_t* Y = (bf16_t*)(ws + B_Y); bf16_t* A2 = (bf16_t*)(ws + B_A2);
        bf16_t* Y1 = (bf16_t*)(ws + B_Y1); bf16_t* Mb = (bf16_t*)(ws + B_M);
        unsigned char* ob = (unsigned char*)p.out; asm volatile("" : "+s"(ob));
        bf16_t* YS5 = (bf16_t*)(ob + O_YS5); const float* RSp = (const float*)(ws + SM_RS);
        const float* ng = p.in[2]; const float* gl_ = ng + l * 6 * DM;
#ifdef PROBE_MASK
        for (int rep = 0, reps = ((PROBE_MASK >> kind) & 1) ? 2 : 1; rep < reps; ++rep)
#endif
        switch (kind) {
        case 0:
            PREP(0) cvt_ffn(p, shm, 0, 0); s5_stage1(p, 0);
            PREP(1) norm_rows(p, 0, 0.f, nullptr);
            break;
        case 1: case 12: {
            EpiSwiglu e; e.O = HID; e.rs = RSp; gemm_phase(lds, mk_gemm(H, LDX, W + W_13, LDX, DM, MT / 256, 44), e);
        } break;
        case 2: case 13: {
            EpiBf16 e; e.O = Y; e.ldc = DM; gemm_phase(lds, mk_gemm(HID, DFF, W + W_2, DFF, DFF, MT / 256, 8), e);
        } break;
        case 3:
            PREP(0) cvt_mixer(p, shm, l);
            s5_stage2(p, l);
            norm_rows(p, 1, 0.5f, gl_ + 1 * DM);
            if ((PROBE2 >> 1) & 1) norm_rows(p, 1, 0.0f, gl_ + 1 * DM);
            break;
        case 4: {
            EpiWin e; e.ws = ws; e.rs = RSp; gemm_phase(lds, mk_gemm(H, LDX, W + W_IN, LDX, DM, MT / 256, 54), e);
        } break;
        case 5: {
            PREP(3) { EpiS e; e.S = (float*)(ob + O_S); gemm_phase(lds, mk_gemm(A2, 512, (const bf16_t*)(ws + SM_G), 256, 256, NSUB / 256, 1, 64, (size_t)NSUB * 512, 65536), e); }
            __syncthreads();
            PREP(4) lru_items<0>(p, shm, l);
            attn_items(p, shm);
        } break;
        case 6:
            PREP(5) { lru_carry(p); s5_bscan(p, shm); attn_combine(p); }
            s5_stage3(p, l);
            break;
        case 7: {
            PREP(3) { EpiY e; e.Y1 = Y1; gemm_phase(lds, mk_gemm(A2, 512, (const bf16_t*)(ws + SM_Y), 512, 512, NSUB / 256, 1, 64, (size_t)NSUB * 512, 131072), e); }
            __syncthreads();
            lru_items<1>(p, shm, l);
        } break;
        case 8: {
            EpiGlu e; e.Y1 = Y1; e.O = YS5; e.bias = p.in[20] + l * 1024; gemm_phase(lds, mk_gemm(Y1, 1024, W + W_GLU, 1024, 1024, MT / 256, 4), e);
        } break;
        case 9: {
            { EpiMerge<true> e; e.Gt = (const bf16_t*)(ws + B_GA); e.Mo = Mb; gemm_phase(lds, mk_gemm((const bf16_t*)(ws + B_GL), 1024, W + W_BRL, 1024, 1024, MT / 256, 8), e); }
            { EpiMerge<false> e; e.Gt = (const bf16_t*)(ws + B_GB); e.Mo = Mb; gemm_phase(lds, mk_gemm(YS5, 1024, W + W_BRS, 1024, 1024, MT / 256, 8), e); }
            { EpiMerge<false> e; e.Gt = (const bf16_t*)(ws + B_GC); e.Mo = Mb; gemm_phase(lds, mk_gemm((const bf16_t*)(ws + B_YATT), 512, W + W_BRA, 512, 512, MT / 256, 8), e); }
        } break;
        case 10: {
            EpiBf16 e; e.O = Y; e.ldc = DM; gemm_phase(lds, mk_gemm(Mb, DM, W + W_OUT, DM, DM, MT / 256, 8), e);
        } break;
        case 11:
            PREP(0) cvt_ffn(p, shm, l, 1);
            norm_rows(p, 1, 1.0f, gl_ + 3 * DM);
            if ((PROBE2 >> 1) & 1) norm_rows(p, 1, 0.0f, gl_ + 3 * DM);
            break;
        default:
            if (l == 0) { PREP(0) cvt_ffn(p, shm, 1, 0); s5_stage1(p, 1); }
            norm_rows(p, l == 0 ? 1 : 2, 0.5f, gl_ + 5 * DM);
            break;
        }
        if (ph + 1 < p.ph_hi) { if (p.ph_hi > 4096) grid.sync(); else xcd_barrier(xb); }
    }
}
constexpr int N_PHASES = 1 + 2 * 14;

extern "C" void kernel_launch(void* const* d_in, const int* in_sizes, int n_in, void* d_out, int out_size, void* d_ws, size_t ws_size, hipStream_t stream) {
    static int grid = 0;
    if (grid == 0) {
        if (n_in != 29 || ws_size < WS_END) { fprintf(stderr, "kernel_launch: need 29 inputs and %zu bytes of workspace (got %d, %zu)\n", (size_t)WS_END, n_in, ws_size); grid = -1; return; }
        if (hipFuncSetAttribute((const void*)mega, hipFuncAttributeMaxDynamicSharedMemorySize, LDS_BYTES) != hipSuccess) { fprintf(stderr, "hipFuncSetAttribute failed\n"); grid = -1; return; }
        int dev = 0, cus = 0, per_cu = 0;
        (void)hipGetDevice(&dev); (void)hipDeviceGetAttribute(&cus, hipDeviceAttributeMultiprocessorCount, dev);
        (void)hipOccupancyMaxActiveBlocksPerMultiprocessor(&per_cu, (const void*)mega, 512, LDS_BYTES);
        if (per_cu < 1) per_cu = 1;
        (void)hipGetLastError();
        grid = cus * 1;
    }
    if (grid < 0) return;
    Params p{};
    for (int i = 0; i < 29; ++i) p.in[i] = (const float*)d_in[i];
    p.out = (float*)d_out; p.ws = (unsigned char*)d_ws;
#if ONE_LAUNCH
    p.ph_lo = 0; p.ph_hi = N_PHASES;
    if (hipMemsetAsync((char*)d_ws + SM_BAR, 0, XCD_BAR_WORDS * sizeof(unsigned), stream) != hipSuccess) { fprintf(stderr, "memset of the barrier words failed\n"); return; }
    void* args[] = {&p};
    hipError_t e = hipLaunchCooperativeKernel((void*)mega, dim3(grid), dim3(512), args, LDS_BYTES, stream);
    if (e != hipSuccess) fprintf(stderr, "cooperative launch failed: %s (grid %d)\n", hipGetErrorString(e), grid);
#else
    for (int ph = 0; ph < N_PHASES; ++ph) { p.ph_lo = ph; p.ph_hi = ph + 1; hipLaunchKernelGGL(mega, dim3(grid), dim3(512), LDS_BYTES, stream, p); }
#endif
}
```

```cpp
#include <hip/hip_runtime.h>
#include <hip/hip_cooperative_groups.h>
#include <cstdio>
namespace cg = cooperative_groups;

#ifndef PROBE2
#define PROBE2 0
#endif
#define PREP(bit) for (int _r = 0; _r < (((PROBE2 >> (bit)) & 1) ? 2 : 1); ++_r)
#ifndef ONE_LAUNCH
#define ONE_LAUNCH 1
#endif

#define LAS __attribute__((address_space(3)))
typedef unsigned short bf16_t;
typedef short bf16x8 __attribute__((ext_vector_type(8)));
typedef float f32x4 __attribute__((ext_vector_type(4)));
typedef unsigned u32x4 __attribute__((ext_vector_type(4)));
typedef unsigned u32x2 __attribute__((ext_vector_type(2)));

constexpr int DM = 2048, MT = 24576, DFF = 5632, NSUB = MT / 16, NCHK = MT / 64;
constexpr float RMS_EPS = 1e-6f;
constexpr int LDS_BYTES = 147456;
constexpr int LDX = 2048 + 64;

constexpr size_t MiB = (size_t)1 << 20;
constexpr size_t SM_G = 0, SM_Y = 8 * MiB, SM_APOW = 24 * MiB, SM_BBAR = 26 * MiB, SM_KD = 27 * MiB, SM_LWT = 29 * MiB,
                 SM_SA = 30 * MiB, SM_SH = 33 * MiB, SM_CIN = 36 * MiB, SM_LSE = 39 * MiB, SM_RS = 41 * MiB + 512 * 1024, SM_BAR = 41 * MiB + 768 * 1024;
constexpr size_t WS_W = 42 * MiB, WS_H = 122 * MiB, WS_BIG = 222 * MiB, WS_END = 918 * MiB;
constexpr size_t B_XL = WS_BIG, B_GL = WS_BIG + 48 * MiB, B_A2 = WS_BIG + 96 * MiB, B_Q = WS_BIG + 192 * MiB, B_K = WS_BIG + 264 * MiB,
                 B_V = WS_BIG + 336 * MiB, B_GA = WS_BIG + 408 * MiB, B_GB = WS_BIG + 504 * MiB, B_GC = WS_BIG + 600 * MiB;
constexpr size_t B_HID = WS_BIG, B_Y = B_GA, B_Y1 = B_K, B_YATT = B_K + 48 * MiB, B_M = B_A2;
constexpr size_t O_S = 0, O_YS5 = 96 * MiB;
constexpr size_t W_13 = 0, W_2 = (size_t)11264 * LDX;
constexpr size_t W_IN = 0, W_GLU = (size_t)13824 * LDX, W_BRL = W_GLU + 1048576, W_BRS = W_BRL + 2097152, W_BRA = W_BRS + 2097152, W_OUT = W_BRA + 1048576;

struct Params { const float* in[29]; float* out; unsigned char* ws; int ph_lo, ph_hi; };

__device__ const unsigned char BUCKET[3][132] = {
 {11,11,11,11,11,11,11,11,11,11,11,11,11,11,11,10,10,10,10,10,10,10,10,10,10,10,10,10,10,10,10,10,10,10,10,10,10,10,9,9,9,9,9,9,9,9,9,9,9,9,8,8,8,8,8,8,8,7,6,5,4,3,2,1,0,17,18,19,20,21,22,23,24,24,24,24,24,24,24,25,25,25,25,25,25,25,25,25,25,25,25,26,26,26,26,26,26,26,26,26,26,26,26,26,26,26,26,26,26,26,26,26,26,26,27,27,27,27,27,27,27,27,27,27,27,27,27,27,27,0,0,0},
 {13,13,13,13,13,13,13,13,13,13,13,13,13,13,13,13,13,13,13,13,13,13,13,12,12,12,12,12,12,12,12,12,12,12,12,12,12,12,12,12,12,12,11,11,11,11,11,11,11,11,11,11,10,10,10,10,10,10,9,9,9,8,8,4,0,20,24,24,25,25,25,26,26,26,26,26,26,27,27,27,27,27,27,27,27,27,27,28,28,28,28,28,28,28,28,28,28,28,28,28,28,28,28,28,28,28,29,29,29,29,29,29,29,29,29,29,29,29,29,29,29,29,29,29,29,29,29,29,29,0,0,0},
 {15,15,15,15,15,15,15,15,15,15,15,15,15,15,15,15,15,15,15,15,15,15,15,15,15,15,15,15,15,15,14,14,14,14,14,14,14,14,14,14,14,14,14,14,14,13,13,13,13,13,13,13,13,13,12,12,12,12,12,11,11,10,10,9,0,25,26,26,27,27,28,28,28,28,28,29,29,29,29,29,29,29,29,29,30,30,30,30,30,30,30,30,30,30,30,30,30,30,30,31,31,31,31,31,31,31,31,31,31,31,31,31,31,31,31,31,31,31,31,31,31,31,31,31,31,31,31,31,31,0,0,0}};

__device__ __forceinline__ unsigned cvt_pk_bf16(float lo, float hi) { unsigned r; asm("v_cvt_pk_bf16_f32 %0, %1, %2" : "=v"(r) : "v"(lo), "v"(hi)); return r; }
__device__ __forceinline__ bf16_t f2bf(float f) { return (bf16_t)(cvt_pk_bf16(f, 0.f) & 0xffffu); }
__device__ __forceinline__ float bf2f(bf16_t b) { return __uint_as_float(((unsigned)b) << 16); }
__device__ __forceinline__ float bflo(unsigned w) { return __uint_as_float(w << 16); }
__device__ __forceinline__ float bfhi(unsigned w) { return __uint_as_float(w & 0xffff0000u); }
__device__ __forceinline__ float sigm(float x) { return __builtin_amdgcn_rcpf(1.0f + __expf(-x)); }
__device__ __forceinline__ float silu(float x) { return x * sigm(x); }
__device__ __forceinline__ float gelu_t(float x) { return x * sigm(1.5957691216057308f * (x + 0.044715f * x * x * x)); }
__device__ __forceinline__ float wave_sum(float v) {
#pragma unroll
    for (int o = 32; o >= 1; o >>= 1) v += __shfl_xor(v, o);
    return v;
}

__device__ __forceinline__ int ltid() { int t = threadIdx.x; asm volatile("" : "+v"(t)); return t; }
__device__ __forceinline__ int lbid() { int b = blockIdx.x; asm volatile("" : "+s"(b)); return b; }

typedef float f32x2 __attribute__((ext_vector_type(2)));
__device__ __forceinline__ f32x2 exp2_2(f32x2 v) { f32x2 r; r.x = __builtin_amdgcn_exp2f(v.x); r.y = __builtin_amdgcn_exp2f(v.y); return r; }
__device__ __forceinline__ f32x2 rcp_2(f32x2 v) { f32x2 r; r.x = __builtin_amdgcn_rcpf(v.x); r.y = __builtin_amdgcn_rcpf(v.y); return r; }
__device__ __forceinline__ f32x2 swiglu2(f32x2 a, f32x2 b, float rn, float r2) { const f32x2 q = rcp_2(exp2_2(a * rn) + 1.0f); return (a * b) * (q * r2); }
__device__ __forceinline__ f32x2 gelu2(f32x2 v) { const f32x2 z = v * ((v * v) * (-0.10294324f) + (-2.3022082f)); return v * rcp_2(exp2_2(z) + 1.0f); }
__device__ __forceinline__ f32x2 sigm2(f32x2 a, float rn) { return rcp_2(exp2_2(a * rn) + 1.0f); }

constexpr int BM = 256, BK = 64, HALF = 128, HTB = HALF * BK * 2, NXCD = 8, WGM = 8;
__device__ __forceinline__ int lds_byte(int r, int c) { const int st = (r >> 4) * 2 + (c >> 5), rr = r & 15, cc = c & 31, ob = rr * 64 + cc * 2; return st * 1024 + (ob ^ (((ob >> 9) & 1) << 5)); }
__device__ __forceinline__ void stage_rc(int b, int& R, int& C) { const int st = b / 1024, sb = b % 1024, swz = sb ^ (((sb >> 9) & 1) << 5); R = (st >> 1) * 16 + swz / 64; C = (st & 1) * 32 + (swz % 64) / 2; }
__device__ __forceinline__ int perm32(int rho) { const int n = rho >> 4, i = rho & 15; return 8 * (i >> 2) + 4 * n + (i & 3); }

struct Unit { int pm, pn, b; };
struct Gemm { const bf16_t* A; const bf16_t* Bt; int lda, ldb, K, nM, nN, nb; size_t sA, sB; };
struct Order {
    int nM, nN, nwg, tot, G, c, nb;
    __device__ void init(const Gemm& g, int G_, int c_) { nM = g.nM; nN = g.nN; nwg = nM * nN; nb = g.nb; tot = nwg * nb; G = G_; c = c_; }
    __device__ bool next(int i, Unit& u) const {
        const long L = (long)i * G + c; if (L >= tot) return false;
        if (nb > 1) { const int b = (int)(L / nwg), rem = (int)(L % nwg); u.b = b; u.pm = rem % nM; u.pn = rem / nM; return true; }
        int wgid = (int)L; { const int q = nwg / NXCD, r = nwg % NXCD, xcd = wgid % NXCD, off = wgid / NXCD; wgid = (xcd < r ? xcd * (q + 1) : r * (q + 1) + (xcd - r) * q) + off; }
        const int nig = WGM * nN, gid = wgid / nig, fm = gid * WGM, gsz = (nM - fm) < WGM ? (nM - fm) : WGM;
        u.pm = fm + ((wgid % nig) % gsz); u.pn = (wgid % nig) / gsz; u.b = 0; return true;
    }
};

template <class Epi>
__device__ __forceinline__ void gemm_phase(LAS unsigned char* lds, const Gemm g, const Epi& E) {
    Order S; S.init(g, (int)gridDim.x, lbid());
    const int tid = ltid(), wid = __builtin_amdgcn_readfirstlane(tid >> 6), lane = tid & 63, wr = wid >> 2, wc = wid & 3, fr = lane & 15, fq = lane >> 4;
    const int K = g.K, nt = K / BK;
    unsigned voffA[2], voffB[2];
#pragma unroll
    for (int i = 0; i < 2; ++i) { int R, C; stage_rc(tid * 16 + i * 8192, R, C); const int Rb = Epi::PERM ? ((R & ~31) + perm32(R & 31)) : R;
        voffA[i] = (unsigned)(R * g.lda + C) * 2u; voffB[i] = (unsigned)(Rb * g.ldb + C) * 2u; }
    const size_t kstep = (size_t)(BK * 2);
    const size_t hstepA = (size_t)HALF * g.lda * 2, hstepB = (size_t)HALF * g.ldb * 2;
    const size_t tstepA = 2 * hstepA, tstepB = 2 * hstepB;
    const unsigned ldsw = (unsigned)wid * 1024u;
    const int aoff = lds_byte(wr * 64 + fr, fq * 8), boff = lds_byte(wc * 32 + fr, fq * 8);
#define PG8_SA(b, h) (((b) * 2 + (h)) * HTB)
#define PG8_SB(b, h) ((4 + (b) * 2 + (h)) * HTB)
#define PG8_STAGE(bufoff, gbase, voff) do { _Pragma("unroll") for (int _i = 0; _i < 2; ++_i) \
        __builtin_amdgcn_global_load_lds((const unsigned*)((const char*)(gbase) + (voff)[_i]), (LAS unsigned*)(lds + (bufoff) + ldsw + _i * 8192), 16, 0, 0); } while (0)
#define PG8_LDA(dst, b, h) do { _Pragma("unroll") for (int m = 0; m < 4; ++m) _Pragma("unroll") for (int k = 0; k < 2; ++k) dst[m][k] = *(const LAS bf16x8*)(lds + PG8_SA(b, h) + aoff + m * 2048 + k * 1024); } while (0)
#define PG8_LDB(dst, b, h) do { _Pragma("unroll") for (int n = 0; n < 2; ++n) _Pragma("unroll") for (int k = 0; k < 2; ++k) dst[n][k] = *(const LAS bf16x8*)(lds + PG8_SB(b, h) + boff + n * 2048 + k * 1024); } while (0)
#define PG8_MMA(ai, bj, At, Bt) do { __builtin_amdgcn_s_setprio(1); _Pragma("unroll") for (int m = 0; m < 4; ++m) _Pragma("unroll") for (int n = 0; n < 2; ++n) _Pragma("unroll") for (int k = 0; k < 2; ++k) \
        acc[ai][bj][m][n] = __builtin_amdgcn_mfma_f32_16x16x32_bf16(Bt[n][k], At[m][k], acc[ai][bj][m][n], 0, 0, 0); __builtin_amdgcn_s_setprio(0); } while (0)
#define PG8_WAIT_V(n) asm volatile("s_waitcnt vmcnt(" #n ")" ::: "memory")
#define PG8_WAIT_L(n) asm volatile("s_waitcnt lgkmcnt(" #n ")" ::: "memory")
#define PG8_BAR __builtin_amdgcn_s_barrier()
#define PG8_SCHED __builtin_amdgcn_sched_barrier(0)
    Unit cur, nxt; int ui = 0;
    if (!S.next(0, cur)) return;
    f32x4 acc[2][2][4][2];
#pragma unroll
    for (int a = 0; a < 2; ++a)
#pragma unroll
        for (int b = 0; b < 2; ++b)
#pragma unroll
            for (int m = 0; m < 4; ++m)
#pragma unroll
                for (int n = 0; n < 2; ++n) acc[a][b][m][n] = (f32x4){0.f, 0.f, 0.f, 0.f};
    bf16x8 At[4][2], B0[2][2], B1[2][2];
    const char* cA = (const char*)(g.A + (size_t)cur.b * g.sA) + (size_t)cur.pm * tstepA; const char* cB = (const char*)(g.Bt + (size_t)cur.b * g.sB) + (size_t)cur.pn * tstepB;
    float pre[8];
    E.prefetch(pre, cur, wr, fr);
    PG8_STAGE(PG8_SB(0, 0), cB, voffB); PG8_STAGE(PG8_SA(0, 0), cA, voffA); PG8_STAGE(PG8_SB(0, 1), cB + hstepB, voffB); PG8_STAGE(PG8_SA(0, 1), cA + hstepA, voffA);
    if (wr == 1) PG8_BAR;
    PG8_WAIT_V(4); PG8_BAR;
    PG8_STAGE(PG8_SB(1, 0), cB + kstep, voffB); PG8_STAGE(PG8_SA(1, 0), cA + kstep, voffA); PG8_STAGE(PG8_SB(1, 1), cB + hstepB + kstep, voffB);
    PG8_WAIT_V(6); PG8_BAR;
    for (;;) {
        const bool has_next = S.next(ui + 1, nxt);
        const char* nA = has_next ? (const char*)(g.A + (size_t)nxt.b * g.sA) + (size_t)nxt.pm * tstepA : cA; const char* nB = has_next ? (const char*)(g.Bt + (size_t)nxt.b * g.sB) + (size_t)nxt.pn * tstepB : cB;
        for (int t = 0; t < nt; t += 2) {
            const bool last = (t == nt - 2);
            const char* a1 = cA + (size_t)(t + 1) * kstep;
            const char* a2 = last ? nA : cA + (size_t)(t + 2) * kstep; const char* b2 = last ? nB : cB + (size_t)(t + 2) * kstep;
            const char* a3 = a2 + kstep; const char* b3 = b2 + kstep;
            PG8_LDB(B0, 0, 0); PG8_SCHED; PG8_LDA(At, 0, 0); PG8_STAGE(PG8_SA(1, 1), a1 + hstepA, voffA);
            PG8_WAIT_L(8); PG8_BAR; PG8_WAIT_L(0); PG8_MMA(0, 0, At, B0); PG8_BAR; PG8_SCHED;
            PG8_LDB(B1, 0, 1); PG8_STAGE(PG8_SB(0, 0), b2, voffB);
            PG8_BAR; PG8_WAIT_L(0); PG8_MMA(0, 1, At, B1); PG8_BAR;
            PG8_LDA(At, 0, 1); PG8_STAGE(PG8_SA(0, 0), a2, voffA);
            PG8_BAR; PG8_WAIT_L(0); PG8_MMA(1, 0, At, B0); PG8_BAR; PG8_SCHED;
            PG8_STAGE(PG8_SB(0, 1), b2 + hstepB, voffB);
            PG8_WAIT_V(6); PG8_BAR; PG8_MMA(1, 1, At, B1); PG8_BAR;
            PG8_LDB(B0, 1, 0); PG8_SCHED; PG8_LDA(At, 1, 0); PG8_STAGE(PG8_SA(0, 1), a2 + hstepA, voffA);
            PG8_WAIT_L(8); PG8_BAR; PG8_WAIT_L(0); PG8_MMA(0, 0, At, B0); PG8_BAR; PG8_SCHED;
            PG8_LDB(B1, 1, 1); PG8_STAGE(PG8_SB(1, 0), b3, voffB);
            PG8_BAR; PG8_WAIT_L(0); PG8_MMA(0, 1, At, B1); PG8_BAR;
            PG8_LDA(At, 1, 1); PG8_STAGE(PG8_SA(1, 0), a3, voffA);
            PG8_BAR; PG8_WAIT_L(0); PG8_MMA(1, 0, At, B0); PG8_BAR; PG8_SCHED;
            PG8_STAGE(PG8_SB(1, 1), b3 + hstepB, voffB);
            PG8_WAIT_V(6); PG8_BAR; PG8_MMA(1, 1, At, B1); PG8_BAR;
        }
        E(acc, cur, wr, wc, fr, fq, pre);
        if (!has_next) break;
#pragma unroll
        for (int a = 0; a < 2; ++a)
#pragma unroll
            for (int b = 0; b < 2; ++b)
#pragma unroll
                for (int m = 0; m < 4; ++m)
#pragma unroll
                    for (int n = 0; n < 2; ++n) acc[a][b][m][n] = (f32x4){0.f, 0.f, 0.f, 0.f};
        cur = nxt; cA = nA; cB = nB; ++ui;
        E.prefetch(pre, cur, wr, fr);
    }
    PG8_WAIT_V(0);
    if (wr == 0) PG8_BAR;
    PG8_BAR;
#undef PG8_SA
#undef PG8_SB
#undef PG8_STAGE
#undef PG8_LDA
#undef PG8_LDB
#undef PG8_MMA
#undef PG8_WAIT_V
#undef PG8_WAIT_L
#undef PG8_BAR
#undef PG8_SCHED
}

#define GAS __attribute__((address_space(1)))
__device__ __forceinline__ u32x4 gld16(const void* p) { return *(const GAS u32x4*)(unsigned long long)p; }
__device__ __forceinline__ void gst16(void* p, u32x4 v) { *(GAS u32x4*)(unsigned long long)p = v; }
__device__ __forceinline__ void gst16nt(void* p, u32x4 v) { __builtin_nontemporal_store(v, (GAS u32x4*)(unsigned long long)p); }
typedef const f32x4 (&AccRef)[2][2][4][2];
__device__ __forceinline__ u32x4 pack8(f32x4 v0, f32x4 v1) { u32x4 w; w.x = cvt_pk_bf16(v0[0], v0[1]); w.y = cvt_pk_bf16(v0[2], v0[3]); w.z = cvt_pk_bf16(v1[0], v1[1]); w.w = cvt_pk_bf16(v1[2], v1[3]); return w; }
__device__ __forceinline__ void unpack8(u32x4 w, f32x4& v0, f32x4& v1) { v0 = (f32x4){bflo(w.x), bfhi(w.x), bflo(w.y), bfhi(w.y)}; v1 = (f32x4){bflo(w.z), bfhi(w.z), bflo(w.w), bfhi(w.w)}; }

struct EpiSwiglu {
    static constexpr bool PERM = true; bf16_t* O; const float* rs;
    __device__ __forceinline__ void prefetch(float (&pre)[8], const Unit& u, int wr, int fr) const {
#pragma unroll
        for (int i = 0; i < 8; ++i) pre[i] = rs[u.pm * BM + wr * 64 + fr + (i >> 2) * HALF + (i & 3) * 16]; }
    __device__ __forceinline__ void operator()(AccRef acc, const Unit& u, int wr, int wc, int fr, int fq, const float (&pre)[8]) const {
        const int row0 = u.pm * BM + wr * 64 + fr, col = u.pn * 128 + wc * 32 + 8 * fq;
#pragma unroll
        for (int ai = 0; ai < 2; ++ai)
#pragma unroll
            for (int m = 0; m < 4; ++m) {
                f32x4 v0, v1; const float r = pre[ai * 4 + m], rn = r * -1.4426950408889634f, r2 = r * r;
                { const f32x4 a0 = acc[ai][0][m][0], a1 = acc[ai][0][m][1], b0 = acc[ai][1][m][0], b1 = acc[ai][1][m][1];
                  const f32x2 o0 = swiglu2((f32x2){a0[0], a0[1]}, (f32x2){b0[0], b0[1]}, rn, r2), o1 = swiglu2((f32x2){a0[2], a0[3]}, (f32x2){b0[2], b0[3]}, rn, r2);
                  const f32x2 o2 = swiglu2((f32x2){a1[0], a1[1]}, (f32x2){b1[0], b1[1]}, rn, r2), o3 = swiglu2((f32x2){a1[2], a1[3]}, (f32x2){b1[2], b1[3]}, rn, r2);
                  v0 = (f32x4){o0.x, o0.y, o1.x, o1.y}; v1 = (f32x4){o2.x, o2.y, o3.x, o3.y}; }
                gst16nt(O + (size_t)(row0 + ai * HALF + m * 16) * DFF + col, pack8(v0, v1));
            }
    }
};
struct EpiBf16 {
    static constexpr bool PERM = true; bf16_t* O; int ldc;
    __device__ __forceinline__ void prefetch(float (&pre)[8], const Unit&, int, int) const {
#pragma unroll
        for (int i = 0; i < 8; ++i) pre[i] = 0.f; }
    __device__ __forceinline__ void operator()(AccRef acc, const Unit& u, int wr, int wc, int fr, int fq, const float (&pre)[8]) const {
        const int row0 = u.pm * BM + wr * 64 + fr, col0 = u.pn * BM + wc * 32 + 8 * fq;
#pragma unroll
        for (int ai = 0; ai < 2; ++ai)
#pragma unroll
            for (int m = 0; m < 4; ++m)
#pragma unroll
                for (int bj = 0; bj < 2; ++bj)
                    gst16(O + (size_t)(row0 + ai * HALF + m * 16) * ldc + col0 + bj * HALF, pack8(acc[ai][bj][m][0], acc[ai][bj][m][1]));
    }
};
struct EpiWin {
    static constexpr bool PERM = true; unsigned char* ws; const float* rs;
    __device__ __forceinline__ void prefetch(float (&pre)[8], const Unit& u, int wr, int fr) const {
#pragma unroll
        for (int i = 0; i < 8; ++i) pre[i] = rs[u.pm * BM + wr * 64 + fr + (i >> 2) * HALF + (i & 3) * 16]; }
    __device__ __forceinline__ void operator()(AccRef acc, const Unit& u, int wr, int wc, int fr, int fq, const float (&pre)[8]) const {
        const int pn = u.pn; int act, ld, cb; size_t base;
        if (pn < 4) { act = 0; ld = 1024; cb = pn * 256; base = B_XL; }
        else if (pn < 8) { act = 1; ld = 1024; cb = (pn - 4) * 256; base = B_GL; }
        else if (pn < 12) { act = 2; ld = 0; cb = (pn - 8) * 256; base = B_A2; }
        else if (pn < 18) { act = 3; ld = 1536; cb = (pn - 12) * 256; base = B_Q; }
        else if (pn < 24) { act = 0; ld = 1536; cb = (pn - 18) * 256; base = B_K; }
        else if (pn < 30) { act = 0; ld = 1536; cb = (pn - 24) * 256; base = B_V; }
        else if (pn < 38) { act = 4; ld = 2048; cb = (pn - 30) * 256; base = B_GA; }
        else if (pn < 46) { act = 4; ld = 2048; cb = (pn - 38) * 256; base = B_GB; }
        else { act = 4; ld = 2048; cb = (pn - 46) * 256; base = B_GC; }
        bf16_t* O = (bf16_t*)(ws + base);
        const int row0 = u.pm * BM + wr * 64 + fr, col0 = cb + wc * 32 + 8 * fq;
#pragma unroll
        for (int ai = 0; ai < 2; ++ai)
#pragma unroll
            for (int m = 0; m < 4; ++m)
#pragma unroll
                for (int bj = 0; bj < 2; ++bj) {
                    const int row = row0 + ai * HALF + m * 16, col = col0 + bj * HALF;
                    const float r = pre[ai * 4 + m]; f32x4 v0 = acc[ai][bj][m][0], v1 = acc[ai][bj][m][1];
                    if (act == 1) { v0 *= r; v1 *= r;
                        const f32x2 o0 = gelu2((f32x2){v0[0], v0[1]}), o1 = gelu2((f32x2){v0[2], v0[3]}), o2 = gelu2((f32x2){v1[0], v1[1]}), o3 = gelu2((f32x2){v1[2], v1[3]});
                        v0 = (f32x4){o0.x, o0.y, o1.x, o1.y}; v1 = (f32x4){o2.x, o2.y, o3.x, o3.y}; }
                    else if (act == 4) { const float rn = r * -1.4426950408889634f;
                        const f32x2 o0 = sigm2((f32x2){v0[0], v0[1]}, rn), o1 = sigm2((f32x2){v0[2], v0[3]}, rn), o2 = sigm2((f32x2){v1[0], v1[1]}, rn), o3 = sigm2((f32x2){v1[2], v1[3]}, rn);
                        v0 = (f32x4){o0.x, o0.y, o1.x, o1.y}; v1 = (f32x4){o2.x, o2.y, o3.x, o3.y}; }
                    else { const float rr = act == 3 ? r * 0.125f : r; v0 *= rr; v1 *= rr; }
                    size_t off;
                    if (act == 2) off = ((size_t)(col >> 4) * NSUB + (row >> 4)) * 512 + (row & 15) * 16 + (col & 15);
                    else off = (size_t)row * ld + col;
                    gst16nt(O + off, pack8(v0, v1));
                }
    }
};
struct EpiS {
    static constexpr bool PERM = false; float* S;
    __device__ __forceinline__ void prefetch(float (&pre)[8], const Unit&, int, int) const {
#pragma unroll
        for (int i = 0; i < 8; ++i) pre[i] = 0.f; }
    __device__ __forceinline__ void operator()(AccRef acc, const Unit& u, int wr, int wc, int fr, int fq, const float (&pre)[8]) const {
        const int row0 = u.pm * BM + wr * 64 + fr, col0 = wc * 32 + 4 * fq;
        float* base = S + (size_t)u.b * NSUB * 256;
#pragma unroll
        for (int ai = 0; ai < 2; ++ai)
#pragma unroll
            for (int m = 0; m < 4; ++m)
#pragma unroll
                for (int bj = 0; bj < 2; ++bj)
#pragma unroll
                    for (int n = 0; n < 2; ++n)
                        *(f32x4*)(base + (size_t)(row0 + ai * HALF + m * 16) * 256 + col0 + bj * HALF + n * 16) = acc[ai][bj][m][n];
    }
};
struct EpiY {
    static constexpr bool PERM = true; bf16_t* Y1;
    __device__ __forceinline__ void prefetch(float (&pre)[8], const Unit&, int, int) const {
#pragma unroll
        for (int i = 0; i < 8; ++i) pre[i] = 0.f; }
    __device__ __forceinline__ void operator()(AccRef acc, const Unit& u, int wr, int wc, int fr, int fq, const float (&pre)[8]) const {
        const int row0 = u.pm * BM + wr * 64 + fr, n0 = wc * 32 + 8 * fq;
#pragma unroll
        for (int ai = 0; ai < 2; ++ai)
#pragma unroll
            for (int m = 0; m < 4; ++m)
#pragma unroll
                for (int bj = 0; bj < 2; ++bj) {
                    const int j = row0 + ai * HALF + m * 16, nn = n0 + bj * HALF, tok = j * 16 + (nn >> 4);
                    f32x4 v0 = acc[ai][bj][m][0], v1 = acc[ai][bj][m][1];
#pragma unroll
                    for (int q = 0; q < 4; ++q) { v0[q] = gelu_t(v0[q]); v1[q] = gelu_t(v1[q]); }
                    gst16(Y1 + (size_t)tok * 1024 + u.b * 16 + (nn & 15), pack8(v0, v1));
                }
    }
};
struct EpiGlu {
    static constexpr bool PERM = true; const bf16_t* Y1; bf16_t* O; const float* bias;
    __device__ __forceinline__ void prefetch(float (&pre)[8], const Unit&, int, int) const {
#pragma unroll
        for (int i = 0; i < 8; ++i) pre[i] = 0.f; }
    __device__ __forceinline__ void operator()(AccRef acc, const Unit& u, int wr, int wc, int fr, int fq, const float (&pre)[8]) const {
        const int row0 = u.pm * BM + wr * 64 + fr, col0 = u.pn * BM + wc * 32 + 8 * fq;
        f32x4 bv[2][2];
#pragma unroll
        for (int bj = 0; bj < 2; ++bj) { bv[bj][0] = *(const GAS f32x4*)(unsigned long long)(bias + col0 + bj * HALF); bv[bj][1] = *(const GAS f32x4*)(unsigned long long)(bias + col0 + bj * HALF + 4); }
#pragma unroll
        for (int ai = 0; ai < 2; ++ai) {
            u32x4 yv[4][2];
#pragma unroll
            for (int m = 0; m < 4; ++m)
#pragma unroll
                for (int bj = 0; bj < 2; ++bj) yv[m][bj] = gld16(Y1 + (size_t)(row0 + ai * HALF + m * 16) * 1024 + col0 + bj * HALF);
#pragma unroll
            for (int m = 0; m < 4; ++m)
#pragma unroll
                for (int bj = 0; bj < 2; ++bj) {
                    f32x4 y0, y1v; unpack8(yv[m][bj], y0, y1v);
                    f32x4 v0 = acc[ai][bj][m][0] + bv[bj][0], v1 = acc[ai][bj][m][1] + bv[bj][1];
#pragma unroll
                    for (int q = 0; q < 4; ++q) { v0[q] = y0[q] * sigm(v0[q]); v1[q] = y1v[q] * sigm(v1[q]); }
                    gst16(O + (size_t)(row0 + ai * HALF + m * 16) * 1024 + col0 + bj * HALF, pack8(v0, v1));
                }
        }
    }
};
template <bool FIRST> struct EpiMerge {
    static constexpr bool PERM = true; const bf16_t* Gt; bf16_t* Mo;
    __device__ __forceinline__ void prefetch(float (&pre)[8], const Unit&, int, int) const {
#pragma unroll
        for (int i = 0; i < 8; ++i) pre[i] = 0.f; }
    __device__ __forceinline__ void operator()(AccRef acc, const Unit& u, int wr, int wc, int fr, int fq, const float (&pre)[8]) const {
        const int row0 = u.pm * BM + wr * 64 + fr, col0 = u.pn * BM + wc * 32 + 8 * fq;
#pragma unroll
        for (int ai = 0; ai < 2; ++ai) {
            u32x4 gv[4][2], mv[4][2];
#pragma unroll
            for (int m = 0; m < 4; ++m)
#pragma unroll
                for (int bj = 0; bj < 2; ++bj) { const size_t off = (size_t)(row0 + ai * HALF + m * 16) * 2048 + col0 + bj * HALF;
                    gv[m][bj] = gld16(Gt + off); mv[m][bj] = FIRST ? (u32x4){0u, 0u, 0u, 0u} : gld16(Mo + off); }
#pragma unroll
            for (int m = 0; m < 4; ++m)
#pragma unroll
                for (int bj = 0; bj < 2; ++bj) { const size_t off = (size_t)(row0 + ai * HALF + m * 16) * 2048 + col0 + bj * HALF;
                    f32x4 g0, g1; unpack8(gv[m][bj], g0, g1);
                    f32x4 v0 = g0 * acc[ai][bj][m][0], v1 = g1 * acc[ai][bj][m][1];
                    if (!FIRST) { f32x4 p0, p1; unpack8(mv[m][bj], p0, p1); v0 += p0; v1 += p1; }
                    gst16(Mo + off, pack8(v0, v1)); }
        }
    }
};

__device__ void cvt_job(unsigned char* shm, const float* src, bf16_t* dst, int K, int N, int mode, const float* kscale = nullptr, int ldd = 0) {
    if (ldd == 0) ldd = K;
    bf16_t* T = (bf16_t*)shm;
    const int tid = ltid(), bid = lbid(), nkt = K / 64, nnt = N / 256, tot = nkt * nnt;
    for (int t = bid; t < tot; t += gridDim.x) {
        const int nti = t % nnt, kt = t / nnt;
        { const int k = tid >> 3, n8 = (tid & 7) * 8;
          const float* s = src + (size_t)(kt * 64 + k) * N + nti * 256 + n8; const float ks = kscale ? kscale[kt * 64 + k] : 1.0f;
          f32x4 v[8];
#pragma unroll
          for (int q = 0; q < 4; ++q) { v[2 * q] = *(const f32x4*)(s + q * 64); v[2 * q + 1] = *(const f32x4*)(s + q * 64 + 4); }
          asm volatile("" ::: "memory");
#pragma unroll
          for (int q = 0; q < 4; ++q)
#pragma unroll
              for (int j = 0; j < 4; ++j) { T[(q * 64 + n8 + j) * 72 + k] = f2bf(v[2 * q][j] * ks); T[(q * 64 + n8 + 4 + j) * 72 + k] = f2bf(v[2 * q + 1][j] * ks); } }
        __syncthreads();
#pragma unroll
        for (int q = 0; q < 4; ++q) { const int n = q * 64 + (tid >> 3), k8 = (tid & 7) * 8; const int nn = nti * 256 + n;
          const int drow = mode == 0 ? nn : ((nn >> 7) * 256 + (nn & 127) + (mode == 2 ? 128 : 0));
          *(u32x4*)(dst + (size_t)drow * ldd + kt * 64 + k8) = *(const u32x4*)(T + n * 72 + k8); }
        __syncthreads();
    }
}
__device__ void cvt_ffn(const Params& p, unsigned char* shm, int l, int sub) {
    bf16_t* W = (bf16_t*)(p.ws + WS_W); const size_t wo = (size_t)(l * 2 + sub) * DM * DFF;
    const float* gk = p.in[2] + (l * 6 + (sub ? 4 : 0)) * DM;
    cvt_job(shm, p.in[26] + wo, W + W_13, DM, DFF, 1, gk, LDX);
    cvt_job(shm, p.in[27] + wo, W + W_13, DM, DFF, 2, gk, LDX);
    cvt_job(shm, p.in[28] + wo, W + W_2, DFF, DM, 0);
}
__device__ void cvt_mixer(const Params& p, unsigned char* shm, int l) {
    bf16_t* W = (bf16_t*)(p.ws + WS_W);
    cvt_job(shm, p.in[3] + (size_t)l * DM * 13824, W + W_IN, DM, 13824, 0, p.in[2] + (l * 6 + 2) * DM, LDX);
    cvt_job(shm, p.in[19] + (size_t)l * 1024 * 1024, W + W_GLU, 1024, 1024, 0);
    cvt_job(shm, p.in[22] + (size_t)l * 1024 * DM, W + W_BRL, 1024, DM, 0);
    cvt_job(shm, p.in[23] + (size_t)l * 1024 * DM, W + W_BRS, 1024, DM, 0);
    cvt_job(shm, p.in[24] + (size_t)l * 512 * DM, W + W_BRA, 512, DM, 0);
    cvt_job(shm, p.in[25] + (size_t)l * DM * DM, W + W_OUT, DM, DM, 0);
}

__device__ void norm_rows(const Params& p, int mode, float scale, const float* gpost) {
    const int tid = ltid(), bid = lbid(), lane = tid & 63, wid = tid >> 6;
    bf16_t* X = (bf16_t*)(p.ws + WS_H); const bf16_t* Y = (const bf16_t*)(p.ws + B_Y); float* RS = (float*)(p.ws + SM_RS);
    for (int row = bid * 8 + wid; row < MT; row += gridDim.x * 8) {
        f32x4 xv[8];
        if (mode == 0) {
            const float* xr = row < 8192 ? p.in[0] + (size_t)row * DM : p.in[1] + (size_t)(row - 8192) * DM;
#pragma unroll
            for (int c = 0; c < 4; ++c) { xv[2 * c] = *(const f32x4*)(xr + (c * 64 + lane) * 8); xv[2 * c + 1] = *(const f32x4*)(xr + (c * 64 + lane) * 8 + 4); }
            asm volatile("" ::: "memory");
        } else {
            f32x4 yv[8]; float ss = 0.f; u32x4 xw[4], yw[4]; f32x4 gq[8];
#pragma unroll
            for (int c = 0; c < 4; ++c) { xw[c] = *(const u32x4*)(X + (size_t)row * LDX + (c * 64 + lane) * 8); yw[c] = *(const u32x4*)(Y + (size_t)row * DM + (c * 64 + lane) * 8); }
#pragma unroll
            for (int c = 0; c < 4; ++c) { gq[2 * c] = *(const f32x4*)(gpost + (c * 64 + lane) * 8); gq[2 * c + 1] = *(const f32x4*)(gpost + (c * 64 + lane) * 8 + 4); }
            asm volatile("" ::: "memory");
#pragma unroll
            for (int c = 0; c < 4; ++c) { unpack8(xw[c], xv[2 * c], xv[2 * c + 1]); unpack8(yw[c], yv[2 * c], yv[2 * c + 1]); }
#pragma unroll
            for (int c = 0; c < 8; ++c) ss += yv[c][0] * yv[c][0] + yv[c][1] * yv[c][1] + yv[c][2] * yv[c][2] + yv[c][3] * yv[c][3];
            ss = wave_sum(ss);
            const float rs = rsqrtf(ss * (1.0f / DM) + RMS_EPS) * scale;
#pragma unroll
            for (int c = 0; c < 4; ++c) { xv[2 * c] += yv[2 * c] * gq[2 * c] * rs; xv[2 * c + 1] += yv[2 * c + 1] * gq[2 * c + 1] * rs; }
        }
        if (mode == 2) {
#pragma unroll
            for (int c = 0; c < 4; ++c) { *(f32x4*)(p.out + (size_t)row * DM + (c * 64 + lane) * 8) = xv[2 * c]; *(f32x4*)(p.out + (size_t)row * DM + (c * 64 + lane) * 8 + 4) = xv[2 * c + 1]; }
        } else {
            float ss = 0.f;
#pragma unroll
            for (int c = 0; c < 8; ++c) ss += xv[c][0] * xv[c][0] + xv[c][1] * xv[c][1] + xv[c][2] * xv[c][2] + xv[c][3] * xv[c][3];
            ss = wave_sum(ss);
#pragma unroll
            for (int c = 0; c < 4; ++c) *(u32x4*)(X + (size_t)row * LDX + (c * 64 + lane) * 8) = pack8(xv[2 * c], xv[2 * c + 1]);
            if (lane == 0) RS[row] = rsqrtf(ss * (1.0f / DM) + RMS_EPS);
        }
    }
}

__device__ void s5_stage1(const Params& p, int l) {
    float2* Apow = (float2*)(p.ws + SM_APOW); float2* Bbar = (float2*)(p.ws + SM_BBAR);
    for (int idx = lbid() * 512 + ltid(); idx < 8192; idx += gridDim.x * 512) {
        const float lr = p.in[11][l * 8192 + idx], li = p.in[12][l * 8192 + idx], dt = expf(p.in[13][l * 128 + (idx >> 6)]);
        f32x4 br4[4], bi4[4];
#pragma unroll
        for (int c = 0; c < 4; ++c) { br4[c] = *(const f32x4*)(p.in[14] + (size_t)l * 131072 + idx * 16 + c * 4); bi4[c] = *(const f32x4*)(p.in[15] + (size_t)l * 131072 + idx * 16 + c * 4); }
        asm volatile("" ::: "memory");
        float ar = 1.f, ai = 0.f;
        for (int k = 0; k < 18; ++k) { const float mag = expf((float)k * lr * dt); float s, c; sincosf((float)k * li * dt, &s, &c); Apow[idx * 18 + k] = make_float2(mag * c, mag * s); if (k == 1) { ar = mag * c; ai = mag * s; } }
        const float den = lr * lr + li * li, cr = ((ar - 1.0f) * lr + ai * li) / den, ci = (ai * lr - (ar - 1.0f) * li) / den;
#pragma unroll
        for (int c = 0; c < 16; ++c) { const float br = br4[c >> 2][c & 3], bi = bi4[c >> 2][c & 3];
            Bbar[idx * 16 + c] = make_float2(cr * br - ci * bi, cr * bi + ci * br); }
    }
}
__device__ void s5_stage2(const Params& p, int l) {
    const float2* Apow = (const float2*)(p.ws + SM_APOW); const float2* Bbar = (const float2*)(p.ws + SM_BBAR);
    float* Kd = (float*)(p.ws + SM_KD); bf16_t* Gm = (bf16_t*)(p.ws + SM_G); bf16_t* Ym = (bf16_t*)(p.ws + SM_Y); bf16_t* LWT = (bf16_t*)(p.ws + SM_LWT);
    const float* cre = p.in[16] + (size_t)l * 131072; const float* cim = p.in[17] + (size_t)l * 131072;
    const int gs = gridDim.x * 512, t0 = lbid() * 512 + ltid();
    for (int o = t0; o < 524288; o += gs) {
        const int c2 = o & 15, c = (o >> 4) & 15, k = (o >> 8) & 15, dg = o >> 12;
        float acc = 0.f;
        for (int p0 = 0; p0 < 64; p0 += 8) {
            float2 A[8], Bb[8]; float Cr[8], Ci[8];
#pragma unroll
            for (int q = 0; q < 8; ++q) { const int sidx = dg * 64 + p0 + q; A[q] = Apow[sidx * 18 + k]; Bb[q] = Bbar[sidx * 16 + c2]; Cr[q] = cre[(dg * 16 + c) * 64 + p0 + q]; Ci[q] = cim[(dg * 16 + c) * 64 + p0 + q]; }
            asm volatile("" ::: "memory");
#pragma unroll
            for (int q = 0; q < 8; ++q) { const float abr = A[q].x * Bb[q].x - A[q].y * Bb[q].y, abi = A[q].x * Bb[q].y + A[q].y * Bb[q].x; acc += Cr[q] * abr - Ci[q] * abi; }
        }
        Kd[o] = acc;
    }
    for (int ob = t0; ob < 64 * 65536; ob += 4 * gs) {
        float2 A1[4], B1[4], A2v[4]; float Cr[4], Ci[4];
#pragma unroll
        for (int q = 0; q < 4; ++q) { const int o = min(ob + q * gs, 64 * 65536 - 1); const int kk = o & 255, n = (o >> 8) & 255, g = o >> 16;
            { const int d = n >> 7, pp = n & 63, s = kk >> 4, c2 = kk & 15, e = d == 0 ? 15 - s : s; const int sidx = (d * 64 + g) * 64 + pp; A1[q] = Apow[sidx * 18 + e]; B1[q] = Bbar[sidx * 16 + c2]; }
            { const int tau = n >> 4, c = n & 15, d = kk >> 7, pp = kk & 63, e = d == 0 ? tau + 1 : 16 - tau; const int sidx = (d * 64 + g) * 64 + pp;
              A2v[q] = Apow[sidx * 18 + e]; Cr[q] = cre[((d * 64 + g) * 16 + c) * 64 + pp]; Ci[q] = cim[((d * 64 + g) * 16 + c) * 64 + pp]; } }
        asm volatile("" ::: "memory");
#pragma unroll
        for (int q = 0; q < 4; ++q) { const int o = ob + q * gs; if (o >= 64 * 65536) break; const int kk = o & 255, n = (o >> 8) & 255, g = o >> 16;
            Gm[o] = f2bf(((n >> 6) & 1) ? A1[q].x * B1[q].y + A1[q].y * B1[q].x : A1[q].x * B1[q].x - A1[q].y * B1[q].y);
            Ym[((size_t)g * 256 + n) * 512 + 256 + kk] = f2bf(((kk >> 6) & 1) ? -(Cr[q] * A2v[q].y + Ci[q] * A2v[q].x) : Cr[q] * A2v[q].x - Ci[q] * A2v[q].y); }
    }
    for (int o = t0; o < 262144; o += gs) {
        const int i = o & 63, j = (o >> 6) & 63, n = (o >> 12) & 15, gate = (o >> 16) & 1, d = o >> 17;
        const float* src = gate ? p.in[8] : p.in[6];
        LWT[o] = f2bf(src[(size_t)((l * 2 + d) * 16 + n) * 4096 + i * 64 + j]);
    }
}
__device__ void s5_stage3(const Params& p, int l) {
    const float* Kd = (const float*)(p.ws + SM_KD); bf16_t* Ym = (bf16_t*)(p.ws + SM_Y); const float* Dk = p.in[18] + l * 1024;
    const int gs = gridDim.x * 512;
    for (int ob = lbid() * 512 + ltid(); ob < 64 * 65536; ob += 4 * gs) {
        float kf[4], kr[4], dd[4];
#pragma unroll
        for (int q = 0; q < 4; ++q) { const int o = min(ob + q * gs, 64 * 65536 - 1); const int kk = o & 255, n = (o >> 8) & 255, g = o >> 16, s = kk >> 4, c2 = kk & 15, tau = n >> 4, c = n & 15;
            const int df = s <= tau ? tau - s : 0, dr = s >= tau ? s - tau : 0;
            kf[q] = Kd[((0 * 64 + g) * 16 + df) * 256 + c * 16 + c2]; kr[q] = Kd[((1 * 64 + g) * 16 + dr) * 256 + c * 16 + c2]; dd[q] = Dk[g * 16 + c]; }
        asm volatile("" ::: "memory");
#pragma unroll
        for (int q = 0; q < 4; ++q) { const int o = ob + q * gs; if (o >= 64 * 65536) break; const int kk = o & 255, n = (o >> 8) & 255, g = o >> 16, s = kk >> 4, c2 = kk & 15, tau = n >> 4, c = n & 15;
            float v = 0.f; if (s <= tau) v += kf[q]; if (s >= tau) v += kr[q]; if (s == tau && c == c2) v += dd[q];
            Ym[((size_t)g * 256 + n) * 512 + kk] = f2bf(v); }
    }
}
__device__ void s5_bscan(const Params& p, unsigned char* shm) {
    const float2* Apow = (const float2*)(p.ws + SM_APOW); const float* S = (const float*)((const unsigned char*)p.out + O_S); bf16_t* A2 = (bf16_t*)(p.ws + B_A2);
    float2* Es = (float2*)shm;
    const int tid = ltid();
    for (int it = lbid(); it < 192; it += gridDim.x) {
        const bool lng = it < 128;
        const int pp = tid & 63, g = lng ? it >> 1 : it - 128, d = lng ? (it & 1) : ((tid >> 6) & 1), seg = lng ? tid >> 6 : 0, seq = lng ? 4 : tid >> 7;
        const int j0 = lng ? 512 + seg * 128 : seq * 128;
        const float2 A16 = Apow[((d * 64 + g) * 64 + pp) * 18 + 16];
        const float* Sg = S + (size_t)g * NSUB * 256 + d * 128 + pp; bf16_t* Xg = A2 + (size_t)g * NSUB * 512 + 256 + d * 128 + pp;
        float xr = 0.f, xi = 0.f;
        if (lng) {
            for (int jb = 0; jb < 128; jb += 16) {
                float sr[16], si[16];
#pragma unroll
                for (int u = 0; u < 16; ++u) { const int j = d ? (j0 + 127 - (jb + u)) : (j0 + jb + u); sr[u] = Sg[(size_t)j * 256]; si[u] = Sg[(size_t)j * 256 + 64]; }
                asm volatile("" ::: "memory");
#pragma unroll
                for (int u = 0; u < 16; ++u) { const float nr = A16.x * xr - A16.y * xi + sr[u], ni = A16.x * xi + A16.y * xr + si[u]; xr = nr; xi = ni; }
            }
            Es[seg * 64 + pp] = make_float2(xr, xi);
            float2 Ab = A16;
#pragma unroll
            for (int q = 0; q < 7; ++q) Ab = make_float2(Ab.x * Ab.x - Ab.y * Ab.y, 2.0f * Ab.x * Ab.y);
            __syncthreads();
            xr = 0.f; xi = 0.f;
            for (int q = 0; q < 8; ++q) { const int sq = d ? 7 - q : q; const bool use = d ? (sq > seg) : (sq < seg);
                if (use) { const float2 E = Es[sq * 64 + pp]; const float nr = Ab.x * xr - Ab.y * xi + E.x, ni = Ab.x * xi + Ab.y * xr + E.y; xr = nr; xi = ni; } }
        }
        for (int jb = 0; jb < 128; jb += 16) {
            float sr[16], si[16];
#pragma unroll
            for (int u = 0; u < 16; ++u) { const int j = d ? (j0 + 127 - (jb + u)) : (j0 + jb + u); sr[u] = Sg[(size_t)j * 256]; si[u] = Sg[(size_t)j * 256 + 64]; }
            asm volatile("" ::: "memory");
#pragma unroll
            for (int u = 0; u < 16; ++u) { const int j = d ? (j0 + 127 - (jb + u)) : (j0 + jb + u);
                Xg[(size_t)j * 512] = f2bf(xr); Xg[(size_t)j * 512 + 64] = f2bf(xi);
                const float nr = A16.x * xr - A16.y * xi + sr[u], ni = A16.x * xi + A16.y * xr + si[u]; xr = nr; xi = ni; }
        }
        __syncthreads();
    }
}

template <int PASS>
__device__ void lru_items(const Params& p, unsigned char* shm, int l) {
    bf16_t* xraw = (bf16_t*)shm;
    float* xcf = (float*)(shm + 8704);
    bf16_t* xcb = (bf16_t*)(shm + 25344);
    bf16_t* wt = (bf16_t*)(shm + 34560);
    float* As = (float*)(shm + 71424);
    float* Bs = (float*)(shm + 104192);
    float* Pq = (float*)(shm + 136960);
    float* Hq = (float*)(shm + 139008);
    const bf16_t* XL = (const bf16_t*)(p.ws + B_XL); bf16_t* GL = (bf16_t*)(p.ws + B_GL); const bf16_t* LWT = (const bf16_t*)(p.ws + SM_LWT);
    float* SA = (float*)(p.ws + SM_SA); float* SH = (float*)(p.ws + SM_SH); const float* CIN = (const float*)(p.ws + SM_CIN);
    const float* cw = p.in[4] + l * 4096; const float* cbias = p.in[5] + l * 1024;
    const int tid = ltid(), lane = tid & 63, w = tid >> 6, fr = lane & 15, fq = lane >> 4, G_ = gridDim.x, total = NCHK * 16;
    int n_loaded = -1;
    float c0 = 0.f, c1 = 0.f, c2 = 0.f, c3 = 0.f, cb = 0.f, gba[4], gbx[4], gsp[4];
#pragma unroll
    for (int jt = 0; jt < 4; ++jt) { gba[jt] = 0.f; gbx[jt] = 0.f; gsp[jt] = 0.f; }
    u32x4 xr0 = (u32x4){0u, 0u, 0u, 0u}, xr1 = (u32x4){0u, 0u, 0u, 0u};
#define LRU_LOAD(IT) do { const int ck_ = (IT) >> 4, n_ = (IT) & 15, t0_ = ck_ * 64; const int ss_ = t0_ < 8192 ? (t0_ & ~2047) : 8192, se_ = t0_ < 8192 ? ss_ + 2048 : MT; \
        { const int row = tid >> 3, c8 = tid & 7, tok = t0_ - 2 + row; xr0 = (u32x4){0u, 0u, 0u, 0u}; if (tok >= ss_ && tok < se_) xr0 = *(const u32x4*)(XL + (size_t)tok * 1024 + n_ * 64 + c8 * 8); } \
        if (tid < 24) { const int row = 64 + (tid >> 3), c8 = tid & 7, tok = t0_ - 2 + row; xr1 = (u32x4){0u, 0u, 0u, 0u}; if (tok >= ss_ && tok < se_) xr1 = *(const u32x4*)(XL + (size_t)tok * 1024 + n_ * 64 + c8 * 8); } } while (0)
    int it = lbid();
    if (it < total) LRU_LOAD(it);
    for (; it < total; it += G_) {
        const int ck = it >> 4, n = it & 15, t0 = ck * 64;
        *(u32x4*)(xraw + (tid >> 3) * 64 + (tid & 7) * 8) = xr0;
        if (tid < 24) *(u32x4*)(xraw + (64 + (tid >> 3)) * 64 + (tid & 7) * 8) = xr1;
        if (n != n_loaded) {
            n_loaded = n;
#pragma unroll
            for (int i = 0; i < 4; ++i) { const int e = tid + 512 * i, mtx = e >> 9, rem = e & 511, j = rem >> 3, c8 = rem & 7;
                *(u32x4*)(wt + (mtx * 64 + j) * 72 + c8 * 8) = *(const u32x4*)(LWT + ((size_t)(mtx * 16 + n) * 64 + j) * 64 + c8 * 8); }
            { const int ch = n * 64 + (tid & 63); c0 = cw[ch]; c1 = cw[1024 + ch]; c2 = cw[2048 + ch]; c3 = cw[3072 + ch]; cb = cbias[ch]; }
#pragma unroll
            for (int jt = 0; jt < 4; ++jt) { const int pi = (l * 2 + (w >> 2)) * 1024 + n * 64 + jt * 16 + fr; gba[jt] = p.in[7][pi]; gbx[jt] = p.in[9][pi]; gsp[jt] = -8.0f * log1pf(__expf(-p.in[10][pi])); }
        }
        u32x4 glv = (u32x4){0u, 0u, 0u, 0u}; float cin = 0.f;
        const size_t go = (size_t)(t0 + (tid >> 3)) * 1024 + n * 64 + (tid & 7) * 8;
        const size_t so = (size_t)(ck * 2 + ((tid >> 6) & 1)) * 1024 + n * 64 + (tid & 63);
        if (PASS == 1) { glv = *(const u32x4*)(GL + go); cin = CIN[so]; }
        asm volatile("" ::: "memory");
        __syncthreads();
        if (it + G_ < total) LRU_LOAD(it + G_);
        asm volatile("" ::: "memory");
        { const int j = tid & 63;
#pragma unroll
          for (int i = 0; i < 8; ++i) { const int t = (tid >> 6) + 8 * i;
              const float v = cb + bf2f(xraw[t * 64 + j]) * c0 + bf2f(xraw[(t + 1) * 64 + j]) * c1 + bf2f(xraw[(t + 2) * 64 + j]) * c2 + bf2f(xraw[(t + 3) * 64 + j]) * c3;
              xcf[t * 65 + j] = v; xcb[t * 72 + j] = f2bf(v); } }
        __syncthreads();
        { const int d = w >> 2, tt = w & 3;
          const bf16x8 a0 = *(const bf16x8*)(xcb + (tt * 16 + fr) * 72 + fq * 8), a1 = *(const bf16x8*)(xcb + (tt * 16 + fr) * 72 + 32 + fq * 8);
#pragma unroll
          for (int jt = 0; jt < 4; ++jt) {
              f32x4 accr = (f32x4){0.f, 0.f, 0.f, 0.f}, acci = (f32x4){0.f, 0.f, 0.f, 0.f};
              const bf16_t* wr_ = wt + ((d * 2 + 0) * 64 + jt * 16 + fr) * 72 + fq * 8; const bf16_t* wi_ = wt + ((d * 2 + 1) * 64 + jt * 16 + fr) * 72 + fq * 8;
              accr = __builtin_amdgcn_mfma_f32_16x16x32_bf16(a0, *(const bf16x8*)wr_, accr, 0, 0, 0);
              accr = __builtin_amdgcn_mfma_f32_16x16x32_bf16(a1, *(const bf16x8*)(wr_ + 32), accr, 0, 0, 0);
              acci = __builtin_amdgcn_mfma_f32_16x16x32_bf16(a0, *(const bf16x8*)wi_, acci, 0, 0, 0);
              acci = __builtin_amdgcn_mfma_f32_16x16x32_bf16(a1, *(const bf16x8*)(wi_ + 32), acci, 0, 0, 0);
              const int j = jt * 16 + fr;
#pragma unroll
              for (int i = 0; i < 4; ++i) { const int t = tt * 16 + fq * 4 + i;
                  const float r = sigm(accr[i] + gba[jt]), ig = sigm(acci[i] + gbx[jt]), a = __expf(r * gsp[jt]);
                  As[(d * 64 + t) * 64 + j] = a;
                  Bs[(d * 64 + t) * 64 + j] = sqrtf(fmaxf(1.0f - a * a, 0.f)) * ig * xcf[t * 65 + j]; }
          } }
        __syncthreads();
        {
            const int seg = tid >> 7, d = (tid >> 6) & 1, j = tid & 63;
            float h = 0.f, P = 1.f;
#pragma unroll
            for (int s = 0; s < 16; ++s) { const int st = seg * 16 + s, t = d ? 63 - st : st; const float a = As[(d * 64 + t) * 64 + j]; h = a * h + Bs[(d * 64 + t) * 64 + j]; P *= a; }
            Pq[seg * 128 + (tid & 127)] = P; Hq[seg * 128 + (tid & 127)] = h;
            __syncthreads();
            if (PASS == 0) {
                if (tid < 128) { float hh = Hq[tid], PP = Pq[tid];
#pragma unroll
                    for (int q = 1; q < 4; ++q) { const float pq = Pq[q * 128 + tid]; hh = pq * hh + Hq[q * 128 + tid]; PP *= pq; }
                    SA[so] = PP; SH[so] = hh; }
            } else {
                float c = cin;
#pragma unroll
                for (int q = 0; q < 3; ++q) if (q < seg) c = Pq[q * 128 + (tid & 127)] * c + Hq[q * 128 + (tid & 127)];
#pragma unroll
                for (int s = 0; s < 16; ++s) { const int st = seg * 16 + s, t = d ? 63 - st : st; c = As[(d * 64 + t) * 64 + j] * c + Bs[(d * 64 + t) * 64 + j]; Bs[(d * 64 + t) * 64 + j] = c; }
                __syncthreads();
                const int t = tid >> 3, c8 = tid & 7;
                f32x4 g0, g1; unpack8(glv, g0, g1);
                const f32x4 f0 = *(const f32x4*)(Bs + t * 64 + c8 * 8), f1 = *(const f32x4*)(Bs + t * 64 + c8 * 8 + 4), r0 = *(const f32x4*)(Bs + (64 + t) * 64 + c8 * 8), r1 = *(const f32x4*)(Bs + (64 + t) * 64 + c8 * 8 + 4);
                *(u32x4*)(GL + go) = pack8((f0 + r0) * g0, (f1 + r1) * g1);
            }
        }
        __syncthreads();
    }
#undef LRU_LOAD
}
__device__ void lru_carry(const Params& p) {
    const float* SA = (const float*)(p.ws + SM_SA); const float* SH = (const float*)(p.ws + SM_SH); float* CIN = (float*)(p.ws + SM_CIN);
    const int tid_ = ltid();
    for (int it = lbid(); it < 20; it += gridDim.x) {
        const int c = it * 512 + tid_, ch = c & 1023, d = (c >> 10) & 1, seq = c >> 11;
        const int k0 = seq < 4 ? seq * 32 : 128, nk = seq < 4 ? 32 : 256;
        float carry = 0.f;
        for (int kb = 0; kb < nk; kb += 8) {
            float a[8], h[8];
#pragma unroll
            for (int u = 0; u < 8; ++u) { const int k = d ? (k0 + nk - 1 - (kb + u)) : (k0 + kb + u); a[u] = SA[(size_t)(k * 2 + d) * 1024 + ch]; h[u] = SH[(size_t)(k * 2 + d) * 1024 + ch]; }
            asm volatile("" ::: "memory");
#pragma unroll
            for (int u = 0; u < 8; ++u) { const int k = d ? (k0 + nk - 1 - (kb + u)) : (k0 + kb + u); CIN[(size_t)(k * 2 + d) * 1024 + ch] = carry; carry = a[u] * carry + h[u]; }
        }
    }
}

struct AttnGeom { int hd, seq_start, dil, n_lat, r, q0; };
__device__ __forceinline__ AttnGeom attn_geom(int it) {
    AttnGeom G; G.hd = it / 192; const int qt = it % 192;
    int T, lt; if (qt < 64) { G.seq_start = (qt >> 4) * 2048; T = 2048; lt = qt & 15; } else { G.seq_start = 8192; T = 16384; lt = qt - 64; }
    const int g = G.hd >> 3; G.dil = g == 0 ? 1 : (g == 1 ? 4 : 16); G.n_lat = T / G.dil; const int tpr = G.n_lat >> 7; G.r = lt / tpr; G.q0 = (lt % tpr) << 7; return G;
}
__device__ void attn_items(const Params& p, unsigned char* shm) {
    bf16_t* Ks = (bf16_t*)shm;
    bf16_t* Vt = (bf16_t*)(shm + 36864);
    bf16_t* Ps = (bf16_t*)(shm + 77824);
    float* BT = (float*)(shm + 120832);
    bf16_t* Qb = (bf16_t*)(p.ws + B_Q); const bf16_t* Kb = (const bf16_t*)(p.ws + B_K); const bf16_t* Vb = (const bf16_t*)(p.ws + B_V);
    float* LSE = (float*)(p.ws + SM_LSE);
    const int tid = ltid(), lane = tid & 63, w = tid >> 6, fr = lane & 15, fq = lane >> 4, G_ = gridDim.x;
    for (int i = tid; i < 24 * 129; i += 512) { const int hd = i / 129, j = i % 129; BT[hd * 132 + j] = p.in[21][(int)BUCKET[hd >> 3][j] * 24 + hd]; }
    u32x4 kreg[5], vreg[5]; bf16x8 q0r, q1r;
    const int total = 24 * 192;
    int it = lbid();
#define ATT_LOAD(IT) do { const AttnGeom G = attn_geom(IT); \
        _Pragma("unroll") for (int i = 0; i < 5; ++i) { const int e = tid + 512 * i, kk = e >> 3, c8 = e & 7, lat = G.q0 - 64 + kk; const bool ok = e < 2176 && kk < 256 && lat >= 0 && lat < G.n_lat; \
            kreg[i] = (u32x4){0u, 0u, 0u, 0u}; vreg[i] = (u32x4){0u, 0u, 0u, 0u}; \
            if (ok) { const size_t go = (size_t)(G.seq_start + G.r + G.dil * lat) * 1536 + G.hd * 64 + c8 * 8; kreg[i] = *(const u32x4*)(Kb + go); vreg[i] = *(const u32x4*)(Vb + go); } } \
        const size_t qo = (size_t)(G.seq_start + G.r + G.dil * (G.q0 + 16 * w + fr)) * 1536 + G.hd * 64; \
        q0r = *(const bf16x8*)(Qb + qo + fq * 8); q1r = *(const bf16x8*)(Qb + qo + 32 + fq * 8); } while (0)
    if (it < total) ATT_LOAD(it);
    for (; it < total; it += G_) {
        const AttnGeom G = attn_geom(it);
#pragma unroll
        for (int i = 0; i < 5; ++i) { const int e = tid + 512 * i, kk = e >> 3, c8 = e & 7;
            if (e < 2176) {
                if (kk < 256) *(u32x4*)(Ks + kk * 72 + c8 * 8) = kreg[i];
#pragma unroll
                for (int j = 0; j < 8; ++j) Vt[(c8 * 8 + j) * 320 + (kk ^ (c8 << 3))] = (bf16_t)((vreg[i][j >> 1] >> ((j & 1) * 16)) & 0xffffu); } }
        const bf16x8 aq0 = q0r, aq1 = q1r;
        __syncthreads();
        if (it + G_ < total) ATT_LOAD(it + G_);
        asm volatile("" ::: "memory");
        const float* bs = BT + G.hd * 132;
        f32x4 s[9];
#pragma unroll
        for (int kt = 0; kt < 9; ++kt) { const bf16_t* kr = Ks + (16 * w + 16 * kt + fr) * 72 + fq * 8;
            f32x4 a = (f32x4){0.f, 0.f, 0.f, 0.f};
            a = __builtin_amdgcn_mfma_f32_16x16x32_bf16(aq0, *(const bf16x8*)kr, a, 0, 0, 0);
            a = __builtin_amdgcn_mfma_f32_16x16x32_bf16(aq1, *(const bf16x8*)(kr + 32), a, 0, 0, 0); s[kt] = a; }
        float mx[4], ls[4];
#pragma unroll
        for (int i = 0; i < 4; ++i) { const int qi = fq * 4 + i; float m = -3.0e38f;
#pragma unroll
            for (int kt = 0; kt < 9; ++kt) { const int rel = 16 * kt + fr - 64 - qi, klat = G.q0 - 64 + 16 * w + 16 * kt + fr;
                const bool ok = rel >= -64 && rel <= 64 && klat >= 0 && klat < G.n_lat; const int bi = min(max(rel + 64, 0), 128);
                const float v = ok ? s[kt][i] + bs[bi] : -1.0e30f; s[kt][i] = v; m = fmaxf(m, v); }
            m = fmaxf(m, __shfl_xor(m, 1)); m = fmaxf(m, __shfl_xor(m, 2)); m = fmaxf(m, __shfl_xor(m, 4)); m = fmaxf(m, __shfl_xor(m, 8));
            float sum = 0.f;
#pragma unroll
            for (int kt = 0; kt < 9; ++kt) { const float pv = __expf(s[kt][i] - m); s[kt][i] = pv; sum += pv; }
            sum += __shfl_xor(sum, 1); sum += __shfl_xor(sum, 2); sum += __shfl_xor(sum, 4); sum += __shfl_xor(sum, 8);
            mx[i] = m; ls[i] = sum; }
        bf16_t* Pw = Ps + w * 16 * 168;
#pragma unroll
        for (int i = 0; i < 4; ++i) {
#pragma unroll
            for (int kt = 0; kt < 9; ++kt) Pw[(fq * 4 + i) * 168 + 16 * kt + fr] = f2bf(s[kt][i]);
            Pw[(fq * 4 + i) * 168 + 144 + fr] = 0; }
        __syncthreads();
        f32x4 o[4];
#pragma unroll
        for (int nt = 0; nt < 4; ++nt) o[nt] = (f32x4){0.f, 0.f, 0.f, 0.f};
#pragma unroll
        for (int ks = 0; ks < 5; ++ks) { const bf16x8 ap = *(const bf16x8*)(Pw + fr * 168 + ks * 32 + fq * 8);
#pragma unroll
            for (int nt = 0; nt < 4; ++nt) { const int dim = nt * 16 + fr; o[nt] = __builtin_amdgcn_mfma_f32_16x16x32_bf16(ap, *(const bf16x8*)(Vt + dim * 320 + ((16 * w + ks * 32 + fq * 8) ^ ((dim >> 3) << 3))), o[nt], 0, 0, 0); } }
        __syncthreads();
#pragma unroll
        for (int i = 0; i < 4; ++i) { const float inv = 1.0f / ls[i];
#pragma unroll
            for (int nt = 0; nt < 4; ++nt) Pw[(fq * 4 + i) * 168 + nt * 16 + fr] = f2bf(o[nt][i] * inv);
            if (fr == 0) LSE[(size_t)(G.seq_start + G.r + G.dil * (G.q0 + 16 * w + fq * 4 + i)) * 24 + G.hd] = mx[i] + __logf(ls[i]); }
        __syncthreads();
#pragma unroll
        for (int h = 0; h < 2; ++h) { const int c = lane + 64 * h, row = c >> 3, c8 = c & 7;
            *(u32x4*)(Qb + (size_t)(G.seq_start + G.r + G.dil * (G.q0 + 16 * w + row)) * 1536 + G.hd * 64 + c8 * 8) = *(const u32x4*)(Pw + row * 168 + c8 * 8); }
        __syncthreads();
    }
#undef ATT_LOAD
}
__device__ void attn_combine(const Params& p) {
    const bf16_t* Ab = (const bf16_t*)(p.ws + B_Q); const float* LSE = (const float*)(p.ws + SM_LSE); bf16_t* YA = (bf16_t*)(p.ws + B_YATT);
    for (int e = lbid() * 512 + ltid(); e < MT * 64; e += gridDim.x * 512) {
        const int tok = e >> 6, h = (e >> 3) & 7, c8 = e & 7;
        const float l0 = LSE[(size_t)tok * 24 + h], l1 = LSE[(size_t)tok * 24 + 8 + h], l2 = LSE[(size_t)tok * 24 + 16 + h];
        const float m = fmaxf(l0, fmaxf(l1, l2)); float w0 = __expf(l0 - m), w1 = __expf(l1 - m), w2 = __expf(l2 - m); const float inv = 1.0f / (w0 + w1 + w2); w0 *= inv; w1 *= inv; w2 *= inv;
        f32x4 a0, a1, b0, b1, c0, c1;
        const u32x4 ua = *(const u32x4*)(Ab + (size_t)tok * 1536 + h * 64 + c8 * 8), ub = *(const u32x4*)(Ab + (size_t)tok * 1536 + (8 + h) * 64 + c8 * 8), uc = *(const u32x4*)(Ab + (size_t)tok * 1536 + (16 + h) * 64 + c8 * 8);
        asm volatile("" ::: "memory");
        unpack8(ua, a0, a1); unpack8(ub, b0, b1); unpack8(uc, c0, c1);
        *(u32x4*)(YA + (size_t)tok * 512 + h * 64 + c8 * 8) = pack8(a0 * w0 + b0 * w1 + c0 * w2, a1 * w0 + b1 * w1 + c1 * w2);
    }
}


#define XB_TMO      128
#define XB_XCNT(j)  (256  + 64 * (j))
#define XB_XSUB(j)  (1280 + 64 * (j))
#define XB_XGEN(j)  (2304 + 64 * (j))
#define XB_TOP      3328
#define XB_TOPGEN   3392
#define XCD_BAR_WORDS 3456
#define XB_SPIN_CAP (1u << 18)
__device__ __forceinline__ unsigned xb_ld(unsigned* p)              { return __hip_atomic_load(p, __ATOMIC_RELAXED, __HIP_MEMORY_SCOPE_AGENT); }
__device__ __forceinline__ unsigned xb_add(unsigned* p, unsigned v) { return __hip_atomic_fetch_add(p, v, __ATOMIC_RELAXED, __HIP_MEMORY_SCOPE_AGENT); }
__device__ __forceinline__ unsigned xb_xcc_id() { return (unsigned)__builtin_amdgcn_s_getreg((3 << 11) | 20) & 0xFu; }
#define XB_SPIN(cond, bar) do { unsigned _sp = 0; while (cond) { __builtin_amdgcn_s_sleep(1); \
    if ((++_sp & 255u) == 0u) { if (xb_ld(&(bar)[XB_TMO])) break; if (_sp > XB_SPIN_CAP) { atomicAdd(&(bar)[XB_TMO], 1u); break; } } } } while (0)
struct XcdBarrier { unsigned* bar; unsigned x; volatile LAS unsigned* st; };
__device__ __forceinline__ XcdBarrier xcd_barrier_post(unsigned* bar, volatile LAS unsigned* st) {
    XcdBarrier b; b.bar = bar; b.x = xb_xcc_id(); b.st = st;
    if (threadIdx.x == 0) (void)xb_add(&bar[XB_XCNT(b.x)], 1u);
    return b;
}
__device__ __forceinline__ void xcd_barrier_complete(unsigned* bar, unsigned x, unsigned& nloc, unsigned& nx) {
    const unsigned G = gridDim.x * gridDim.y * gridDim.z;
    unsigned sum, cnt, mine, sp = 0u;
    for (;;) {
        sum = 0u; cnt = 0u; mine = 0u;
#pragma unroll
        for (unsigned j = 0; j < 16; ++j) { const unsigned c = xb_ld(&bar[XB_XCNT(j)]); sum += c; cnt += (c > 0u) ? 1u : 0u; mine = (j == x) ? c : mine; }
        if (sum == G) break;
        __builtin_amdgcn_s_sleep(1);
        if ((++sp & 255u) == 0u) { if (xb_ld(&bar[XB_TMO])) break; if (sp > XB_SPIN_CAP) { atomicAdd(&bar[XB_TMO], 1u); break; } }
    }
    nloc = mine > 0u ? mine : 1u; nx = cnt > 0u ? cnt : 1u;
}
__device__ __forceinline__ void xcd_barrier(const XcdBarrier& b) {
    asm volatile("s_waitcnt vmcnt(0)" ::: "memory");
    __syncthreads();
    if (threadIdx.x == 0) {
        unsigned* bar = b.bar;
        __builtin_amdgcn_s_waitcnt(0);
        unsigned nloc = b.st[0], nx = b.st[1];
        if (nloc == 0u) { xcd_barrier_complete(bar, b.x, nloc, nx); b.st[0] = nloc; b.st[1] = nx; }
        const unsigned old = xb_add(&bar[XB_XSUB(b.x)], 1u);
        const unsigned gen = old / nloc;
        if (old + 1u == (gen + 1u) * nloc) {
            __builtin_amdgcn_fence(__ATOMIC_RELEASE, "agent");
            asm volatile("s_waitcnt vmcnt(0)" ::: "memory");
            const unsigned og = xb_add(&bar[XB_TOP], 1u);
            const unsigned tg = og / nx;
            if (og + 1u == (tg + 1u) * nx) xb_add(&bar[XB_TOPGEN], 1u);
            else XB_SPIN(xb_ld(&bar[XB_TOPGEN]) == tg, bar);
            __builtin_amdgcn_fence(__ATOMIC_ACQUIRE, "agent");
            xb_add(&bar[XB_XGEN(b.x)], 1u);
            asm volatile("s_waitcnt vmcnt(0)" ::: "memory");
        } else {
            XB_SPIN(xb_ld(&bar[XB_XGEN(b.x)]) == gen, bar);
            __builtin_amdgcn_fence(__ATOMIC_ACQUIRE, "agent");
            asm volatile("s_waitcnt vmcnt(0)" ::: "memory");
        }
    }
    __syncthreads();
}

__device__ __forceinline__ Gemm mk_gemm(const bf16_t* A, int lda, const bf16_t* Bt, int ldb, int K, int nM, int nN, int nb = 1, size_t sA = 0, size_t sB = 0) {
    Gemm g; g.A = A; g.Bt = Bt; g.lda = lda; g.ldb = ldb; g.K = K; g.nM = nM; g.nN = nN; g.nb = nb; g.sA = sA; g.sB = sB; return g; }

__global__ __launch_bounds__(512, 2) void mega(Params p) {
    extern __shared__ __attribute__((aligned(16))) unsigned char shm[];
    LAS unsigned char* lds = (LAS unsigned char*)shm;
    cg::grid_group grid = cg::this_grid();
    volatile LAS unsigned* xst = (volatile LAS unsigned*)(lds + LDS_BYTES - 16);
    XcdBarrier xb; xb.bar = (unsigned*)(p.ws + SM_BAR); xb.x = 0; xb.st = xst;
    if (p.ph_hi - p.ph_lo > 1) { if (threadIdx.x == 0) { xst[0] = 0u; xst[1] = 0u; } __syncthreads(); xb = xcd_barrier_post((unsigned*)(p.ws + SM_BAR), xst); }
#pragma nounroll
    for (int ph = p.ph_lo; ph < p.ph_hi; ++ph) {
        unsigned char* ws = p.ws; asm volatile("" : "+s"(ws));
        const int l = ph == 0 ? 0 : (ph - 1) / 14, kind = ph == 0 ? 0 : (ph - 1) % 14 + 1;
        bf16_t* W = (bf16_t*)(ws + WS_W); bf16_t* H = (bf16_t*)(ws + WS_H);
        bf16_t* HID = (bf16_t*)(ws + B_HID); bf16_t* Y = (bf16_t*)(ws + B_Y); bf16_t* A2 = (bf16_t*)(ws + B_A2);
        bf16_t* Y1 = (bf16_t*)(ws + B_Y1); bf16_t* Mb = (bf16_t*)(ws + B_M);
        unsigned char* ob = (unsigned char*)p.out; asm volatile("" : "+s"(ob));
        bf16_t* YS5 = (bf16_t*)(ob + O_YS5); const float* RSp = (const float*)(ws + SM_RS);
        const float* ng = p.in[2]; const float* gl_ = ng + l * 6 * DM;
#ifdef PROBE_MASK
        for (int rep = 0, reps = ((PROBE_MASK >> kind) & 1) ? 2 : 1; rep < reps; ++rep)
#endif
        switch (kind) {
        case 0:
            PREP(0) cvt_ffn(p, shm, 0, 0); s5_stage1(p, 0);
            PREP(1) norm_rows(p, 0, 0.f, nullptr);
            break;
        case 1: case 12: {
            EpiSwiglu e; e.O = HID; e.rs = RSp; gemm_phase(lds, mk_gemm(H, LDX, W + W_13, LDX, DM, MT / 256, 44), e);
        } break;
        case 2: case 13: {
            EpiBf16 e; e.O = Y; e.ldc = DM; gemm_phase(lds, mk_gemm(HID, DFF, W + W_2, DFF, DFF, MT / 256, 8), e);
        } break;
        case 3:
            PREP(0) cvt_mixer(p, shm, l);
            s5_stage2(p, l);
            norm_rows(p, 1, 0.5f, gl_ + 1 * DM);
            if ((PROBE2 >> 1) & 1) norm_rows(p, 1, 0.0f, gl_ + 1 * DM);
            break;
        case 4: {
            EpiWin e; e.ws = ws; e.rs = RSp; gemm_phase(lds, mk_gemm(H, LDX, W + W_IN, LDX, DM, MT / 256, 54), e);
        } break;
        case 5: {
            PREP(3) { EpiS e; e.S = (float*)(ob + O_S); gemm_phase(lds, mk_gemm(A2, 512, (const bf16_t*)(ws + SM_G), 256, 256, NSUB / 256, 1, 64, (size_t)NSUB * 512, 65536), e); }
            __syncthreads();
            PREP(4) lru_items<0>(p, shm, l);
            attn_items(p, shm);
        } break;
        case 6:
            PREP(5) { lru_carry(p); s5_bscan(p, shm); attn_combine(p); }
            s5_stage3(p, l);
            break;
        case 7: {
            PREP(3) { EpiY e; e.Y1 = Y1; gemm_phase(lds, mk_gemm(A2, 512, (const bf16_t*)(ws + SM_Y), 512, 512, NSUB / 256, 1, 64, (size_t)NSUB * 512, 131072), e); }
            __syncthreads();
            lru_items<1>(p, shm, l);
        } break;
        case 8: {
            EpiGlu e; e.Y1 = Y1; e.O = YS5; e.bias = p.in[20] + l * 1024; gemm_phase(lds, mk_gemm(Y1, 1024, W + W_GLU, 1024, 1024, MT / 256, 4), e);
        } break;
        case 9: {
            { EpiMerge<true> e; e.Gt = (const bf16_t*)(ws + B_GA); e.Mo = Mb; gemm_phase(lds, mk_gemm((const bf16_t*)(ws + B_GL), 1024, W + W_BRL, 1024, 1024, MT / 256, 8), e); }
            { EpiMerge<false> e; e.Gt = (const bf16_t*)(ws + B_GB); e.Mo = Mb; gemm_phase(lds, mk_gemm(YS5, 1024, W + W_BRS, 1024, 1024, MT / 256, 8), e); }
            { EpiMerge<false> e; e.Gt = (const bf16_t*)(ws + B_GC); e.Mo = Mb; gemm_phase(lds, mk_gemm((const bf16_t*)(ws + B_YATT), 512, W + W_BRA, 512, 512, MT / 256, 8), e); }
        } break;
        case 10: {
            EpiBf16 e; e.O = Y; e.ldc = DM; gemm_phase(lds, mk_gemm(Mb, DM, W + W_OUT, DM, DM, MT / 256, 8), e);
        } break;
        case 11:
            PREP(0) cvt_ffn(p, shm, l, 1);
            norm_rows(p, 1, 1.0f, gl_ + 3 * DM);
            if ((PROBE2 >> 1) & 1) norm_rows(p, 1, 0.0f, gl_ + 3 * DM);
            break;
        default:
            if (l == 0) { PREP(0) cvt_ffn(p, shm, 1, 0); s5_stage1(p, 1); }
            norm_rows(p, l == 0 ? 1 : 2, 0.5f, gl_ + 5 * DM);
            break;
        }
        if (ph + 1 < p.ph_hi) { if (p.ph_hi > 4096) grid.sync(); else xcd_barrier(xb); }
    }
}
constexpr int N_PHASES = 1 + 2 * 14;

extern "C" void kernel_launch(void* const* d_in, const int* in_sizes, int n_in, void* d_out, int out_size, void* d_ws, size_t ws_size, hipStream_t stream) {
    static int grid = 0;
    if (grid == 0) {
        if (n_in != 29 || ws_size < WS_END) { fprintf(stderr, "kernel_launch: need 29 inputs and %zu bytes of workspace (got %d, %zu)\n", (size_t)WS_END, n_in, ws_size); grid = -1; return; }
        if (hipFuncSetAttribute((const void*)mega, hipFuncAttributeMaxDynamicSharedMemorySize, LDS_BYTES) != hipSuccess) { fprintf(stderr, "hipFuncSetAttribute failed\n"); grid = -1; return; }
        int dev = 0, cus = 0, per_cu = 0;
        (void)hipGetDevice(&dev); (void)hipDeviceGetAttribute(&cus, hipDeviceAttributeMultiprocessorCount, dev);
        (void)hipOccupancyMaxActiveBlocksPerMultiprocessor(&per_cu, (const void*)mega, 512, LDS_BYTES);
        if (per_cu < 1) per_cu = 1;
        (void)hipGetLastError();
        grid = cus * 1;
    }
    if (grid < 0) return;
    Params p{};
    for (int i = 0; i < 29; ++i) p.in[i] = (const float*)d_in[i];
    p.out = (float*)d_out; p.ws = (unsigned char*)d_ws;
#if ONE_LAUNCH
    p.ph_lo = 0; p.ph_hi = N_PHASES;
    if (hipMemsetAsync((char*)d_ws + SM_BAR, 0, XCD_BAR_WORDS * sizeof(unsigned), stream) != hipSuccess) { fprintf(stderr, "memset of the barrier words failed\n"); return; }
    void* args[] = {&p};
    hipError_t e = hipLaunchCooperativeKernel((void*)mega, dim3(grid), dim3(512), args, LDS_BYTES, stream);
    if (e != hipSuccess) fprintf(stderr, "cooperative launch failed: %s (grid %d)\n", hipGetErrorString(e), grid);
#else
    for (int ph = 0; ph < N_PHASES; ++ph) { p.ph_lo = ph; p.ph_hi = ph + 1; hipLaunchKernelGGL(mega, dim3(grid), dim3(512), LDS_BYTES, stream, p); }
#endif
}
```

```cpp
#include <hip/hip_runtime.h>
#include <hip/hip_cooperative_groups.h>
#include <cstdio>
namespace cg = cooperative_groups;

#ifndef PROBE2
#define PROBE2 0
#endif
#define PREP(bit) for (int _r = 0; _r < (((PROBE2 >> (bit)) & 1) ? 2 : 1); ++_r)
#ifndef ONE_LAUNCH
#define ONE_LAUNCH 1
#endif

#define LAS __attribute__((address_space(3)))
typedef unsigned short bf16_t;
typedef short bf16x8 __attribute__((ext_vector_type(8)));
typedef float f32x4 __attribute__((ext_vector_type(4)));
typedef unsigned u32x4 __attribute__((ext_vector_type(4)));
typedef unsigned u32x2 __attribute__((ext_vector_type(2)));

constexpr int DM = 2048, MT = 24576, DFF = 5632, NSUB = MT / 16, NCHK = MT / 64;
constexpr float RMS_EPS = 1e-6f;
constexpr int LDS_BYTES = 147456;
constexpr int LDX = 2048 + 64;

constexpr size_t MiB = (size_t)1 << 20;
constexpr size_t SM_G = 0, SM_Y = 8 * MiB, SM_APOW = 24 * MiB, SM_BBAR = 26 * MiB, SM_KD = 27 * MiB, SM_LWT = 29 * MiB,
                 SM_SA = 30 * MiB, SM_SH = 33 * MiB, SM_CIN = 36 * MiB, SM_LSE = 39 * MiB, SM_RS = 41 * MiB + 512 * 1024, SM_BAR = 41 * MiB + 768 * 1024;
constexpr size_t WS_W = 42 * MiB, WS_H = 122 * MiB, WS_BIG = 222 * MiB, WS_END = 918 * MiB;
constexpr size_t B_XL = WS_BIG, B_GL = WS_BIG + 48 * MiB, B_A2 = WS_BIG + 96 * MiB, B_Q = WS_BIG + 192 * MiB, B_K = WS_BIG + 264 * MiB,
                 B_V = WS_BIG + 336 * MiB, B_GA = WS_BIG + 408 * MiB, B_GB = WS_BIG + 504 * MiB, B_GC = WS_BIG + 600 * MiB;
constexpr size_t B_HID = WS_BIG, B_Y = B_GA, B_Y1 = B_K, B_YATT = B_K + 48 * MiB, B_M = B_A2;
constexpr size_t O_S = 0, O_YS5 = 96 * MiB;
constexpr size_t W_13 = 0, W_2 = (size_t)11264 * LDX;
constexpr size_t W_IN = 0, W_GLU = (size_t)13824 * LDX, W_BRL = W_GLU + 1048576, W_BRS = W_BRL + 2097152, W_BRA = W_BRS + 2097152, W_OUT = W_BRA + 1048576;

struct Params { const float* in[29]; float* out; unsigned char* ws; int ph_lo, ph_hi; };

__device__ const unsigned char BUCKET[3][132] = {
 {11,11,11,11,11,11,11,11,11,11,11,11,11,11,11,10,10,10,10,10,10,10,10,10,10,10,10,10,10,10,10,10,10,10,10,10,10,10,9,9,9,9,9,9,9,9,9,9,9,9,8,8,8,8,8,8,8,7,6,5,4,3,2,1,0,17,18,19,20,21,22,23,24,24,24,24,24,24,24,25,25,25,25,25,25,25,25,25,25,25,25,26,26,26,26,26,26,26,26,26,26,26,26,26,26,26,26,26,26,26,26,26,26,26,27,27,27,27,27,27,27,27,27,27,27,27,27,27,27,0,0,0},
 {13,13,13,13,13,13,13,13,13,13,13,13,13,13,13,13,13,13,13,13,13,13,13,12,12,12,12,12,12,12,12,12,12,12,12,12,12,12,12,12,12,12,11,11,11,11,11,11,11,11,11,11,10,10,10,10,10,10,9,9,9,8,8,4,0,20,24,24,25,25,25,26,26,26,26,26,26,27,27,27,27,27,27,27,27,27,27,28,28,28,28,28,28,28,28,28,28,28,28,28,28,28,28,28,28,28,29,29,29,29,29,29,29,29,29,29,29,29,29,29,29,29,29,29,29,29,29,29,29,0,0,0},
 {15,15,15,15,15,15,15,15,15,15,15,15,15,15,15,15,15,15,15,15,15,15,15,15,15,15,15,15,15,15,14,14,14,14,14,14,14,14,14,14,14,14,14,14,14,13,13,13,13,13,13,13,13,13,12,12,12,12,12,11,11,10,10,9,0,25,26,26,27,27,28,28,28,28,28,29,29,29,29,29,29,29,29,29,30,30,30,30,30,30,30,30,30,30,30,30,30,30,30,31,31,31,31,31,31,31,31,31,31,31,31,31,31,31,31,31,31,31,31,31,31,31,31,31,31,31,31,31,31,0,0,0}};

__device__ __forceinline__ unsigned cvt_pk_bf16(float lo, float hi) { unsigned r; asm("v_cvt_pk_bf16_f32 %0, %1, %2" : "=v"(r) : "v"(lo), "v"(hi)); return r; }
__device__ __forceinline__ bf16_t f2bf(float f) { return (bf16_t)(cvt_pk_bf16(f, 0.f) & 0xffffu); }
__device__ __forceinline__ float bf2f(bf16_t b) { return __uint_as_float(((unsigned)b) << 16); }
__device__ __forceinline__ float bflo(unsigned w) { return __uint_as_float(w << 16); }
__device__ __forceinline__ float bfhi(unsigned w) { return __uint_as_float(w & 0xffff0000u); }
__device__ __forceinline__ float sigm(float x) { return __builtin_amdgcn_rcpf(1.0f + __expf(-x)); }
__device__ __forceinline__ float silu(float x) { return x * sigm(x); }
__device__ __forceinline__ float gelu_t(float x) { return x * sigm(1.5957691216057308f * (x + 0.044715f * x * x * x)); }
__device__ __forceinline__ float wave_sum(float v) {
#pragma unroll
    for (int o = 32; o >= 1; o >>= 1) v += __shfl_xor(v, o);
    return v;
}

__device__ __forceinline__ int ltid() { int t = threadIdx.x; asm volatile("" : "+v"(t)); return t; }
__device__ __forceinline__ int lbid() { int b = blockIdx.x; asm volatile("" : "+s"(b)); return b; }

typedef float f32x2 __attribute__((ext_vector_type(2)));
__device__ __forceinline__ f32x2 exp2_2(f32x2 v) { f32x2 r; r.x = __builtin_amdgcn_exp2f(v.x); r.y = __builtin_amdgcn_exp2f(v.y); return r; }
__device__ __forceinline__ f32x2 rcp_2(f32x2 v) { f32x2 r; r.x = __builtin_amdgcn_rcpf(v.x); r.y = __builtin_amdgcn_rcpf(v.y); return r; }
__device__ __forceinline__ f32x2 swiglu2(f32x2 a, f32x2 b, float rn, float r2) { const f32x2 q = rcp_2(exp2_2(a * rn) + 1.0f); return (a * b) * (q * r2); }
__device__ __forceinline__ f32x2 gelu2(f32x2 v) { const f32x2 z = v * ((v * v) * (-0.10294324f) + (-2.3022082f)); return v * rcp_2(exp2_2(z) + 1.0f); }
__device__ __forceinline__ f32x2 sigm2(f32x2 a, float rn) { return rcp_2(exp2_2(a * rn) + 1.0f); }

constexpr int BM = 256, BK = 64, HALF = 128, HTB = HALF * BK * 2, NXCD = 8, WGM = 8;
__device__ __forceinline__ int lds_byte(int r, int c) { const int st = (r >> 4) * 2 + (c >> 5), rr = r & 15, cc = c & 31, ob = rr * 64 + cc * 2; return st * 1024 + (ob ^ (((ob >> 9) & 1) << 5)); }
__device__ __forceinline__ void stage_rc(int b, int& R, int& C) { const int st = b / 1024, sb = b % 1024, swz = sb ^ (((sb >> 9) & 1) << 5); R = (st >> 1) * 16 + swz / 64; C = (st & 1) * 32 + (swz % 64) / 2; }
__device__ __forceinline__ int perm32(int rho) { const int n = rho >> 4, i = rho & 15; return 8 * (i >> 2) + 4 * n + (i & 3); }

struct Unit { int pm, pn, b; };
struct Gemm { const bf16_t* A; const bf16_t* Bt; int lda, ldb, K, nM, nN, nb; size_t sA, sB; };
struct Order {
    int nM, nN, nwg, tot, G, c, nb;
    __device__ void init(const Gemm& g, int G_, int c_) { nM = g.nM; nN = g.nN; nwg = nM * nN; nb = g.nb; tot = nwg * nb; G = G_; c = c_; }
    __device__ bool next(int i, Unit& u) const {
        const long L = (long)i * G + c; if (L >= tot) return false;
        if (nb > 1) { const int b = (int)(L / nwg), rem = (int)(L % nwg); u.b = b; u.pm = rem % nM; u.pn = rem / nM; return true; }
        int wgid = (int)L; { const int q = nwg / NXCD, r = nwg % NXCD, xcd = wgid % NXCD, off = wgid / NXCD; wgid = (xcd < r ? xcd * (q + 1) : r * (q + 1) + (xcd - r) * q) + off; }
        const int nig = WGM * nN, gid = wgid / nig, fm = gid * WGM, gsz = (nM - fm) < WGM ? (nM - fm) : WGM;
        u.pm = fm + ((wgid % nig) % gsz); u.pn = (wgid % nig) / gsz; u.b = 0; return true;
    }
};

__device__ __forceinline__ unsigned hw_xcc_id() { return (unsigned)__builtin_amdgcn_s_getreg((3 << 11) | 20) & 0xFu; }
template <class Epi, bool DYN = false>
__device__ __forceinline__ void gemm_phase(LAS unsigned char* lds, const Gemm g, const Epi& E, unsigned* ctr = nullptr) {
    Order S; S.init(g, (int)gridDim.x, lbid());
    const int tid = ltid(), wid = __builtin_amdgcn_readfirstlane(tid >> 6), lane = tid & 63, wr = wid >> 2, wc = wid & 3, fr = lane & 15, fq = lane >> 4;
    const int K = g.K, nt = K / BK;
    unsigned voffA[2], voffB[2];
#pragma unroll
    for (int i = 0; i < 2; ++i) { int R, C; stage_rc(tid * 16 + i * 8192, R, C); const int Rb = Epi::PERM ? ((R & ~31) + perm32(R & 31)) : R;
        voffA[i] = (unsigned)(R * g.lda + C) * 2u; voffB[i] = (unsigned)(Rb * g.ldb + C) * 2u; }
    const size_t kstep = (size_t)(BK * 2);
    const size_t hstepA = (size_t)HALF * g.lda * 2, hstepB = (size_t)HALF * g.ldb * 2;
    const size_t tstepA = 2 * hstepA, tstepB = 2 * hstepB;
    const unsigned ldsw = (unsigned)wid * 1024u;
    const int aoff = lds_byte(wr * 64 + fr, fq * 8), boff = lds_byte(wc * 32 + fr, fq * 8);
#define PG8_SA(b, h) (((b) * 2 + (h)) * HTB)
#define PG8_SB(b, h) ((4 + (b) * 2 + (h)) * HTB)
#define PG8_STAGE(bufoff, gbase, voff) do { _Pragma("unroll") for (int _i = 0; _i < 2; ++_i) \
        __builtin_amdgcn_global_load_lds((const unsigned*)((const char*)(gbase) + (voff)[_i]), (LAS unsigned*)(lds + (bufoff) + ldsw + _i * 8192), 16, 0, 0); } while (0)
#define PG8_LDA(dst, b, h) do { _Pragma("unroll") for (int m = 0; m < 4; ++m) _Pragma("unroll") for (int k = 0; k < 2; ++k) dst[m][k] = *(const LAS bf16x8*)(lds + PG8_SA(b, h) + aoff + m * 2048 + k * 1024); } while (0)
#define PG8_LDB(dst, b, h) do { _Pragma("unroll") for (int n = 0; n < 2; ++n) _Pragma("unroll") for (int k = 0; k < 2; ++k) dst[n][k] = *(const LAS bf16x8*)(lds + PG8_SB(b, h) + boff + n * 2048 + k * 1024); } while (0)
#define PG8_MMA(ai, bj, At, Bt) do { __builtin_amdgcn_s_setprio(1); _Pragma("unroll") for (int m = 0; m < 4; ++m) _Pragma("unroll") for (int n = 0; n < 2; ++n) _Pragma("unroll") for (int k = 0; k < 2; ++k) \
        acc[ai][bj][m][n] = __builtin_amdgcn_mfma_f32_16x16x32_bf16(Bt[n][k], At[m][k], acc[ai][bj][m][n], 0, 0, 0); __builtin_amdgcn_s_setprio(0); } while (0)
#define PG8_WAIT_V(n) asm volatile("s_waitcnt vmcnt(" #n ")" ::: "memory")
#define PG8_WAIT_L(n) asm volatile("s_waitcnt lgkmcnt(" #n ")" ::: "memory")
#define PG8_BAR __builtin_amdgcn_s_barrier()
#define PG8_SCHED __builtin_amdgcn_sched_barrier(0)
    Unit cur, nxt; int ui = 0;
    LAS int* slot = (LAS int*)(lds + 131072 + 64);
    const int xcd = (int)(hw_xcc_id() & 7u); int ticket = 0;
    auto rng_cnt = [&](int x) { const int q = S.nwg / NXCD, r = S.nwg % NXCD; return q + (x < r ? 1 : 0); };
    auto rng_start = [&](int x) { const int q = S.nwg / NXCD, r = S.nwg % NXCD; return x < r ? x * (q + 1) : r * (q + 1) + (x - r) * q; };
    auto decode = [&](int wgid, Unit& u) { const int nig = WGM * S.nN, gid = wgid / nig, fm = gid * WGM, gsz = (S.nM - fm) < WGM ? (S.nM - fm) : WGM; u.pm = fm + ((wgid % nig) % gsz); u.pn = (wgid % nig) / gsz; u.b = 0; };
    auto issue = [&]() { if (tid == 0) ticket = (int)__hip_atomic_fetch_add(ctr + xcd * 16, 1u, __ATOMIC_RELAXED, __HIP_MEMORY_SCOPE_AGENT); };
    auto publish = [&](int si) { if (tid == 0) { int wg = -1;
            if (ticket < rng_cnt(xcd)) wg = rng_start(xcd) + ticket;
            else { for (int k = 1; k < 8; ++k) { const int x2 = (xcd + k) & 7; const int t2 = (int)__hip_atomic_fetch_add(ctr + x2 * 16, 1u, __ATOMIC_RELAXED, __HIP_MEMORY_SCOPE_AGENT); if (t2 < rng_cnt(x2)) { wg = rng_start(x2) + t2; break; } } }
            slot[si] = wg; } };
    if (DYN) { issue(); publish(0); __syncthreads(); const int w0 = __builtin_amdgcn_readfirstlane(slot[0]); if (w0 < 0) return; decode(w0, cur); issue(); }
    else if (!S.next(0, cur)) return;
    f32x4 acc[2][2][4][2];
#pragma unroll
    for (int a = 0; a < 2; ++a)
#pragma unroll
        for (int b = 0; b < 2; ++b)
#pragma unroll
            for (int m = 0; m < 4; ++m)
#pragma unroll
                for (int n = 0; n < 2; ++n) acc[a][b][m][n] = (f32x4){0.f, 0.f, 0.f, 0.f};
    bf16x8 At[4][2], B0[2][2], B1[2][2];
    const char* cA = (const char*)(g.A + (size_t)cur.b * g.sA) + (size_t)cur.pm * tstepA; const char* cB = (const char*)(g.Bt + (size_t)cur.b * g.sB) + (size_t)cur.pn * tstepB;
    float pre[8];
    E.prefetch(pre, cur, wr, fr);
    PG8_STAGE(PG8_SB(0, 0), cB, voffB); PG8_STAGE(PG8_SA(0, 0), cA, voffA); PG8_STAGE(PG8_SB(0, 1), cB + hstepB, voffB); PG8_STAGE(PG8_SA(0, 1), cA + hstepA, voffA);
    if (wr == 1) PG8_BAR;
    PG8_WAIT_V(4); PG8_BAR;
    PG8_STAGE(PG8_SB(1, 0), cB + kstep, voffB); PG8_STAGE(PG8_SA(1, 0), cA + kstep, voffA); PG8_STAGE(PG8_SB(1, 1), cB + hstepB + kstep, voffB);
    PG8_WAIT_V(6); PG8_BAR;
    for (;;) {
        bool has_next = DYN ? false : S.next(ui + 1, nxt);
        const char* nA = has_next ? (const char*)(g.A + (size_t)nxt.b * g.sA) + (size_t)nxt.pm * tstepA : cA; const char* nB = has_next ? (const char*)(g.Bt + (size_t)nxt.b * g.sB) + (size_t)nxt.pn * tstepB : cB;
        for (int t = 0; t < nt; t += 2) {
            const bool last = (t == nt - 2);
            if (DYN && last) { const int nw = __builtin_amdgcn_readfirstlane(slot[(ui + 1) & 1]); has_next = nw >= 0;
                if (has_next) { decode(nw, nxt); nA = (const char*)g.A + (size_t)nxt.pm * tstepA; nB = (const char*)g.Bt + (size_t)nxt.pn * tstepB; } }
            const char* a1 = cA + (size_t)(t + 1) * kstep;
            const char* a2 = last ? nA : cA + (size_t)(t + 2) * kstep; const char* b2 = last ? nB : cB + (size_t)(t + 2) * kstep;
            const char* a3 = a2 + kstep; const char* b3 = b2 + kstep;
            PG8_LDB(B0, 0, 0); PG8_SCHED; PG8_LDA(At, 0, 0); PG8_STAGE(PG8_SA(1, 1), a1 + hstepA, voffA);
            PG8_WAIT_L(8); PG8_BAR; PG8_WAIT_L(0); PG8_MMA(0, 0, At, B0); PG8_BAR; PG8_SCHED;
            PG8_LDB(B1, 0, 1); PG8_STAGE(PG8_SB(0, 0), b2, voffB);
            PG8_BAR; PG8_WAIT_L(0); PG8_MMA(0, 1, At, B1); PG8_BAR;
            PG8_LDA(At, 0, 1); PG8_STAGE(PG8_SA(0, 0), a2, voffA);
            PG8_BAR; PG8_WAIT_L(0); PG8_MMA(1, 0, At, B0); PG8_BAR; PG8_SCHED;
            PG8_STAGE(PG8_SB(0, 1), b2 + hstepB, voffB);
            PG8_WAIT_V(6); PG8_BAR; PG8_MMA(1, 1, At, B1); PG8_BAR;
            PG8_LDB(B0, 1, 0); PG8_SCHED; PG8_LDA(At, 1, 0); PG8_STAGE(PG8_SA(0, 1), a2 + hstepA, voffA);
            PG8_WAIT_L(8); PG8_BAR; PG8_WAIT_L(0); PG8_MMA(0, 0, At, B0); PG8_BAR; PG8_SCHED;
            PG8_LDB(B1, 1, 1); PG8_STAGE(PG8_SB(1, 0), b3, voffB);
            PG8_BAR; PG8_WAIT_L(0); PG8_MMA(0, 1, At, B1); PG8_BAR;
            PG8_LDA(At, 1, 1); PG8_STAGE(PG8_SA(1, 0), a3, voffA);
            PG8_BAR; PG8_WAIT_L(0); PG8_MMA(1, 0, At, B0); PG8_BAR; PG8_SCHED;
            if (DYN && t == 0) publish((ui + 1) & 1);
            PG8_STAGE(PG8_SB(1, 1), b3 + hstepB, voffB);
            PG8_WAIT_V(6); PG8_BAR; PG8_MMA(1, 1, At, B1); PG8_BAR;
        }
        E(acc, cur, wr, wc, fr, fq, pre);
        if (!has_next) break;
#pragma unroll
        for (int a = 0; a < 2; ++a)
#pragma unroll
            for (int b = 0; b < 2; ++b)
#pragma unroll
                for (int m = 0; m < 4; ++m)
#pragma unroll
                    for (int n = 0; n < 2; ++n) acc[a][b][m][n] = (f32x4){0.f, 0.f, 0.f, 0.f};
        cur = nxt; cA = nA; cB = nB; ++ui;
        if (DYN) issue();
        E.prefetch(pre, cur, wr, fr);
    }
    PG8_WAIT_V(0);
    if (wr == 0) PG8_BAR;
    PG8_BAR;
#undef PG8_SA
#undef PG8_SB
#undef PG8_STAGE
#undef PG8_LDA
#undef PG8_LDB
#undef PG8_MMA
#undef PG8_WAIT_V
#undef PG8_WAIT_L
#undef PG8_BAR
#undef PG8_SCHED
}

#define GAS __attribute__((address_space(1)))
__device__ __forceinline__ u32x4 gld16(const void* p) { return *(const GAS u32x4*)(unsigned long long)p; }
__device__ __forceinline__ void gst16(void* p, u32x4 v) { *(GAS u32x4*)(unsigned long long)p = v; }
__device__ __forceinline__ void gst16nt(void* p, u32x4 v) { __builtin_nontemporal_store(v, (GAS u32x4*)(unsigned long long)p); }
typedef const f32x4 (&AccRef)[2][2][4][2];
__device__ __forceinline__ u32x4 pack8(f32x4 v0, f32x4 v1) { u32x4 w; w.x = cvt_pk_bf16(v0[0], v0[1]); w.y = cvt_pk_bf16(v0[2], v0[3]); w.z = cvt_pk_bf16(v1[0], v1[1]); w.w = cvt_pk_bf16(v1[2], v1[3]); return w; }
__device__ __forceinline__ void unpack8(u32x4 w, f32x4& v0, f32x4& v1) { v0 = (f32x4){bflo(w.x), bfhi(w.x), bflo(w.y), bfhi(w.y)}; v1 = (f32x4){bflo(w.z), bfhi(w.z), bflo(w.w), bfhi(w.w)}; }

struct EpiSwiglu {
    static constexpr bool PERM = true; bf16_t* O; const float* rs;
    __device__ __forceinline__ void prefetch(float (&pre)[8], const Unit& u, int wr, int fr) const {
#pragma unroll
        for (int i = 0; i < 8; ++i) pre[i] = rs[u.pm * BM + wr * 64 + fr + (i >> 2) * HALF + (i & 3) * 16]; }
    __device__ __forceinline__ void operator()(AccRef acc, const Unit& u, int wr, int wc, int fr, int fq, const float (&pre)[8]) const {
        const int row0 = u.pm * BM + wr * 64 + fr, col = u.pn * 128 + wc * 32 + 8 * fq;
#pragma unroll
        for (int ai = 0; ai < 2; ++ai)
#pragma unroll
            for (int m = 0; m < 4; ++m) {
                f32x4 v0, v1; const float r = pre[ai * 4 + m], rn = r * -1.4426950408889634f, r2 = r * r;
                { const f32x4 a0 = acc[ai][0][m][0], a1 = acc[ai][0][m][1], b0 = acc[ai][1][m][0], b1 = acc[ai][1][m][1];
                  const f32x2 o0 = swiglu2((f32x2){a0[0], a0[1]}, (f32x2){b0[0], b0[1]}, rn, r2), o1 = swiglu2((f32x2){a0[2], a0[3]}, (f32x2){b0[2], b0[3]}, rn, r2);
                  const f32x2 o2 = swiglu2((f32x2){a1[0], a1[1]}, (f32x2){b1[0], b1[1]}, rn, r2), o3 = swiglu2((f32x2){a1[2], a1[3]}, (f32x2){b1[2], b1[3]}, rn, r2);
                  v0 = (f32x4){o0.x, o0.y, o1.x, o1.y}; v1 = (f32x4){o2.x, o2.y, o3.x, o3.y}; }
                gst16nt(O + (size_t)(row0 + ai * HALF + m * 16) * DFF + col, pack8(v0, v1));
            }
    }
};
struct EpiBf16 {
    static constexpr bool PERM = true; bf16_t* O; int ldc;
    __device__ __forceinline__ void prefetch(float (&pre)[8], const Unit&, int, int) const {
#pragma unroll
        for (int i = 0; i < 8; ++i) pre[i] = 0.f; }
    __device__ __forceinline__ void operator()(AccRef acc, const Unit& u, int wr, int wc, int fr, int fq, const float (&pre)[8]) const {
        const int row0 = u.pm * BM + wr * 64 + fr, col0 = u.pn * BM + wc * 32 + 8 * fq;
#pragma unroll
        for (int ai = 0; ai < 2; ++ai)
#pragma unroll
            for (int m = 0; m < 4; ++m)
#pragma unroll
                for (int bj = 0; bj < 2; ++bj)
                    gst16(O + (size_t)(row0 + ai * HALF + m * 16) * ldc + col0 + bj * HALF, pack8(acc[ai][bj][m][0], acc[ai][bj][m][1]));
    }
};
struct EpiWin {
    static constexpr bool PERM = true; unsigned char* ws; const float* rs;
    __device__ __forceinline__ void prefetch(float (&pre)[8], const Unit& u, int wr, int fr) const {
#pragma unroll
        for (int i = 0; i < 8; ++i) pre[i] = rs[u.pm * BM + wr * 64 + fr + (i >> 2) * HALF + (i & 3) * 16]; }
    __device__ __forceinline__ void operator()(AccRef acc, const Unit& u, int wr, int wc, int fr, int fq, const float (&pre)[8]) const {
        const int pn = u.pn; int act, ld, cb; size_t base;
        if (pn < 4) { act = 0; ld = 1024; cb = pn * 256; base = B_XL; }
        else if (pn < 8) { act = 1; ld = 1024; cb = (pn - 4) * 256; base = B_GL; }
        else if (pn < 12) { act = 2; ld = 0; cb = (pn - 8) * 256; base = B_A2; }
        else if (pn < 18) { act = 3; ld = 1536; cb = (pn - 12) * 256; base = B_Q; }
        else if (pn < 24) { act = 0; ld = 1536; cb = (pn - 18) * 256; base = B_K; }
        else if (pn < 30) { act = 0; ld = 1536; cb = (pn - 24) * 256; base = B_V; }
        else if (pn < 38) { act = 4; ld = 2048; cb = (pn - 30) * 256; base = B_GA; }
        else if (pn < 46) { act = 4; ld = 2048; cb = (pn - 38) * 256; base = B_GB; }
        else { act = 4; ld = 2048; cb = (pn - 46) * 256; base = B_GC; }
        bf16_t* O = (bf16_t*)(ws + base);
        const int row0 = u.pm * BM + wr * 64 + fr, col0 = cb + wc * 32 + 8 * fq;
#pragma unroll
        for (int ai = 0; ai < 2; ++ai)
#pragma unroll
            for (int m = 0; m < 4; ++m)
#pragma unroll
                for (int bj = 0; bj < 2; ++bj) {
                    const int row = row0 + ai * HALF + m * 16, col = col0 + bj * HALF;
                    const float r = pre[ai * 4 + m]; f32x4 v0 = acc[ai][bj][m][0], v1 = acc[ai][bj][m][1];
                    if (act == 1) { v0 *= r; v1 *= r;
                        const f32x2 o0 = gelu2((f32x2){v0[0], v0[1]}), o1 = gelu2((f32x2){v0[2], v0[3]}), o2 = gelu2((f32x2){v1[0], v1[1]}), o3 = gelu2((f32x2){v1[2], v1[3]});
                        v0 = (f32x4){o0.x, o0.y, o1.x, o1.y}; v1 = (f32x4){o2.x, o2.y, o3.x, o3.y}; }
                    else if (act == 4) { const float rn = r * -1.4426950408889634f;
                        const f32x2 o0 = sigm2((f32x2){v0[0], v0[1]}, rn), o1 = sigm2((f32x2){v0[2], v0[3]}, rn), o2 = sigm2((f32x2){v1[0], v1[1]}, rn), o3 = sigm2((f32x2){v1[2], v1[3]}, rn);
                        v0 = (f32x4){o0.x, o0.y, o1.x, o1.y}; v1 = (f32x4){o2.x, o2.y, o3.x, o3.y}; }
                    else { const float rr = act == 3 ? r * 0.125f : r; v0 *= rr; v1 *= rr; }
                    size_t off;
                    if (act == 2) off = ((size_t)(col >> 4) * NSUB + (row >> 4)) * 512 + (row & 15) * 16 + (col & 15);
                    else off = (size_t)row * ld + col;
                    gst16nt(O + off, pack8(v0, v1));
                }
    }
};
struct EpiS {
    static constexpr bool PERM = false; float* S;
    __device__ __forceinline__ void prefetch(float (&pre)[8], const Unit&, int, int) const {
#pragma unroll
        for (int i = 0; i < 8; ++i) pre[i] = 0.f; }
    __device__ __forceinline__ void operator()(AccRef acc, const Unit& u, int wr, int wc, int fr, int fq, const float (&pre)[8]) const {
        const int row0 = u.pm * BM + wr * 64 + fr, col0 = wc * 32 + 4 * fq;
        float* base = S + (size_t)u.b * NSUB * 256;
#pragma unroll
        for (int ai = 0; ai < 2; ++ai)
#pragma unroll
            for (int m = 0; m < 4; ++m)
#pragma unroll
                for (int bj = 0; bj < 2; ++bj)
#pragma unroll
                    for (int n = 0; n < 2; ++n)
                        *(f32x4*)(base + (size_t)(row0 + ai * HALF + m * 16) * 256 + col0 + bj * HALF + n * 16) = acc[ai][bj][m][n];
    }
};
struct EpiY {
    static constexpr bool PERM = true; bf16_t* Y1;
    __device__ __forceinline__ void prefetch(float (&pre)[8], const Unit&, int, int) const {
#pragma unroll
        for (int i = 0; i < 8; ++i) pre[i] = 0.f; }
    __device__ __forceinline__ void operator()(AccRef acc, const Unit& u, int wr, int wc, int fr, int fq, const float (&pre)[8]) const {
        const int row0 = u.pm * BM + wr * 64 + fr, n0 = wc * 32 + 8 * fq;
#pragma unroll
        for (int ai = 0; ai < 2; ++ai)
#pragma unroll
            for (int m = 0; m < 4; ++m)
#pragma unroll
                for (int bj = 0; bj < 2; ++bj) {
                    const int j = row0 + ai * HALF + m * 16, nn = n0 + bj * HALF, tok = j * 16 + (nn >> 4);
                    f32x4 v0 = acc[ai][bj][m][0], v1 = acc[ai][bj][m][1];
#pragma unroll
                    for (int q = 0; q < 4; ++q) { v0[q] = gelu_t(v0[q]); v1[q] = gelu_t(v1[q]); }
                    gst16(Y1 + (size_t)tok * 1024 + u.b * 16 + (nn & 15), pack8(v0, v1));
                }
    }
};
struct EpiGlu {
    static constexpr bool PERM = true; const bf16_t* Y1; bf16_t* O; const float* bias;
    __device__ __forceinline__ void prefetch(float (&pre)[8], const Unit&, int, int) const {
#pragma unroll
        for (int i = 0; i < 8; ++i) pre[i] = 0.f; }
    __device__ __forceinline__ void operator()(AccRef acc, const Unit& u, int wr, int wc, int fr, int fq, const float (&pre)[8]) const {
        const int row0 = u.pm * BM + wr * 64 + fr, col0 = u.pn * BM + wc * 32 + 8 * fq;
        f32x4 bv[2][2];
#pragma unroll
        for (int bj = 0; bj < 2; ++bj) { bv[bj][0] = *(const GAS f32x4*)(unsigned long long)(bias + col0 + bj * HALF); bv[bj][1] = *(const GAS f32x4*)(unsigned long long)(bias + col0 + bj * HALF + 4); }
#pragma unroll
        for (int ai = 0; ai < 2; ++ai) {
            u32x4 yv[4][2];
#pragma unroll
            for (int m = 0; m < 4; ++m)
#pragma unroll
                for (int bj = 0; bj < 2; ++bj) yv[m][bj] = gld16(Y1 + (size_t)(row0 + ai * HALF + m * 16) * 1024 + col0 + bj * HALF);
#pragma unroll
            for (int m = 0; m < 4; ++m)
#pragma unroll
                for (int bj = 0; bj < 2; ++bj) {
                    f32x4 y0, y1v; unpack8(yv[m][bj], y0, y1v);
                    f32x4 v0 = acc[ai][bj][m][0] + bv[bj][0], v1 = acc[ai][bj][m][1] + bv[bj][1];
#pragma unroll
                    for (int q = 0; q < 4; ++q) { v0[q] = y0[q] * sigm(v0[q]); v1[q] = y1v[q] * sigm(v1[q]); }
                    gst16(O + (size_t)(row0 + ai * HALF + m * 16) * 1024 + col0 + bj * HALF, pack8(v0, v1));
                }
        }
    }
};
template <bool FIRST> struct EpiMerge {
    static constexpr bool PERM = true; const bf16_t* Gt; bf16_t* Mo;
    __device__ __forceinline__ void prefetch(float (&pre)[8], const Unit&, int, int) const {
#pragma unroll
        for (int i = 0; i < 8; ++i) pre[i] = 0.f; }
    __device__ __forceinline__ void operator()(AccRef acc, const Unit& u, int wr, int wc, int fr, int fq, const float (&pre)[8]) const {
        const int row0 = u.pm * BM + wr * 64 + fr, col0 = u.pn * BM + wc * 32 + 8 * fq;
#pragma unroll
        for (int ai = 0; ai < 2; ++ai) {
            u32x4 gv[4][2], mv[4][2];
#pragma unroll
            for (int m = 0; m < 4; ++m)
#pragma unroll
                for (int bj = 0; bj < 2; ++bj) { const size_t off = (size_t)(row0 + ai * HALF + m * 16) * 2048 + col0 + bj * HALF;
                    gv[m][bj] = gld16(Gt + off); mv[m][bj] = FIRST ? (u32x4){0u, 0u, 0u, 0u} : gld16(Mo + off); }
#pragma unroll
            for (int m = 0; m < 4; ++m)
#pragma unroll
                for (int bj = 0; bj < 2; ++bj) { const size_t off = (size_t)(row0 + ai * HALF + m * 16) * 2048 + col0 + bj * HALF;
                    f32x4 g0, g1; unpack8(gv[m][bj], g0, g1);
                    f32x4 v0 = g0 * acc[ai][bj][m][0], v1 = g1 * acc[ai][bj][m][1];
                    if (!FIRST) { f32x4 p0, p1; unpack8(mv[m][bj], p0, p1); v0 += p0; v1 += p1; }
                    gst16(Mo + off, pack8(v0, v1)); }
        }
    }
};

__device__ void cvt_job(unsigned char* shm, const float* src, bf16_t* dst, int K, int N, int mode, const float* kscale = nullptr, int ldd = 0) {
    if (ldd == 0) ldd = K;
    bf16_t* T = (bf16_t*)shm;
    const int tid = ltid(), bid = lbid(), nkt = K / 64, nnt = N / 256, tot = nkt * nnt;
    for (int t = bid; t < tot; t += gridDim.x) {
        const int nti = t % nnt, kt = t / nnt;
        { const int k = tid >> 3, n8 = (tid & 7) * 8;
          const float* s = src + (size_t)(kt * 64 + k) * N + nti * 256 + n8; const float ks = kscale ? kscale[kt * 64 + k] : 1.0f;
          f32x4 v[8];
#pragma unroll
          for (int q = 0; q < 4; ++q) { v[2 * q] = *(const f32x4*)(s + q * 64); v[2 * q + 1] = *(const f32x4*)(s + q * 64 + 4); }
          asm volatile("" ::: "memory");
#pragma unroll
          for (int q = 0; q < 4; ++q)
#pragma unroll
              for (int j = 0; j < 4; ++j) { T[(q * 64 + n8 + j) * 72 + k] = f2bf(v[2 * q][j] * ks); T[(q * 64 + n8 + 4 + j) * 72 + k] = f2bf(v[2 * q + 1][j] * ks); } }
        __syncthreads();
#pragma unroll
        for (int q = 0; q < 4; ++q) { const int n = q * 64 + (tid >> 3), k8 = (tid & 7) * 8; const int nn = nti * 256 + n;
          const int drow = mode == 0 ? nn : ((nn >> 7) * 256 + (nn & 127) + (mode == 2 ? 128 : 0));
          *(u32x4*)(dst + (size_t)drow * ldd + kt * 64 + k8) = *(const u32x4*)(T + n * 72 + k8); }
        __syncthreads();
    }
}
__device__ void cvt_ffn(const Params& p, unsigned char* shm, int l, int sub) {
    bf16_t* W = (bf16_t*)(p.ws + WS_W); const size_t wo = (size_t)(l * 2 + sub) * DM * DFF;
    const float* gk = p.in[2] + (l * 6 + (sub ? 4 : 0)) * DM;
    cvt_job(shm, p.in[26] + wo, W + W_13, DM, DFF, 1, gk, LDX);
    cvt_job(shm, p.in[27] + wo, W + W_13, DM, DFF, 2, gk, LDX);
    cvt_job(shm, p.in[28] + wo, W + W_2, DFF, DM, 0);
}
__device__ void cvt_mixer(const Params& p, unsigned char* shm, int l) {
    bf16_t* W = (bf16_t*)(p.ws + WS_W);
    cvt_job(shm, p.in[3] + (size_t)l * DM * 13824, W + W_IN, DM, 13824, 0, p.in[2] + (l * 6 + 2) * DM, LDX);
    cvt_job(shm, p.in[19] + (size_t)l * 1024 * 1024, W + W_GLU, 1024, 1024, 0);
    cvt_job(shm, p.in[22] + (size_t)l * 1024 * DM, W + W_BRL, 1024, DM, 0);
    cvt_job(shm, p.in[23] + (size_t)l * 1024 * DM, W + W_BRS, 1024, DM, 0);
    cvt_job(shm, p.in[24] + (size_t)l * 512 * DM, W + W_BRA, 512, DM, 0);
    cvt_job(shm, p.in[25] + (size_t)l * DM * DM, W + W_OUT, DM, DM, 0);
}

__device__ void norm_rows(const Params& p, int mode, float scale, const float* gpost) {
    const int tid = ltid(), bid = lbid(), lane = tid & 63, wid = tid >> 6;
    bf16_t* X = (bf16_t*)(p.ws + WS_H); const bf16_t* Y = (const bf16_t*)(p.ws + B_Y); float* RS = (float*)(p.ws + SM_RS);
    for (int row = bid * 8 + wid; row < MT; row += gridDim.x * 8) {
        f32x4 xv[8];
        if (mode == 0) {
            const float* xr = row < 8192 ? p.in[0] + (size_t)row * DM : p.in[1] + (size_t)(row - 8192) * DM;
#pragma unroll
            for (int c = 0; c < 4; ++c) { xv[2 * c] = *(const f32x4*)(xr + (c * 64 + lane) * 8); xv[2 * c + 1] = *(const f32x4*)(xr + (c * 64 + lane) * 8 + 4); }
            asm volatile("" ::: "memory");
        } else {
            f32x4 yv[8]; float ss = 0.f; u32x4 xw[4], yw[4]; f32x4 gq[8];
#pragma unroll
            for (int c = 0; c < 4; ++c) { xw[c] = *(const u32x4*)(X + (size_t)row * LDX + (c * 64 + lane) * 8); yw[c] = *(const u32x4*)(Y + (size_t)row * DM + (c * 64 + lane) * 8); }
#pragma unroll
            for (int c = 0; c < 4; ++c) { gq[2 * c] = *(const f32x4*)(gpost + (c * 64 + lane) * 8); gq[2 * c + 1] = *(const f32x4*)(gpost + (c * 64 + lane) * 8 + 4); }
            asm volatile("" ::: "memory");
#pragma unroll
            for (int c = 0; c < 4; ++c) { unpack8(xw[c], xv[2 * c], xv[2 * c + 1]); unpack8(yw[c], yv[2 * c], yv[2 * c + 1]); }
#pragma unroll
            for (int c = 0; c < 8; ++c) ss += yv[c][0] * yv[c][0] + yv[c][1] * yv[c][1] + yv[c][2] * yv[c][2] + yv[c][3] * yv[c][3];
            ss = wave_sum(ss);
            const float rs = rsqrtf(ss * (1.0f / DM) + RMS_EPS) * scale;
#pragma unroll
            for (int c = 0; c < 4; ++c) { xv[2 * c] += yv[2 * c] * gq[2 * c] * rs; xv[2 * c + 1] += yv[2 * c + 1] * gq[2 * c + 1] * rs; }
        }
        if (mode == 2) {
#pragma unroll
            for (int c = 0; c < 4; ++c) { *(f32x4*)(p.out + (size_t)row * DM + (c * 64 + lane) * 8) = xv[2 * c]; *(f32x4*)(p.out + (size_t)row * DM + (c * 64 + lane) * 8 + 4) = xv[2 * c + 1]; }
        } else {
            float ss = 0.f;
#pragma unroll
            for (int c = 0; c < 8; ++c) ss += xv[c][0] * xv[c][0] + xv[c][1] * xv[c][1] + xv[c][2] * xv[c][2] + xv[c][3] * xv[c][3];
            ss = wave_sum(ss);
#pragma unroll
            for (int c = 0; c < 4; ++c) *(u32x4*)(X + (size_t)row * LDX + (c * 64 + lane) * 8) = pack8(xv[2 * c], xv[2 * c + 1]);
            if (lane == 0) RS[row] = rsqrtf(ss * (1.0f / DM) + RMS_EPS);
        }
    }
}

__device__ void s5_stage1(const Params& p, int l) {
    float2* Apow = (float2*)(p.ws + SM_APOW); float2* Bbar = (float2*)(p.ws + SM_BBAR);
    for (int idx = lbid() * 512 + ltid(); idx < 8192; idx += gridDim.x * 512) {
        const float lr = p.in[11][l * 8192 + idx], li = p.in[12][l * 8192 + idx], dt = expf(p.in[13][l * 128 + (idx >> 6)]);
        f32x4 br4[4], bi4[4];
#pragma unroll
        for (int c = 0; c < 4; ++c) { br4[c] = *(const f32x4*)(p.in[14] + (size_t)l * 131072 + idx * 16 + c * 4); bi4[c] = *(const f32x4*)(p.in[15] + (size_t)l * 131072 + idx * 16 + c * 4); }
        asm volatile("" ::: "memory");
        float ar = 1.f, ai = 0.f;
        for (int k = 0; k < 18; ++k) { const float mag = expf((float)k * lr * dt); float s, c; sincosf((float)k * li * dt, &s, &c); Apow[idx * 18 + k] = make_float2(mag * c, mag * s); if (k == 1) { ar = mag * c; ai = mag * s; } }
        const float den = lr * lr + li * li, cr = ((ar - 1.0f) * lr + ai * li) / den, ci = (ai * lr - (ar - 1.0f) * li) / den;
#pragma unroll
        for (int c = 0; c < 16; ++c) { const float br = br4[c >> 2][c & 3], bi = bi4[c >> 2][c & 3];
            Bbar[idx * 16 + c] = make_float2(cr * br - ci * bi, cr * bi + ci * br); }
    }
}
__device__ void s5_stage2(const Params& p, int l) {
    const float2* Apow = (const float2*)(p.ws + SM_APOW); const float2* Bbar = (const float2*)(p.ws + SM_BBAR);
    float* Kd = (float*)(p.ws + SM_KD); bf16_t* Gm = (bf16_t*)(p.ws + SM_G); bf16_t* Ym = (bf16_t*)(p.ws + SM_Y); bf16_t* LWT = (bf16_t*)(p.ws + SM_LWT);
    const float* cre = p.in[16] + (size_t)l * 131072; const float* cim = p.in[17] + (size_t)l * 131072;
    const int gs = gridDim.x * 512, t0 = lbid() * 512 + ltid();
    for (int o = t0; o < 524288; o += gs) {
        const int c2 = o & 15, c = (o >> 4) & 15, k = (o >> 8) & 15, dg = o >> 12;
        float acc = 0.f;
        for (int p0 = 0; p0 < 64; p0 += 8) {
            float2 A[8], Bb[8]; float Cr[8], Ci[8];
#pragma unroll
            for (int q = 0; q < 8; ++q) { const int sidx = dg * 64 + p0 + q; A[q] = Apow[sidx * 18 + k]; Bb[q] = Bbar[sidx * 16 + c2]; Cr[q] = cre[(dg * 16 + c) * 64 + p0 + q]; Ci[q] = cim[(dg * 16 + c) * 64 + p0 + q]; }
            asm volatile("" ::: "memory");
#pragma unroll
            for (int q = 0; q < 8; ++q) { const float abr = A[q].x * Bb[q].x - A[q].y * Bb[q].y, abi = A[q].x * Bb[q].y + A[q].y * Bb[q].x; acc += Cr[q] * abr - Ci[q] * abi; }
        }
        Kd[o] = acc;
    }
    for (int ob = t0; ob < 64 * 65536; ob += 4 * gs) {
        float2 A1[4], B1[4], A2v[4]; float Cr[4], Ci[4];
#pragma unroll
        for (int q = 0; q < 4; ++q) { const int o = min(ob + q * gs, 64 * 65536 - 1); const int kk = o & 255, n = (o >> 8) & 255, g = o >> 16;
            { const int d = n >> 7, pp = n & 63, s = kk >> 4, c2 = kk & 15, e = d == 0 ? 15 - s : s; const int sidx = (d * 64 + g) * 64 + pp; A1[q] = Apow[sidx * 18 + e]; B1[q] = Bbar[sidx * 16 + c2]; }
            { const int tau = n >> 4, c = n & 15, d = kk >> 7, pp = kk & 63, e = d == 0 ? tau + 1 : 16 - tau; const int sidx = (d * 64 + g) * 64 + pp;
              A2v[q] = Apow[sidx * 18 + e]; Cr[q] = cre[((d * 64 + g) * 16 + c) * 64 + pp]; Ci[q] = cim[((d * 64 + g) * 16 + c) * 64 + pp]; } }
        asm volatile("" ::: "memory");
#pragma unroll
        for (int q = 0; q < 4; ++q) { const int o = ob + q * gs; if (o >= 64 * 65536) break; const int kk = o & 255, n = (o >> 8) & 255, g = o >> 16;
            Gm[o] = f2bf(((n >> 6) & 1) ? A1[q].x * B1[q].y + A1[q].y * B1[q].x : A1[q].x * B1[q].x - A1[q].y * B1[q].y);
            Ym[((size_t)g * 256 + n) * 512 + 256 + kk] = f2bf(((kk >> 6) & 1) ? -(Cr[q] * A2v[q].y + Ci[q] * A2v[q].x) : Cr[q] * A2v[q].x - Ci[q] * A2v[q].y); }
    }
    for (int o = t0; o < 262144; o += gs) {
        const int i = o & 63, j = (o >> 6) & 63, n = (o >> 12) & 15, gate = (o >> 16) & 1, d = o >> 17;
        const float* src = gate ? p.in[8] : p.in[6];
        LWT[o] = f2bf(src[(size_t)((l * 2 + d) * 16 + n) * 4096 + i * 64 + j]);
    }
}
__device__ void s5_stage3(const Params& p, int l) {
    const float* Kd = (const float*)(p.ws + SM_KD); bf16_t* Ym = (bf16_t*)(p.ws + SM_Y); const float* Dk = p.in[18] + l * 1024;
    const int gs = gridDim.x * 512;
    for (int ob = lbid() * 512 + ltid(); ob < 64 * 65536; ob += 4 * gs) {
        float kf[4], kr[4], dd[4];
#pragma unroll
        for (int q = 0; q < 4; ++q) { const int o = min(ob + q * gs, 64 * 65536 - 1); const int kk = o & 255, n = (o >> 8) & 255, g = o >> 16, s = kk >> 4, c2 = kk & 15, tau = n >> 4, c = n & 15;
            const int df = s <= tau ? tau - s : 0, dr = s >= tau ? s - tau : 0;
            kf[q] = Kd[((0 * 64 + g) * 16 + df) * 256 + c * 16 + c2]; kr[q] = Kd[((1 * 64 + g) * 16 + dr) * 256 + c * 16 + c2]; dd[q] = Dk[g * 16 + c]; }
        asm volatile("" ::: "memory");
#pragma unroll
        for (int q = 0; q < 4; ++q) { const int o = ob + q * gs; if (o >= 64 * 65536) break; const int kk = o & 255, n = (o >> 8) & 255, g = o >> 16, s = kk >> 4, c2 = kk & 15, tau = n >> 4, c = n & 15;
            float v = 0.f; if (s <= tau) v += kf[q]; if (s >= tau) v += kr[q]; if (s == tau && c == c2) v += dd[q];
            Ym[((size_t)g * 256 + n) * 512 + kk] = f2bf(v); }
    }
}
__device__ void s5_bscan(const Params& p, unsigned char* shm) {
    const float2* Apow = (const float2*)(p.ws + SM_APOW); const float* S = (const float*)((const unsigned char*)p.out + O_S); bf16_t* A2 = (bf16_t*)(p.ws + B_A2);
    float2* Es = (float2*)shm;
    const int tid = ltid();
    for (int it = lbid(); it < 192; it += gridDim.x) {
        const bool lng = it < 128;
        const int pp = tid & 63, g = lng ? it >> 1 : it - 128, d = lng ? (it & 1) : ((tid >> 6) & 1), seg = lng ? tid >> 6 : 0, seq = lng ? 4 : tid >> 7;
        const int j0 = lng ? 512 + seg * 128 : seq * 128;
        const float2 A16 = Apow[((d * 64 + g) * 64 + pp) * 18 + 16];
        const float* Sg = S + (size_t)g * NSUB * 256 + d * 128 + pp; bf16_t* Xg = A2 + (size_t)g * NSUB * 512 + 256 + d * 128 + pp;
        float xr = 0.f, xi = 0.f;
        if (lng) {
            for (int jb = 0; jb < 128; jb += 16) {
                float sr[16], si[16];
#pragma unroll
                for (int u = 0; u < 16; ++u) { const int j = d ? (j0 + 127 - (jb + u)) : (j0 + jb + u); sr[u] = Sg[(size_t)j * 256]; si[u] = Sg[(size_t)j * 256 + 64]; }
                asm volatile("" ::: "memory");
#pragma unroll
                for (int u = 0; u < 16; ++u) { const float nr = A16.x * xr - A16.y * xi + sr[u], ni = A16.x * xi + A16.y * xr + si[u]; xr = nr; xi = ni; }
            }
            Es[seg * 64 + pp] = make_float2(xr, xi);
            float2 Ab = A16;
#pragma unroll
            for (int q = 0; q < 7; ++q) Ab = make_float2(Ab.x * Ab.x - Ab.y * Ab.y, 2.0f * Ab.x * Ab.y);
            __syncthreads();
            xr = 0.f; xi = 0.f;
            for (int q = 0; q < 8; ++q) { const int sq = d ? 7 - q : q; const bool use = d ? (sq > seg) : (sq < seg);
                if (use) { const float2 E = Es[sq * 64 + pp]; const float nr = Ab.x * xr - Ab.y * xi + E.x, ni = Ab.x * xi + Ab.y * xr + E.y; xr = nr; xi = ni; } }
        }
        for (int jb = 0; jb < 128; jb += 16) {
            float sr[16], si[16];
#pragma unroll
            for (int u = 0; u < 16; ++u) { const int j = d ? (j0 + 127 - (jb + u)) : (j0 + jb + u); sr[u] = Sg[(size_t)j * 256]; si[u] = Sg[(size_t)j * 256 + 64]; }
            asm volatile("" ::: "memory");
#pragma unroll
            for (int u = 0; u < 16; ++u) { const int j = d ? (j0 + 127 - (jb + u)) : (j0 + jb + u);
                Xg[(size_t)j * 512] = f2bf(xr); Xg[(size_t)j * 512 + 64] = f2bf(xi);
                const float nr = A16.x * xr - A16.y * xi + sr[u], ni = A16.x * xi + A16.y * xr + si[u]; xr = nr; xi = ni; }
        }
        __syncthreads();
    }
}

template <int PASS>
__device__ void lru_items(const Params& p, unsigned char* shm, int l) {
    bf16_t* xraw = (bf16_t*)shm;
    float* xcf = (float*)(shm + 8704);
    bf16_t* xcb = (bf16_t*)(shm + 25344);
    bf16_t* wt = (bf16_t*)(shm + 34560);
    float* As = (float*)(shm + 71424);
    float* Bs = (float*)(shm + 104192);
    float* Pq = (float*)(shm + 136960);
    float* Hq = (float*)(shm + 139008);
    const bf16_t* XL = (const bf16_t*)(p.ws + B_XL); bf16_t* GL = (bf16_t*)(p.ws + B_GL); const bf16_t* LWT = (const bf16_t*)(p.ws + SM_LWT);
    float* SA = (float*)(p.ws + SM_SA); float* SH = (float*)(p.ws + SM_SH); const float* CIN = (const float*)(p.ws + SM_CIN);
    const float* cw = p.in[4] + l * 4096; const float* cbias = p.in[5] + l * 1024;
    const int tid = ltid(), lane = tid & 63, w = tid >> 6, fr = lane & 15, fq = lane >> 4, G_ = gridDim.x, total = NCHK * 16;
    int n_loaded = -1;
    float c0 = 0.f, c1 = 0.f, c2 = 0.f, c3 = 0.f, cb = 0.f, gba[4], gbx[4], gsp[4];
#pragma unroll
    for (int jt = 0; jt < 4; ++jt) { gba[jt] = 0.f; gbx[jt] = 0.f; gsp[jt] = 0.f; }
    u32x4 xr0 = (u32x4){0u, 0u, 0u, 0u}, xr1 = (u32x4){0u, 0u, 0u, 0u};
#define LRU_LOAD(IT) do { const int ck_ = (IT) >> 4, n_ = (IT) & 15, t0_ = ck_ * 64; const int ss_ = t0_ < 8192 ? (t0_ & ~2047) : 8192, se_ = t0_ < 8192 ? ss_ + 2048 : MT; \
        { const int row = tid >> 3, c8 = tid & 7, tok = t0_ - 2 + row; xr0 = (u32x4){0u, 0u, 0u, 0u}; if (tok >= ss_ && tok < se_) xr0 = *(const u32x4*)(XL + (size_t)tok * 1024 + n_ * 64 + c8 * 8); } \
        if (tid < 24) { const int row = 64 + (tid >> 3), c8 = tid & 7, tok = t0_ - 2 + row; xr1 = (u32x4){0u, 0u, 0u, 0u}; if (tok >= ss_ && tok < se_) xr1 = *(const u32x4*)(XL + (size_t)tok * 1024 + n_ * 64 + c8 * 8); } } while (0)
    int it = lbid();
    if (it < total) LRU_LOAD(it);
    for (; it < total; it += G_) {
        const int ck = it >> 4, n = it & 15, t0 = ck * 64;
        *(u32x4*)(xraw + (tid >> 3) * 64 + (tid & 7) * 8) = xr0;
        if (tid < 24) *(u32x4*)(xraw + (64 + (tid >> 3)) * 64 + (tid & 7) * 8) = xr1;
        if (n != n_loaded) {
            n_loaded = n;
#pragma unroll
            for (int i = 0; i < 4; ++i) { const int e = tid + 512 * i, mtx = e >> 9, rem = e & 511, j = rem >> 3, c8 = rem & 7;
                *(u32x4*)(wt + (mtx * 64 + j) * 72 + c8 * 8) = *(const u32x4*)(LWT + ((size_t)(mtx * 16 + n) * 64 + j) * 64 + c8 * 8); }
            { const int ch = n * 64 + (tid & 63); c0 = cw[ch]; c1 = cw[1024 + ch]; c2 = cw[2048 + ch]; c3 = cw[3072 + ch]; cb = cbias[ch]; }
#pragma unroll
            for (int jt = 0; jt < 4; ++jt) { const int pi = (l * 2 + (w >> 2)) * 1024 + n * 64 + jt * 16 + fr; gba[jt] = p.in[7][pi]; gbx[jt] = p.in[9][pi]; gsp[jt] = -8.0f * log1pf(__expf(-p.in[10][pi])); }
        }
        u32x4 glv = (u32x4){0u, 0u, 0u, 0u}; float cin = 0.f;
        const size_t go = (size_t)(t0 + (tid >> 3)) * 1024 + n * 64 + (tid & 7) * 8;
        const size_t so = (size_t)(ck * 2 + ((tid >> 6) & 1)) * 1024 + n * 64 + (tid & 63);
        if (PASS == 1) { glv = *(const u32x4*)(GL + go); cin = CIN[so]; }
        asm volatile("" ::: "memory");
        __syncthreads();
        if (it + G_ < total) LRU_LOAD(it + G_);
        asm volatile("" ::: "memory");
        { const int j = tid & 63;
#pragma unroll
          for (int i = 0; i < 8; ++i) { const int t = (tid >> 6) + 8 * i;
              const float v = cb + bf2f(xraw[t * 64 + j]) * c0 + bf2f(xraw[(t + 1) * 64 + j]) * c1 + bf2f(xraw[(t + 2) * 64 + j]) * c2 + bf2f(xraw[(t + 3) * 64 + j]) * c3;
              xcf[t * 65 + j] = v; xcb[t * 72 + j] = f2bf(v); } }
        __syncthreads();
        { const int d = w >> 2, tt = w & 3;
          const bf16x8 a0 = *(const bf16x8*)(xcb + (tt * 16 + fr) * 72 + fq * 8), a1 = *(const bf16x8*)(xcb + (tt * 16 + fr) * 72 + 32 + fq * 8);
#pragma unroll
          for (int jt = 0; jt < 4; ++jt) {
              f32x4 accr = (f32x4){0.f, 0.f, 0.f, 0.f}, acci = (f32x4){0.f, 0.f, 0.f, 0.f};
              const bf16_t* wr_ = wt + ((d * 2 + 0) * 64 + jt * 16 + fr) * 72 + fq * 8; const bf16_t* wi_ = wt + ((d * 2 + 1) * 64 + jt * 16 + fr) * 72 + fq * 8;
              accr = __builtin_amdgcn_mfma_f32_16x16x32_bf16(a0, *(const bf16x8*)wr_, accr, 0, 0, 0);
              accr = __builtin_amdgcn_mfma_f32_16x16x32_bf16(a1, *(const bf16x8*)(wr_ + 32), accr, 0, 0, 0);
              acci = __builtin_amdgcn_mfma_f32_16x16x32_bf16(a0, *(const bf16x8*)wi_, acci, 0, 0, 0);
              acci = __builtin_amdgcn_mfma_f32_16x16x32_bf16(a1, *(const bf16x8*)(wi_ + 32), acci, 0, 0, 0);
              const int j = jt * 16 + fr;
#pragma unroll
              for (int i = 0; i < 4; ++i) { const int t = tt * 16 + fq * 4 + i;
                  const float r = sigm(accr[i] + gba[jt]), ig = sigm(acci[i] + gbx[jt]), a = __expf(r * gsp[jt]);
                  As[(d * 64 + t) * 64 + j] = a;
                  Bs[(d * 64 + t) * 64 + j] = sqrtf(fmaxf(1.0f - a * a, 0.f)) * ig * xcf[t * 65 + j]; }
          } }
        __syncthreads();
        {
            const int seg = tid >> 7, d = (tid >> 6) & 1, j = tid & 63;
            float h = 0.f, P = 1.f;
#pragma unroll
            for (int s = 0; s < 16; ++s) { const int st = seg * 16 + s, t = d ? 63 - st : st; const float a = As[(d * 64 + t) * 64 + j]; h = a * h + Bs[(d * 64 + t) * 64 + j]; P *= a; }
            Pq[seg * 128 + (tid & 127)] = P; Hq[seg * 128 + (tid & 127)] = h;
            __syncthreads();
            if (PASS == 0) {
                if (tid < 128) { float hh = Hq[tid], PP = Pq[tid];
#pragma unroll
                    for (int q = 1; q < 4; ++q) { const float pq = Pq[q * 128 + tid]; hh = pq * hh + Hq[q * 128 + tid]; PP *= pq; }
                    SA[so] = PP; SH[so] = hh; }
            } else {
                float c = cin;
#pragma unroll
                for (int q = 0; q < 3; ++q) if (q < seg) c = Pq[q * 128 + (tid & 127)] * c + Hq[q * 128 + (tid & 127)];
#pragma unroll
                for (int s = 0; s < 16; ++s) { const int st = seg * 16 + s, t = d ? 63 - st : st; c = As[(d * 64 + t) * 64 + j] * c + Bs[(d * 64 + t) * 64 + j]; Bs[(d * 64 + t) * 64 + j] = c; }
                __syncthreads();
                const int t = tid >> 3, c8 = tid & 7;
                f32x4 g0, g1; unpack8(glv, g0, g1);
                const f32x4 f0 = *(const f32x4*)(Bs + t * 64 + c8 * 8), f1 = *(const f32x4*)(Bs + t * 64 + c8 * 8 + 4), r0 = *(const f32x4*)(Bs + (64 + t) * 64 + c8 * 8), r1 = *(const f32x4*)(Bs + (64 + t) * 64 + c8 * 8 + 4);
                *(u32x4*)(GL + go) = pack8((f0 + r0) * g0, (f1 + r1) * g1);
            }
        }
        __syncthreads();
    }
#undef LRU_LOAD
}
__device__ void lru_carry(const Params& p) {
    const float* SA = (const float*)(p.ws + SM_SA); const float* SH = (const float*)(p.ws + SM_SH); float* CIN = (float*)(p.ws + SM_CIN);
    const int tid_ = ltid();
    for (int it = lbid(); it < 20; it += gridDim.x) {
        const int c = it * 512 + tid_, ch = c & 1023, d = (c >> 10) & 1, seq = c >> 11;
        const int k0 = seq < 4 ? seq * 32 : 128, nk = seq < 4 ? 32 : 256;
        float carry = 0.f;
        for (int kb = 0; kb < nk; kb += 8) {
            float a[8], h[8];
#pragma unroll
            for (int u = 0; u < 8; ++u) { const int k = d ? (k0 + nk - 1 - (kb + u)) : (k0 + kb + u); a[u] = SA[(size_t)(k * 2 + d) * 1024 + ch]; h[u] = SH[(size_t)(k * 2 + d) * 1024 + ch]; }
            asm volatile("" ::: "memory");
#pragma unroll
            for (int u = 0; u < 8; ++u) { const int k = d ? (k0 + nk - 1 - (kb + u)) : (k0 + kb + u); CIN[(size_t)(k * 2 + d) * 1024 + ch] = carry; carry = a[u] * carry + h[u]; }
        }
    }
}

struct AttnGeom { int hd, seq_start, dil, n_lat, r, q0; };
__device__ __forceinline__ AttnGeom attn_geom(int it) {
    AttnGeom G; G.hd = it / 192; const int qt = it % 192;
    int T, lt; if (qt < 64) { G.seq_start = (qt >> 4) * 2048; T = 2048; lt = qt & 15; } else { G.seq_start = 8192; T = 16384; lt = qt - 64; }
    const int g = G.hd >> 3; G.dil = g == 0 ? 1 : (g == 1 ? 4 : 16); G.n_lat = T / G.dil; const int tpr = G.n_lat >> 7; G.r = lt / tpr; G.q0 = (lt % tpr) << 7; return G;
}
__device__ void attn_items(const Params& p, unsigned char* shm) {
    bf16_t* Ks = (bf16_t*)shm;
    bf16_t* Vt = (bf16_t*)(shm + 36864);
    bf16_t* Ps = (bf16_t*)(shm + 77824);
    float* BT = (float*)(shm + 120832);
    bf16_t* Qb = (bf16_t*)(p.ws + B_Q); const bf16_t* Kb = (const bf16_t*)(p.ws + B_K); const bf16_t* Vb = (const bf16_t*)(p.ws + B_V);
    float* LSE = (float*)(p.ws + SM_LSE);
    const int tid = ltid(), lane = tid & 63, w = tid >> 6, fr = lane & 15, fq = lane >> 4, G_ = gridDim.x;
    for (int i = tid; i < 24 * 129; i += 512) { const int hd = i / 129, j = i % 129; BT[hd * 132 + j] = p.in[21][(int)BUCKET[hd >> 3][j] * 24 + hd]; }
    u32x4 kreg[5], vreg[5]; bf16x8 q0r, q1r;
    const int total = 24 * 192;
    int it = lbid();
#define ATT_LOAD(IT) do { const AttnGeom G = attn_geom(IT); \
        _Pragma("unroll") for (int i = 0; i < 5; ++i) { const int e = tid + 512 * i, kk = e >> 3, c8 = e & 7, lat = G.q0 - 64 + kk; const bool ok = e < 2176 && kk < 256 && lat >= 0 && lat < G.n_lat; \
            kreg[i] = (u32x4){0u, 0u, 0u, 0u}; vreg[i] = (u32x4){0u, 0u, 0u, 0u}; \
            if (ok) { const size_t go = (size_t)(G.seq_start + G.r + G.dil * lat) * 1536 + G.hd * 64 + c8 * 8; kreg[i] = *(const u32x4*)(Kb + go); vreg[i] = *(const u32x4*)(Vb + go); } } \
        const size_t qo = (size_t)(G.seq_start + G.r + G.dil * (G.q0 + 16 * w + fr)) * 1536 + G.hd * 64; \
        q0r = *(const bf16x8*)(Qb + qo + fq * 8); q1r = *(const bf16x8*)(Qb + qo + 32 + fq * 8); } while (0)
    if (it < total) ATT_LOAD(it);
    for (; it < total; it += G_) {
        const AttnGeom G = attn_geom(it);
#pragma unroll
        for (int i = 0; i < 5; ++i) { const int e = tid + 512 * i, kk = e >> 3, c8 = e & 7;
            if (e < 2176) {
                if (kk < 256) *(u32x4*)(Ks + kk * 72 + c8 * 8) = kreg[i];
#pragma unroll
                for (int j = 0; j < 8; ++j) Vt[(c8 * 8 + j) * 320 + (kk ^ (c8 << 3))] = (bf16_t)((vreg[i][j >> 1] >> ((j & 1) * 16)) & 0xffffu); } }
        const bf16x8 aq0 = q0r, aq1 = q1r;
        __syncthreads();
        if (it + G_ < total) ATT_LOAD(it + G_);
        asm volatile("" ::: "memory");
        const float* bs = BT + G.hd * 132;
        f32x4 s[9];
#pragma unroll
        for (int kt = 0; kt < 9; ++kt) { const bf16_t* kr = Ks + (16 * w + 16 * kt + fr) * 72 + fq * 8;
            f32x4 a = (f32x4){0.f, 0.f, 0.f, 0.f};
            a = __builtin_amdgcn_mfma_f32_16x16x32_bf16(aq0, *(const bf16x8*)kr, a, 0, 0, 0);
            a = __builtin_amdgcn_mfma_f32_16x16x32_bf16(aq1, *(const bf16x8*)(kr + 32), a, 0, 0, 0); s[kt] = a; }
        float mx[4], ls[4];
#pragma unroll
        for (int i = 0; i < 4; ++i) { const int qi = fq * 4 + i; float m = -3.0e38f;
#pragma unroll
            for (int kt = 0; kt < 9; ++kt) { const int rel = 16 * kt + fr - 64 - qi, klat = G.q0 - 64 + 16 * w + 16 * kt + fr;
                const bool ok = rel >= -64 && rel <= 64 && klat >= 0 && klat < G.n_lat; const int bi = min(max(rel + 64, 0), 128);
                const float v = ok ? s[kt][i] + bs[bi] : -1.0e30f; s[kt][i] = v; m = fmaxf(m, v); }
            m = fmaxf(m, __shfl_xor(m, 1)); m = fmaxf(m, __shfl_xor(m, 2)); m = fmaxf(m, __shfl_xor(m, 4)); m = fmaxf(m, __shfl_xor(m, 8));
            float sum = 0.f;
#pragma unroll
            for (int kt = 0; kt < 9; ++kt) { const float pv = __expf(s[kt][i] - m); s[kt][i] = pv; sum += pv; }
            sum += __shfl_xor(sum, 1); sum += __shfl_xor(sum, 2); sum += __shfl_xor(sum, 4); sum += __shfl_xor(sum, 8);
            mx[i] = m; ls[i] = sum; }
        bf16_t* Pw = Ps + w * 16 * 168;
#pragma unroll
        for (int i = 0; i < 4; ++i) {
#pragma unroll
            for (int kt = 0; kt < 9; ++kt) Pw[(fq * 4 + i) * 168 + 16 * kt + fr] = f2bf(s[kt][i]);
            Pw[(fq * 4 + i) * 168 + 144 + fr] = 0; }
        __syncthreads();
        f32x4 o[4];
#pragma unroll
        for (int nt = 0; nt < 4; ++nt) o[nt] = (f32x4){0.f, 0.f, 0.f, 0.f};
#pragma unroll
        for (int ks = 0; ks < 5; ++ks) { const bf16x8 ap = *(const bf16x8*)(Pw + fr * 168 + ks * 32 + fq * 8);
#pragma unroll
            for (int nt = 0; nt < 4; ++nt) { const int dim = nt * 16 + fr; o[nt] = __builtin_amdgcn_mfma_f32_16x16x32_bf16(ap, *(const bf16x8*)(Vt + dim * 320 + ((16 * w + ks * 32 + fq * 8) ^ ((dim >> 3) << 3))), o[nt], 0, 0, 0); } }
        __syncthreads();
#pragma unroll
        for (int i = 0; i < 4; ++i) { const float inv = 1.0f / ls[i];
#pragma unroll
            for (int nt = 0; nt < 4; ++nt) Pw[(fq * 4 + i) * 168 + nt * 16 + fr] = f2bf(o[nt][i] * inv);
            if (fr == 0) LSE[(size_t)(G.seq_start + G.r + G.dil * (G.q0 + 16 * w + fq * 4 + i)) * 24 + G.hd] = mx[i] + __logf(ls[i]); }
        __syncthreads();
#pragma unroll
        for (int h = 0; h < 2; ++h) { const int c = lane + 64 * h, row = c >> 3, c8 = c & 7;
            *(u32x4*)(Qb + (size_t)(G.seq_start + G.r + G.dil * (G.q0 + 16 * w + row)) * 1536 + G.hd * 64 + c8 * 8) = *(const u32x4*)(Pw + row * 168 + c8 * 8); }
        __syncthreads();
    }
#undef ATT_LOAD
}
__device__ void attn_combine(const Params& p) {
    const bf16_t* Ab = (const bf16_t*)(p.ws + B_Q); const float* LSE = (const float*)(p.ws + SM_LSE); bf16_t* YA = (bf16_t*)(p.ws + B_YATT);
    for (int e = lbid() * 512 + ltid(); e < MT * 64; e += gridDim.x * 512) {
        const int tok = e >> 6, h = (e >> 3) & 7, c8 = e & 7;
        const float l0 = LSE[(size_t)tok * 24 + h], l1 = LSE[(size_t)tok * 24 + 8 + h], l2 = LSE[(size_t)tok * 24 + 16 + h];
        const float m = fmaxf(l0, fmaxf(l1, l2)); float w0 = __expf(l0 - m), w1 = __expf(l1 - m), w2 = __expf(l2 - m); const float inv = 1.0f / (w0 + w1 + w2); w0 *= inv; w1 *= inv; w2 *= inv;
        f32x4 a0, a1, b0, b1, c0, c1;
        const u32x4 ua = *(const u32x4*)(Ab + (size_t)tok * 1536 + h * 64 + c8 * 8), ub = *(const u32x4*)(Ab + (size_t)tok * 1536 + (8 + h) * 64 + c8 * 8), uc = *(const u32x4*)(Ab + (size_t)tok * 1536 + (16 + h) * 64 + c8 * 8);
        asm volatile("" ::: "memory");
        unpack8(ua, a0, a1); unpack8(ub, b0, b1); unpack8(uc, c0, c1);
        *(u32x4*)(YA + (size_t)tok * 512 + h * 64 + c8 * 8) = pack8(a0 * w0 + b0 * w1 + c0 * w2, a1 * w0 + b1 * w1 + c1 * w2);
    }
}


#define XB_TMO      128
#define XB_XCNT(j)  (256  + 64 * (j))
#define XB_XSUB(j)  (1280 + 64 * (j))
#define XB_XGEN(j)  (2304 + 64 * (j))
#define XB_TOP      3328
#define XB_TOPGEN   3392
#define XCD_BAR_WORDS 3456
#define XB_SPIN_CAP (1u << 18)
__device__ __forceinline__ unsigned xb_ld(unsigned* p)              { return __hip_atomic_load(p, __ATOMIC_RELAXED, __HIP_MEMORY_SCOPE_AGENT); }
__device__ __forceinline__ unsigned xb_add(unsigned* p, unsigned v) { return __hip_atomic_fetch_add(p, v, __ATOMIC_RELAXED, __HIP_MEMORY_SCOPE_AGENT); }
__device__ __forceinline__ unsigned xb_xcc_id() { return (unsigned)__builtin_amdgcn_s_getreg((3 << 11) | 20) & 0xFu; }
#define XB_SPIN(cond, bar) do { unsigned _sp = 0; while (cond) { __builtin_amdgcn_s_sleep(1); \
    if ((++_sp & 255u) == 0u) { if (xb_ld(&(bar)[XB_TMO])) break; if (_sp > XB_SPIN_CAP) { atomicAdd(&(bar)[XB_TMO], 1u); break; } } } } while (0)
struct XcdBarrier { unsigned* bar; unsigned x; volatile LAS unsigned* st; };
__device__ __forceinline__ XcdBarrier xcd_barrier_post(unsigned* bar, volatile LAS unsigned* st) {
    XcdBarrier b; b.bar = bar; b.x = xb_xcc_id(); b.st = st;
    if (threadIdx.x == 0) (void)xb_add(&bar[XB_XCNT(b.x)], 1u);
    return b;
}
__device__ __forceinline__ void xcd_barrier_complete(unsigned* bar, unsigned x, unsigned& nloc, unsigned& nx) {
    const unsigned G = gridDim.x * gridDim.y * gridDim.z;
    unsigned sum, cnt, mine, sp = 0u;
    for (;;) {
        sum = 0u; cnt = 0u; mine = 0u;
#pragma unroll
        for (unsigned j = 0; j < 16; ++j) { const unsigned c = xb_ld(&bar[XB_XCNT(j)]); sum += c; cnt += (c > 0u) ? 1u : 0u; mine = (j == x) ? c : mine; }
        if (sum == G) break;
        __builtin_amdgcn_s_sleep(1);
        if ((++sp & 255u) == 0u) { if (xb_ld(&bar[XB_TMO])) break; if (sp > XB_SPIN_CAP) { atomicAdd(&bar[XB_TMO], 1u); break; } }
    }
    nloc = mine > 0u ? mine : 1u; nx = cnt > 0u ? cnt : 1u;
}
__device__ __forceinline__ void xcd_barrier(const XcdBarrier& b) {
    asm volatile("s_waitcnt vmcnt(0)" ::: "memory");
    __syncthreads();
    if (threadIdx.x == 0) {
        unsigned* bar = b.bar;
        __builtin_amdgcn_s_waitcnt(0);
        unsigned nloc = b.st[0], nx = b.st[1];
        if (nloc == 0u) { xcd_barrier_complete(bar, b.x, nloc, nx); b.st[0] = nloc; b.st[1] = nx; }
        const unsigned old = xb_add(&bar[XB_XSUB(b.x)], 1u);
        const unsigned gen = old / nloc;
        if (old + 1u == (gen + 1u) * nloc) {
            __builtin_amdgcn_fence(__ATOMIC_RELEASE, "agent");
            asm volatile("s_waitcnt vmcnt(0)" ::: "memory");
            const unsigned og = xb_add(&bar[XB_TOP], 1u);
            const unsigned tg = og / nx;
            if (og + 1u == (tg + 1u) * nx) xb_add(&bar[XB_TOPGEN], 1u);
            else XB_SPIN(xb_ld(&bar[XB_TOPGEN]) == tg, bar);
            __builtin_amdgcn_fence(__ATOMIC_ACQUIRE, "agent");
            xb_add(&bar[XB_XGEN(b.x)], 1u);
            asm volatile("s_waitcnt vmcnt(0)" ::: "memory");
        } else {
            XB_SPIN(xb_ld(&bar[XB_XGEN(b.x)]) == gen, bar);
            __builtin_amdgcn_fence(__ATOMIC_ACQUIRE, "agent");
            asm volatile("s_waitcnt vmcnt(0)" ::: "memory");
        }
    }
    __syncthreads();
}

__device__ __forceinline__ Gemm mk_gemm(const bf16_t* A, int lda, const bf16_t* Bt, int ldb, int K, int nM, int nN, int nb = 1, size_t sA = 0, size_t sB = 0) {
    Gemm g; g.A = A; g.Bt = Bt; g.lda = lda; g.ldb = ldb; g.K = K; g.nM = nM; g.nN = nN; g.nb = nb; g.sA = sA; g.sB = sB; return g; }

__global__ __launch_bounds__(512, 2) void mega(Params p) {
    extern __shared__ __attribute__((aligned(16))) unsigned char shm[];
    LAS unsigned char* lds = (LAS unsigned char*)shm;
    cg::grid_group grid = cg::this_grid();
    volatile LAS unsigned* xst = (volatile LAS unsigned*)(lds + LDS_BYTES - 16);
    XcdBarrier xb; xb.bar = (unsigned*)(p.ws + SM_BAR); xb.x = 0; xb.st = xst;
    if (p.ph_hi - p.ph_lo > 1) { if (threadIdx.x == 0) { xst[0] = 0u; xst[1] = 0u; } __syncthreads(); xb = xcd_barrier_post((unsigned*)(p.ws + SM_BAR), xst); }
#pragma nounroll
    for (int ph = p.ph_lo; ph < p.ph_hi; ++ph) {
        unsigned char* ws = p.ws; asm volatile("" : "+s"(ws));
        const int l = ph == 0 ? 0 : (ph - 1) / 14, kind = ph == 0 ? 0 : (ph - 1) % 14 + 1;
        bf16_t* W = (bf16_t*)(ws + WS_W); bf16_t* H = (bf16_t*)(ws + WS_H);
        bf16_t* HID = (bf16_t*)(ws + B_HID); bf16_t* Y = (bf16_t*)(ws + B_Y); bf16_t* A2 = (bf16_t*)(ws + B_A2);
        bf16_t* Y1 = (bf16_t*)(ws + B_Y1); bf16_t* Mb = (bf16_t*)(ws + B_M);
        unsigned char* ob = (unsigned char*)p.out; asm volatile("" : "+s"(ob));
        bf16_t* YS5 = (bf16_t*)(ob + O_YS5); const float* RSp = (const float*)(ws + SM_RS);
        const float* ng = p.in[2]; const float* gl_ = ng + l * 6 * DM;
        unsigned* dynq = (unsigned*)(ws + SM_BAR) + XCD_BAR_WORDS;
#ifdef PROBE_MASK
        for (int rep = 0, reps = ((PROBE_MASK >> kind) & 1) ? 2 : 1; rep < reps; ++rep)
#endif
        switch (kind) {
        case 0:
            PREP(0) cvt_ffn(p, shm, 0, 0); s5_stage1(p, 0);
            PREP(1) norm_rows(p, 0, 0.f, nullptr);
            break;
        case 1: case 12: {
            EpiSwiglu e; e.O = HID; e.rs = RSp; gemm_phase<EpiSwiglu, true>(lds, mk_gemm(H, LDX, W + W_13, LDX, DM, MT / 256, 44), e, dynq + (l * 6 + (kind == 1 ? 0 : 4)) * 128);
        } break;
        case 2: case 13: {
            EpiBf16 e; e.O = Y; e.ldc = DM; gemm_phase<EpiBf16, true>(lds, mk_gemm(HID, DFF, W + W_2, DFF, DFF, MT / 256, 8), e, dynq + (l * 6 + (kind == 2 ? 1 : 5)) * 128);
        } break;
        case 3:
            PREP(0) cvt_mixer(p, shm, l);
            s5_stage2(p, l);
            norm_rows(p, 1, 0.5f, gl_ + 1 * DM);
            if ((PROBE2 >> 1) & 1) norm_rows(p, 1, 0.0f, gl_ + 1 * DM);
            break;
        case 4: {
            EpiWin e; e.ws = ws; e.rs = RSp; gemm_phase<EpiWin, true>(lds, mk_gemm(H, LDX, W + W_IN, LDX, DM, MT / 256, 54), e, dynq + (l * 6 + 2) * 128);
        } break;
        case 5: {
            PREP(3) { EpiS e; e.S = (float*)(ob + O_S); gemm_phase(lds, mk_gemm(A2, 512, (const bf16_t*)(ws + SM_G), 256, 256, NSUB / 256, 1, 64, (size_t)NSUB * 512, 65536), e); }
            __syncthreads();
            PREP(4) lru_items<0>(p, shm, l);
            attn_items(p, shm);
        } break;
        case 6:
            PREP(5) { lru_carry(p); s5_bscan(p, shm); attn_combine(p); }
            s5_stage3(p, l);
            break;
        case 7: {
            PREP(3) { EpiY e; e.Y1 = Y1; gemm_phase(lds, mk_gemm(A2, 512, (const bf16_t*)(ws + SM_Y), 512, 512, NSUB / 256, 1, 64, (size_t)NSUB * 512, 131072), e); }
            __syncthreads();
            lru_items<1>(p, shm, l);
        } break;
        case 8: {
            EpiGlu e; e.Y1 = Y1; e.O = YS5; e.bias = p.in[20] + l * 1024; gemm_phase(lds, mk_gemm(Y1, 1024, W + W_GLU, 1024, 1024, MT / 256, 4), e);
        } break;
        case 9: {
            { EpiMerge<true> e; e.Gt = (const bf16_t*)(ws + B_GA); e.Mo = Mb; gemm_phase(lds, mk_gemm((const bf16_t*)(ws + B_GL), 1024, W + W_BRL, 1024, 1024, MT / 256, 8), e); }
            { EpiMerge<false> e; e.Gt = (const bf16_t*)(ws + B_GB); e.Mo = Mb; gemm_phase(lds, mk_gemm(YS5, 1024, W + W_BRS, 1024, 1024, MT / 256, 8), e); }
            { EpiMerge<false> e; e.Gt = (const bf16_t*)(ws + B_GC); e.Mo = Mb; gemm_phase(lds, mk_gemm((const bf16_t*)(ws + B_YATT), 512, W + W_BRA, 512, 512, MT / 256, 8), e); }
        } break;
        case 10: {
            EpiBf16 e; e.O = Y; e.ldc = DM; gemm_phase<EpiBf16, true>(lds, mk_gemm(Mb, DM, W + W_OUT, DM, DM, MT / 256, 8), e, dynq + (l * 6 + 3) * 128);
        } break;
        case 11:
            PREP(0) cvt_ffn(p, shm, l, 1);
            norm_rows(p, 1, 1.0f, gl_ + 3 * DM);
            if ((PROBE2 >> 1) & 1) norm_rows(p, 1, 0.0f, gl_ + 3 * DM);
            break;
        default:
            if (l == 0) { PREP(0) cvt_ffn(p, shm, 1, 0); s5_stage1(p, 1); }
            norm_rows(p, l == 0 ? 1 : 2, 0.5f, gl_ + 5 * DM);
            break;
        }
        if (ph + 1 < p.ph_hi) { if (p.ph_hi > 4096) grid.sync(); else xcd_barrier(xb); }
    }
}
constexpr int N_PHASES = 1 + 2 * 14;

extern "C" void kernel_launch(void* const* d_in, const int* in_sizes, int n_in, void* d_out, int out_size, void* d_ws, size_t ws_size, hipStream_t stream) {
    static int grid = 0;
    if (grid == 0) {
        if (n_in != 29 || ws_size < WS_END) { fprintf(stderr, "kernel_launch: need 29 inputs and %zu bytes of workspace (got %d, %zu)\n", (size_t)WS_END, n_in, ws_size); grid = -1; return; }
        if (hipFuncSetAttribute((const void*)mega, hipFuncAttributeMaxDynamicSharedMemorySize, LDS_BYTES) != hipSuccess) { fprintf(stderr, "hipFuncSetAttribute failed\n"); grid = -1; return; }
        int dev = 0, cus = 0, per_cu = 0;
        (void)hipGetDevice(&dev); (void)hipDeviceGetAttribute(&cus, hipDeviceAttributeMultiprocessorCount, dev);
        (void)hipOccupancyMaxActiveBlocksPerMultiprocessor(&per_cu, (const void*)mega, 512, LDS_BYTES);
        if (per_cu < 1) per_cu = 1;
        (void)hipGetLastError();
        grid = cus * 1;
    }
    if (grid < 0) return;
    Params p{};
    for (int i = 0; i < 29; ++i) p.in[i] = (const float*)d_in[i];
    p.out = (float*)d_out; p.ws = (unsigned char*)d_ws;
    if (hipMemsetAsync((char*)d_ws + SM_BAR, 0, (XCD_BAR_WORDS + 12 * 128) * sizeof(unsigned), stream) != hipSuccess) { fprintf(stderr, "memset of the barrier / ticket words failed\n"); return; }
#if ONE_LAUNCH
    p.ph_lo = 0; p.ph_hi = N_PHASES;
    void* args[] = {&p};
    hipError_t e = hipLaunchCooperativeKernel((void*)mega, dim3(grid), dim3(512), args, LDS_BYTES, stream);
    if (e != hipSuccess) fprintf(stderr, "cooperative launch failed: %s (grid %d)\n", hipGetErrorString(e), grid);
#else
    for (int ph = 0; ph < N_PHASES; ++ph) { p.ph_lo = ph; p.ph_hi = ph + 1; hipLaunchKernelGGL(mega, dim3(grid), dim3(512), LDS_BYTES, stream, p); }
#endif
}
```

```cpp
#include <hip/hip_runtime.h>
#include <hip/hip_cooperative_groups.h>
#include <cstdio>
namespace cg = cooperative_groups;

#ifndef PROBE2
#define PROBE2 0
#endif
#define PREP(bit) for (int _r = 0; _r < (((PROBE2 >> (bit)) & 1) ? 2 : 1); ++_r)
#ifndef ONE_LAUNCH
#define ONE_LAUNCH 1
#endif

#define LAS __attribute__((address_space(3)))
typedef unsigned short bf16_t;
typedef short bf16x8 __attribute__((ext_vector_type(8)));
typedef float f32x4 __attribute__((ext_vector_type(4)));
typedef unsigned u32x4 __attribute__((ext_vector_type(4)));
typedef unsigned u32x2 __attribute__((ext_vector_type(2)));

constexpr int DM = 2048, MT = 24576, DFF = 5632, NSUB = MT / 16, NCHK = MT / 64;
constexpr float RMS_EPS = 1e-6f;
constexpr int LDS_BYTES = 147456;
constexpr int LDX = 2048 + 64;

constexpr size_t MiB = (size_t)1 << 20;
constexpr size_t SM_G = 0, SM_Y = 8 * MiB, SM_APOW = 24 * MiB, SM_BBAR = 26 * MiB, SM_KD = 27 * MiB, SM_LWT = 29 * MiB,
                 SM_SA = 30 * MiB, SM_SH = 33 * MiB, SM_CIN = 36 * MiB, SM_LSE = 39 * MiB, SM_RS = 41 * MiB + 512 * 1024, SM_BAR = 41 * MiB + 768 * 1024;
constexpr size_t WS_W = 42 * MiB, WS_H = 122 * MiB, WS_BIG = 222 * MiB, WS_END = 918 * MiB;
constexpr size_t B_XL = WS_BIG, B_GL = WS_BIG + 48 * MiB, B_A2 = WS_BIG + 96 * MiB, B_Q = WS_BIG + 192 * MiB, B_K = WS_BIG + 264 * MiB,
                 B_V = WS_BIG + 336 * MiB, B_GA = WS_BIG + 408 * MiB, B_GB = WS_BIG + 504 * MiB, B_GC = WS_BIG + 600 * MiB;
constexpr size_t B_HID = WS_BIG, B_Y = B_GA, B_Y1 = B_K, B_YATT = B_K + 48 * MiB, B_M = B_A2;
constexpr size_t O_S = 0, O_YS5 = 96 * MiB;
constexpr size_t W_13 = 0, W_2 = (size_t)11264 * LDX;
constexpr size_t W_IN = 0, W_GLU = (size_t)13824 * LDX, W_BRL = W_GLU + 1048576, W_BRS = W_BRL + 2097152, W_BRA = W_BRS + 2097152, W_OUT = W_BRA + 1048576;

struct Params { const float* in[29]; float* out; unsigned char* ws; int ph_lo, ph_hi; };

__device__ const unsigned char BUCKET[3][132] = {
 {11,11,11,11,11,11,11,11,11,11,11,11,11,11,11,10,10,10,10,10,10,10,10,10,10,10,10,10,10,10,10,10,10,10,10,10,10,10,9,9,9,9,9,9,9,9,9,9,9,9,8,8,8,8,8,8,8,7,6,5,4,3,2,1,0,17,18,19,20,21,22,23,24,24,24,24,24,24,24,25,25,25,25,25,25,25,25,25,25,25,25,26,26,26,26,26,26,26,26,26,26,26,26,26,26,26,26,26,26,26,26,26,26,26,27,27,27,27,27,27,27,27,27,27,27,27,27,27,27,0,0,0},
 {13,13,13,13,13,13,13,13,13,13,13,13,13,13,13,13,13,13,13,13,13,13,13,12,12,12,12,12,12,12,12,12,12,12,12,12,12,12,12,12,12,12,11,11,11,11,11,11,11,11,11,11,10,10,10,10,10,10,9,9,9,8,8,4,0,20,24,24,25,25,25,26,26,26,26,26,26,27,27,27,27,27,27,27,27,27,27,28,28,28,28,28,28,28,28,28,28,28,28,28,28,28,28,28,28,28,29,29,29,29,29,29,29,29,29,29,29,29,29,29,29,29,29,29,29,29,29,29,29,0,0,0},
 {15,15,15,15,15,15,15,15,15,15,15,15,15,15,15,15,15,15,15,15,15,15,15,15,15,15,15,15,15,15,14,14,14,14,14,14,14,14,14,14,14,14,14,14,14,13,13,13,13,13,13,13,13,13,12,12,12,12,12,11,11,10,10,9,0,25,26,26,27,27,28,28,28,28,28,29,29,29,29,29,29,29,29,29,30,30,30,30,30,30,30,30,30,30,30,30,30,30,30,31,31,31,31,31,31,31,31,31,31,31,31,31,31,31,31,31,31,31,31,31,31,31,31,31,31,31,31,31,31,0,0,0}};

__device__ __forceinline__ unsigned cvt_pk_bf16(float lo, float hi) { unsigned r; asm("v_cvt_pk_bf16_f32 %0, %1, %2" : "=v"(r) : "v"(lo), "v"(hi)); return r; }
__device__ __forceinline__ bf16_t f2bf(float f) { return (bf16_t)(cvt_pk_bf16(f, 0.f) & 0xffffu); }
__device__ __forceinline__ float bf2f(bf16_t b) { return __uint_as_float(((unsigned)b) << 16); }
__device__ __forceinline__ float bflo(unsigned w) { return __uint_as_float(w << 16); }
__device__ __forceinline__ float bfhi(unsigned w) { return __uint_as_float(w & 0xffff0000u); }
__device__ __forceinline__ float sigm(float x) { return __builtin_amdgcn_rcpf(1.0f + __expf(-x)); }
__device__ __forceinline__ float silu(float x) { return x * sigm(x); }
__device__ __forceinline__ float gelu_t(float x) { return x * sigm(1.5957691216057308f * (x + 0.044715f * x * x * x)); }
__device__ __forceinline__ float wave_sum(float v) {
#pragma unroll
    for (int o = 32; o >= 1; o >>= 1) v += __shfl_xor(v, o);
    return v;
}

__device__ __forceinline__ int ltid() { int t = threadIdx.x; asm volatile("" : "+v"(t)); return t; }
__device__ __forceinline__ int lbid() { int b = blockIdx.x; asm volatile("" : "+s"(b)); return b; }

typedef float f32x2 __attribute__((ext_vector_type(2)));
__device__ __forceinline__ f32x2 exp2_2(f32x2 v) { f32x2 r; r.x = __builtin_amdgcn_exp2f(v.x); r.y = __builtin_amdgcn_exp2f(v.y); return r; }
__device__ __forceinline__ f32x2 rcp_2(f32x2 v) { f32x2 r; r.x = __builtin_amdgcn_rcpf(v.x); r.y = __builtin_amdgcn_rcpf(v.y); return r; }
__device__ __forceinline__ f32x2 swiglu2(f32x2 a, f32x2 b, float rn, float r2) { const f32x2 q = rcp_2(exp2_2(a * rn) + 1.0f); return (a * b) * (q * r2); }
__device__ __forceinline__ f32x2 gelu2(f32x2 v) { const f32x2 z = v * ((v * v) * (-0.10294324f) + (-2.3022082f)); return v * rcp_2(exp2_2(z) + 1.0f); }
__device__ __forceinline__ f32x2 sigm2(f32x2 a, float rn) { return rcp_2(exp2_2(a * rn) + 1.0f); }

constexpr int BM = 256, BK = 64, HALF = 128, HTB = HALF * BK * 2, NXCD = 8, WGM = 8;
__device__ __forceinline__ int lds_byte(int r, int c) { const int st = (r >> 4) * 2 + (c >> 5), rr = r & 15, cc = c & 31, ob = rr * 64 + cc * 2; return st * 1024 + (ob ^ (((ob >> 9) & 1) << 5)); }
__device__ __forceinline__ void stage_rc(int b, int& R, int& C) { const int st = b / 1024, sb = b % 1024, swz = sb ^ (((sb >> 9) & 1) << 5); R = (st >> 1) * 16 + swz / 64; C = (st & 1) * 32 + (swz % 64) / 2; }
__device__ __forceinline__ int perm32(int rho) { const int n = rho >> 4, i = rho & 15; return 8 * (i >> 2) + 4 * n + (i & 3); }

struct Unit { int pm, pn, b; };
struct Gemm { const bf16_t* A; const bf16_t* Bt; int lda, ldb, K, nM, nN, nb; size_t sA, sB; };
struct Order {
    int nM, nN, nwg, tot, G, c, nb;
    __device__ void init(const Gemm& g, int G_, int c_) { nM = g.nM; nN = g.nN; nwg = nM * nN; nb = g.nb; tot = nwg * nb; G = G_; c = c_; }
    __device__ bool next(int i, Unit& u) const {
        const long L = (long)i * G + c; if (L >= tot) return false;
        if (nb > 1) { const int b = (int)(L / nwg), rem = (int)(L % nwg); u.b = b; u.pm = rem % nM; u.pn = rem / nM; return true; }
        int wgid = (int)L; { const int q = nwg / NXCD, r = nwg % NXCD, xcd = wgid % NXCD, off = wgid / NXCD; wgid = (xcd < r ? xcd * (q + 1) : r * (q + 1) + (xcd - r) * q) + off; }
        const int nig = WGM * nN, gid = wgid / nig, fm = gid * WGM, gsz = (nM - fm) < WGM ? (nM - fm) : WGM;
        u.pm = fm + ((wgid % nig) % gsz); u.pn = (wgid % nig) / gsz; u.b = 0; return true;
    }
};

__device__ __forceinline__ unsigned hw_xcc_id() { return (unsigned)__builtin_amdgcn_s_getreg((3 << 11) | 20) & 0xFu; }
template <class Epi, bool DYN = false>
__device__ __forceinline__ void gemm_phase(LAS unsigned char* lds, const Gemm g, const Epi& E, unsigned* ctr = nullptr) {
    Order S; S.init(g, (int)gridDim.x, lbid());
    const int tid = ltid(), wid = __builtin_amdgcn_readfirstlane(tid >> 6), lane = tid & 63, wr = wid >> 2, wc = wid & 3, fr = lane & 15, fq = lane >> 4;
    const int K = g.K, nt = K / BK;
    unsigned voffA[2], voffB[2];
#pragma unroll
    for (int i = 0; i < 2; ++i) { int R, C; stage_rc(tid * 16 + i * 8192, R, C); const int Rb = Epi::PERM ? ((R & ~31) + perm32(R & 31)) : R;
        voffA[i] = (unsigned)(R * g.lda + C) * 2u; voffB[i] = (unsigned)(Rb * g.ldb + C) * 2u; }
    const size_t kstep = (size_t)(BK * 2);
    const size_t hstepA = (size_t)HALF * g.lda * 2, hstepB = (size_t)HALF * g.ldb * 2;
    const size_t tstepA = 2 * hstepA, tstepB = 2 * hstepB;
    const unsigned ldsw = (unsigned)wid * 1024u;
    const int aoff = lds_byte(wr * 64 + fr, fq * 8), boff = lds_byte(wc * 32 + fr, fq * 8);
#define PG8_SA(b, h) (((b) * 2 + (h)) * HTB)
#define PG8_SB(b, h) ((4 + (b) * 2 + (h)) * HTB)
#define PG8_STAGE(bufoff, gbase, voff) do { _Pragma("unroll") for (int _i = 0; _i < 2; ++_i) \
        __builtin_amdgcn_global_load_lds((const unsigned*)((const char*)(gbase) + (voff)[_i]), (LAS unsigned*)(lds + (bufoff) + ldsw + _i * 8192), 16, 0, 0); } while (0)
#define PG8_LDA(dst, b, h) do { _Pragma("unroll") for (int m = 0; m < 4; ++m) _Pragma("unroll") for (int k = 0; k < 2; ++k) dst[m][k] = *(const LAS bf16x8*)(lds + PG8_SA(b, h) + aoff + m * 2048 + k * 1024); } while (0)
#define PG8_LDB(dst, b, h) do { _Pragma("unroll") for (int n = 0; n < 2; ++n) _Pragma("unroll") for (int k = 0; k < 2; ++k) dst[n][k] = *(const LAS bf16x8*)(lds + PG8_SB(b, h) + boff + n * 2048 + k * 1024); } while (0)
#define PG8_MMA(ai, bj, At, Bt) do { __builtin_amdgcn_s_setprio(1); _Pragma("unroll") for (int m = 0; m < 4; ++m) _Pragma("unroll") for (int n = 0; n < 2; ++n) _Pragma("unroll") for (int k = 0; k < 2; ++k) \
        acc[ai][bj][m][n] = __builtin_amdgcn_mfma_f32_16x16x32_bf16(Bt[n][k], At[m][k], acc[ai][bj][m][n], 0, 0, 0); __builtin_amdgcn_s_setprio(0); } while (0)
#define PG8_WAIT_V(n) asm volatile("s_waitcnt vmcnt(" #n ")" ::: "memory")
#define PG8_WAIT_L(n) asm volatile("s_waitcnt lgkmcnt(" #n ")" ::: "memory")
#define PG8_BAR __builtin_amdgcn_s_barrier()
#define PG8_SCHED __builtin_amdgcn_sched_barrier(0)
    Unit cur, nxt; int ui = 0;
    LAS int* slot = (LAS int*)(lds + 131072 + 64);
    const int xcd = (int)(hw_xcc_id() & 7u); int ticket = 0;
    auto rng_cnt = [&](int x) { const int q = S.nwg / NXCD, r = S.nwg % NXCD; return q + (x < r ? 1 : 0); };
    auto rng_start = [&](int x) { const int q = S.nwg / NXCD, r = S.nwg % NXCD; return x < r ? x * (q + 1) : r * (q + 1) + (x - r) * q; };
    auto decode = [&](int wgid, Unit& u) { const int nig = WGM * S.nN, gid = wgid / nig, fm = gid * WGM, gsz = (S.nM - fm) < WGM ? (S.nM - fm) : WGM; u.pm = fm + ((wgid % nig) % gsz); u.pn = (wgid % nig) / gsz; u.b = 0; };
    auto issue = [&]() { if (tid == 0) ticket = (int)__hip_atomic_fetch_add(ctr + xcd * 16, 1u, __ATOMIC_RELAXED, __HIP_MEMORY_SCOPE_AGENT); };
    auto publish = [&](int si) { if (tid == 0) { int wg = -1;
            if (ticket < rng_cnt(xcd)) wg = rng_start(xcd) + ticket;
            else { for (int k = 1; k < 8; ++k) { const int x2 = (xcd + k) & 7; const int t2 = (int)__hip_atomic_fetch_add(ctr + x2 * 16, 1u, __ATOMIC_RELAXED, __HIP_MEMORY_SCOPE_AGENT); if (t2 < rng_cnt(x2)) { wg = rng_start(x2) + t2; break; } } }
            slot[si] = wg; } };
    if (DYN) { issue(); publish(0); __syncthreads(); const int w0 = __builtin_amdgcn_readfirstlane(slot[0]); if (w0 < 0) return; decode(w0, cur); issue(); }
    else if (!S.next(0, cur)) return;
    f32x4 acc[2][2][4][2];
#pragma unroll
    for (int a = 0; a < 2; ++a)
#pragma unroll
        for (int b = 0; b < 2; ++b)
#pragma unroll
            for (int m = 0; m < 4; ++m)
#pragma unroll
                for (int n = 0; n < 2; ++n) acc[a][b][m][n] = (f32x4){0.f, 0.f, 0.f, 0.f};
    bf16x8 At[4][2], B0[2][2], B1[2][2];
    const char* cA = (const char*)(g.A + (size_t)cur.b * g.sA) + (size_t)cur.pm * tstepA; const char* cB = (const char*)(g.Bt + (size_t)cur.b * g.sB) + (size_t)cur.pn * tstepB;
    float pre[8];
    E.prefetch(pre, cur, wr, fr);
    PG8_STAGE(PG8_SB(0, 0), cB, voffB); PG8_STAGE(PG8_SA(0, 0), cA, voffA); PG8_STAGE(PG8_SB(0, 1), cB + hstepB, voffB); PG8_STAGE(PG8_SA(0, 1), cA + hstepA, voffA);
    if (wr == 1) PG8_BAR;
    PG8_WAIT_V(4); PG8_BAR;
    PG8_STAGE(PG8_SB(1, 0), cB + kstep, voffB); PG8_STAGE(PG8_SA(1, 0), cA + kstep, voffA); PG8_STAGE(PG8_SB(1, 1), cB + hstepB + kstep, voffB);
    PG8_WAIT_V(6); PG8_BAR;
    for (;;) {
        bool has_next = DYN ? false : S.next(ui + 1, nxt);
        const char* nA = has_next ? (const char*)(g.A + (size_t)nxt.b * g.sA) + (size_t)nxt.pm * tstepA : cA; const char* nB = has_next ? (const char*)(g.Bt + (size_t)nxt.b * g.sB) + (size_t)nxt.pn * tstepB : cB;
        for (int t = 0; t < nt; t += 2) {
            const bool last = (t == nt - 2);
            if (DYN && last) { const int nw = __builtin_amdgcn_readfirstlane(slot[(ui + 1) & 1]); has_next = nw >= 0;
                if (has_next) { decode(nw, nxt); nA = (const char*)g.A + (size_t)nxt.pm * tstepA; nB = (const char*)g.Bt + (size_t)nxt.pn * tstepB; } }
            const char* a1 = cA + (size_t)(t + 1) * kstep;
            const char* a2 = last ? nA : cA + (size_t)(t + 2) * kstep; const char* b2 = last ? nB : cB + (size_t)(t + 2) * kstep;
            const char* a3 = a2 + kstep; const char* b3 = b2 + kstep;
            PG8_LDB(B0, 0, 0); PG8_SCHED; PG8_LDA(At, 0, 0); PG8_STAGE(PG8_SA(1, 1), a1 + hstepA, voffA);
            PG8_WAIT_L(8); PG8_BAR; PG8_WAIT_L(0); PG8_MMA(0, 0, At, B0); PG8_BAR; PG8_SCHED;
            PG8_LDB(B1, 0, 1); PG8_STAGE(PG8_SB(0, 0), b2, voffB);
            PG8_BAR; PG8_WAIT_L(0); PG8_MMA(0, 1, At, B1); PG8_BAR;
            PG8_LDA(At, 0, 1); PG8_STAGE(PG8_SA(0, 0), a2, voffA);
            PG8_BAR; PG8_WAIT_L(0); PG8_MMA(1, 0, At, B0); PG8_BAR; PG8_SCHED;
            PG8_STAGE(PG8_SB(0, 1), b2 + hstepB, voffB);
            PG8_WAIT_V(6); PG8_BAR; PG8_MMA(1, 1, At, B1); PG8_BAR;
            PG8_LDB(B0, 1, 0); PG8_SCHED; PG8_LDA(At, 1, 0); PG8_STAGE(PG8_SA(0, 1), a2 + hstepA, voffA);
            PG8_WAIT_L(8); PG8_BAR; PG8_WAIT_L(0); PG8_MMA(0, 0, At, B0); PG8_BAR; PG8_SCHED;
            PG8_LDB(B1, 1, 1); PG8_STAGE(PG8_SB(1, 0), b3, voffB);
            PG8_BAR; PG8_WAIT_L(0); PG8_MMA(0, 1, At, B1); PG8_BAR;
            PG8_LDA(At, 1, 1); PG8_STAGE(PG8_SA(1, 0), a3, voffA);
            PG8_BAR; PG8_WAIT_L(0); PG8_MMA(1, 0, At, B0); PG8_BAR; PG8_SCHED;
            if (DYN && t == 0) publish((ui + 1) & 1);
            PG8_STAGE(PG8_SB(1, 1), b3 + hstepB, voffB);
            PG8_WAIT_V(6); PG8_BAR; PG8_MMA(1, 1, At, B1); PG8_BAR;
        }
        E(acc, cur, wr, wc, fr, fq, pre);
        if (!has_next) break;
#pragma unroll
        for (int a = 0; a < 2; ++a)
#pragma unroll
            for (int b = 0; b < 2; ++b)
#pragma unroll
                for (int m = 0; m < 4; ++m)
#pragma unroll
                    for (int n = 0; n < 2; ++n) acc[a][b][m][n] = (f32x4){0.f, 0.f, 0.f, 0.f};
        cur = nxt; cA = nA; cB = nB; ++ui;
        if (DYN) issue();
        E.prefetch(pre, cur, wr, fr);
    }
    PG8_WAIT_V(0);
    if (wr == 0) PG8_BAR;
    PG8_BAR;
#undef PG8_SA
#undef PG8_SB
#undef PG8_STAGE
#undef PG8_LDA
#undef PG8_LDB
#undef PG8_MMA
#undef PG8_WAIT_V
#undef PG8_WAIT_L
#undef PG8_BAR
#undef PG8_SCHED
}

#define GAS __attribute__((address_space(1)))
__device__ __forceinline__ u32x4 gld16(const void* p) { return *(const GAS u32x4*)(unsigned long long)p; }
__device__ __forceinline__ void gst16(void* p, u32x4 v) { *(GAS u32x4*)(unsigned long long)p = v; }
__device__ __forceinline__ void gst16nt(void* p, u32x4 v) { __builtin_nontemporal_store(v, (GAS u32x4*)(unsigned long long)p); }
typedef const f32x4 (&AccRef)[2][2][4][2];
__device__ __forceinline__ u32x4 pack8(f32x4 v0, f32x4 v1) { u32x4 w; w.x = cvt_pk_bf16(v0[0], v0[1]); w.y = cvt_pk_bf16(v0[2], v0[3]); w.z = cvt_pk_bf16(v1[0], v1[1]); w.w = cvt_pk_bf16(v1[2], v1[3]); return w; }
__device__ __forceinline__ void unpack8(u32x4 w, f32x4& v0, f32x4& v1) { v0 = (f32x4){bflo(w.x), bfhi(w.x), bflo(w.y), bfhi(w.y)}; v1 = (f32x4){bflo(w.z), bfhi(w.z), bflo(w.w), bfhi(w.w)}; }

struct EpiSwiglu {
    static constexpr bool PERM = true; bf16_t* O; const float* rs;
    __device__ __forceinline__ void prefetch(float (&pre)[8], const Unit& u, int wr, int fr) const {
#pragma unroll
        for (int i = 0; i < 8; ++i) pre[i] = rs[u.pm * BM + wr * 64 + fr + (i >> 2) * HALF + (i & 3) * 16]; }
    __device__ __forceinline__ void operator()(AccRef acc, const Unit& u, int wr, int wc, int fr, int fq, const float (&pre)[8]) const {
        const int row0 = u.pm * BM + wr * 64 + fr, col = u.pn * 128 + wc * 32 + 8 * fq;
#pragma unroll
        for (int ai = 0; ai < 2; ++ai)
#pragma unroll
            for (int m = 0; m < 4; ++m) {
                f32x4 v0, v1; const float r = pre[ai * 4 + m], rn = r * -1.4426950408889634f, r2 = r * r;
                { const f32x4 a0 = acc[ai][0][m][0], a1 = acc[ai][0][m][1], b0 = acc[ai][1][m][0], b1 = acc[ai][1][m][1];
                  const f32x2 o0 = swiglu2((f32x2){a0[0], a0[1]}, (f32x2){b0[0], b0[1]}, rn, r2), o1 = swiglu2((f32x2){a0[2], a0[3]}, (f32x2){b0[2], b0[3]}, rn, r2);
                  const f32x2 o2 = swiglu2((f32x2){a1[0], a1[1]}, (f32x2){b1[0], b1[1]}, rn, r2), o3 = swiglu2((f32x2){a1[2], a1[3]}, (f32x2){b1[2], b1[3]}, rn, r2);
                  v0 = (f32x4){o0.x, o0.y, o1.x, o1.y}; v1 = (f32x4){o2.x, o2.y, o3.x, o3.y}; }
                gst16nt(O + (size_t)(row0 + ai * HALF + m * 16) * DFF + col, pack8(v0, v1));
            }
    }
};
struct EpiBf16 {
    static constexpr bool PERM = true; bf16_t* O; int ldc;
    __device__ __forceinline__ void prefetch(float (&pre)[8], const Unit&, int, int) const {
#pragma unroll
        for (int i = 0; i < 8; ++i) pre[i] = 0.f; }
    __device__ __forceinline__ void operator()(AccRef acc, const Unit& u, int wr, int wc, int fr, int fq, const float (&pre)[8]) const {
        const int row0 = u.pm * BM + wr * 64 + fr, col0 = u.pn * BM + wc * 32 + 8 * fq;
#pragma unroll
        for (int ai = 0; ai < 2; ++ai)
#pragma unroll
            for (int m = 0; m < 4; ++m)
#pragma unroll
                for (int bj = 0; bj < 2; ++bj)
                    gst16(O + (size_t)(row0 + ai * HALF + m * 16) * ldc + col0 + bj * HALF, pack8(acc[ai][bj][m][0], acc[ai][bj][m][1]));
    }
};
struct EpiWin {
    static constexpr bool PERM = true; unsigned char* ws; const float* rs;
    __device__ __forceinline__ void prefetch(float (&pre)[8], const Unit& u, int wr, int fr) const {
#pragma unroll
        for (int i = 0; i < 8; ++i) pre[i] = rs[u.pm * BM + wr * 64 + fr + (i >> 2) * HALF + (i & 3) * 16]; }
    __device__ __forceinline__ void operator()(AccRef acc, const Unit& u, int wr, int wc, int fr, int fq, const float (&pre)[8]) const {
        const int pn = u.pn; int act, ld, cb; size_t base;
        if (pn < 4) { act = 0; ld = 1024; cb = pn * 256; base = B_XL; }
        else if (pn < 8) { act = 1; ld = 1024; cb = (pn - 4) * 256; base = B_GL; }
        else if (pn < 12) { act = 2; ld = 0; cb = (pn - 8) * 256; base = B_A2; }
        else if (pn < 18) { act = 3; ld = 1536; cb = (pn - 12) * 256; base = B_Q; }
        else if (pn < 24) { act = 0; ld = 1536; cb = (pn - 18) * 256; base = B_K; }
        else if (pn < 30) { act = 0; ld = 1536; cb = (pn - 24) * 256; base = B_V; }
        else if (pn < 38) { act = 4; ld = 2048; cb = (pn - 30) * 256; base = B_GA; }
        else if (pn < 46) { act = 4; ld = 2048; cb = (pn - 38) * 256; base = B_GB; }
        else { act = 4; ld = 2048; cb = (pn - 46) * 256; base = B_GC; }
        bf16_t* O = (bf16_t*)(ws + base);
        const int row0 = u.pm * BM + wr * 64 + fr, col0 = cb + wc * 32 + 8 * fq;
#pragma unroll
        for (int ai = 0; ai < 2; ++ai)
#pragma unroll
            for (int m = 0; m < 4; ++m)
#pragma unroll
                for (int bj = 0; bj < 2; ++bj) {
                    const int row = row0 + ai * HALF + m * 16, col = col0 + bj * HALF;
                    const float r = pre[ai * 4 + m]; f32x4 v0 = acc[ai][bj][m][0], v1 = acc[ai][bj][m][1];
                    if (act == 1) { v0 *= r; v1 *= r;
                        const f32x2 o0 = gelu2((f32x2){v0[0], v0[1]}), o1 = gelu2((f32x2){v0[2], v0[3]}), o2 = gelu2((f32x2){v1[0], v1[1]}), o3 = gelu2((f32x2){v1[2], v1[3]});
                        v0 = (f32x4){o0.x, o0.y, o1.x, o1.y}; v1 = (f32x4){o2.x, o2.y, o3.x, o3.y}; }
                    else if (act == 4) { const float rn = r * -1.4426950408889634f;
                        const f32x2 o0 = sigm2((f32x2){v0[0], v0[1]}, rn), o1 = sigm2((f32x2){v0[2], v0[3]}, rn), o2 = sigm2((f32x2){v1[0], v1[1]}, rn), o3 = sigm2((f32x2){v1[2], v1[3]}, rn);
                        v0 = (f32x4){o0.x, o0.y, o1.x, o1.y}; v1 = (f32x4){o2.x, o2.y, o3.x, o3.y}; }
                    else { const float rr = act == 3 ? r * 0.125f : r; v0 *= rr; v1 *= rr; }
                    size_t off;
                    if (act == 2) off = ((size_t)(col >> 4) * NSUB + (row >> 4)) * 512 + (row & 15) * 16 + (col & 15);
                    else off = (size_t)row * ld + col;
                    gst16nt(O + off, pack8(v0, v1));
                }
    }
};
struct EpiS {
    static constexpr bool PERM = false; float* S;
    __device__ __forceinline__ void prefetch(float (&pre)[8], const Unit&, int, int) const {
#pragma unroll
        for (int i = 0; i < 8; ++i) pre[i] = 0.f; }
    __device__ __forceinline__ void operator()(AccRef acc, const Unit& u, int wr, int wc, int fr, int fq, const float (&pre)[8]) const {
        const int row0 = u.pm * BM + wr * 64 + fr, col0 = wc * 32 + 4 * fq;
        float* base = S + (size_t)u.b * NSUB * 256;
#pragma unroll
        for (int ai = 0; ai < 2; ++ai)
#pragma unroll
            for (int m = 0; m < 4; ++m)
#pragma unroll
                for (int bj = 0; bj < 2; ++bj)
#pragma unroll
                    for (int n = 0; n < 2; ++n)
                        *(f32x4*)(base + (size_t)(row0 + ai * HALF + m * 16) * 256 + col0 + bj * HALF + n * 16) = acc[ai][bj][m][n];
    }
};
struct EpiY {
    static constexpr bool PERM = true; bf16_t* Y1;
    __device__ __forceinline__ void prefetch(float (&pre)[8], const Unit&, int, int) const {
#pragma unroll
        for (int i = 0; i < 8; ++i) pre[i] = 0.f; }
    __device__ __forceinline__ void operator()(AccRef acc, const Unit& u, int wr, int wc, int fr, int fq, const float (&pre)[8]) const {
        const int row0 = u.pm * BM + wr * 64 + fr, n0 = wc * 32 + 8 * fq;
#pragma unroll
        for (int ai = 0; ai < 2; ++ai)
#pragma unroll
            for (int m = 0; m < 4; ++m)
#pragma unroll
                for (int bj = 0; bj < 2; ++bj) {
                    const int j = row0 + ai * HALF + m * 16, nn = n0 + bj * HALF, tok = j * 16 + (nn >> 4);
                    f32x4 v0 = acc[ai][bj][m][0], v1 = acc[ai][bj][m][1];
#pragma unroll
                    for (int q = 0; q < 4; ++q) { v0[q] = gelu_t(v0[q]); v1[q] = gelu_t(v1[q]); }
                    gst16(Y1 + (size_t)tok * 1024 + u.b * 16 + (nn & 15), pack8(v0, v1));
                }
    }
};
struct EpiGlu {
    static constexpr bool PERM = true; const bf16_t* Y1; bf16_t* O; const float* bias;
    __device__ __forceinline__ void prefetch(float (&pre)[8], const Unit&, int, int) const {
#pragma unroll
        for (int i = 0; i < 8; ++i) pre[i] = 0.f; }
    __device__ __forceinline__ void operator()(AccRef acc, const Unit& u, int wr, int wc, int fr, int fq, const float (&pre)[8]) const {
        const int row0 = u.pm * BM + wr * 64 + fr, col0 = u.pn * BM + wc * 32 + 8 * fq;
        f32x4 bv[2][2];
#pragma unroll
        for (int bj = 0; bj < 2; ++bj) { bv[bj][0] = *(const GAS f32x4*)(unsigned long long)(bias + col0 + bj * HALF); bv[bj][1] = *(const GAS f32x4*)(unsigned long long)(bias + col0 + bj * HALF + 4); }
#pragma unroll
        for (int ai = 0; ai < 2; ++ai) {
            u32x4 yv[4][2];
#pragma unroll
            for (int m = 0; m < 4; ++m)
#pragma unroll
                for (int bj = 0; bj < 2; ++bj) yv[m][bj] = gld16(Y1 + (size_t)(row0 + ai * HALF + m * 16) * 1024 + col0 + bj * HALF);
#pragma unroll
            for (int m = 0; m < 4; ++m)
#pragma unroll
                for (int bj = 0; bj < 2; ++bj) {
                    f32x4 y0, y1v; unpack8(yv[m][bj], y0, y1v);
                    f32x4 v0 = acc[ai][bj][m][0] + bv[bj][0], v1 = acc[ai][bj][m][1] + bv[bj][1];
#pragma unroll
                    for (int q = 0; q < 4; ++q) { v0[q] = y0[q] * sigm(v0[q]); v1[q] = y1v[q] * sigm(v1[q]); }
                    gst16(O + (size_t)(row0 + ai * HALF + m * 16) * 1024 + col0 + bj * HALF, pack8(v0, v1));
                }
        }
    }
};
template <bool FIRST> struct EpiMerge {
    static constexpr bool PERM = true; const bf16_t* Gt; bf16_t* Mo;
    __device__ __forceinline__ void prefetch(float (&pre)[8], const Unit&, int, int) const {
#pragma unroll
        for (int i = 0; i < 8; ++i) pre[i] = 0.f; }
    __device__ __forceinline__ void operator()(AccRef acc, const Unit& u, int wr, int wc, int fr, int fq, const float (&pre)[8]) const {
        const int row0 = u.pm * BM + wr * 64 + fr, col0 = u.pn * BM + wc * 32 + 8 * fq;
#pragma unroll
        for (int ai = 0; ai < 2; ++ai) {
            u32x4 gv[4][2], mv[4][2];
#pragma unroll
            for (int m = 0; m < 4; ++m)
#pragma unroll
                for (int bj = 0; bj < 2; ++bj) { const size_t off = (size_t)(row0 + ai * HALF + m * 16) * 2048 + col0 + bj * HALF;
                    gv[m][bj] = gld16(Gt + off); mv[m][bj] = FIRST ? (u32x4){0u, 0u, 0u, 0u} : gld16(Mo + off); }
#pragma unroll
            for (int m = 0; m < 4; ++m)
#pragma unroll
                for (int bj = 0; bj < 2; ++bj) { const size_t off = (size_t)(row0 + ai * HALF + m * 16) * 2048 + col0 + bj * HALF;
                    f32x4 g0, g1; unpack8(gv[m][bj], g0, g1);
                    f32x4 v0 = g0 * acc[ai][bj][m][0], v1 = g1 * acc[ai][bj][m][1];
                    if (!FIRST) { f32x4 p0, p1; unpack8(mv[m][bj], p0, p1); v0 += p0; v1 += p1; }
                    gst16(Mo + off, pack8(v0, v1)); }
        }
    }
};

__device__ void cvt_job(unsigned char* shm, const float* src, bf16_t* dst, int K, int N, int mode, const float* kscale = nullptr, int ldd = 0) {
    if (ldd == 0) ldd = K;
    bf16_t* T = (bf16_t*)shm;
    const int tid = ltid(), bid = lbid(), nkt = K / 64, nnt = N / 256, tot = nkt * nnt;
    for (int t = bid; t < tot; t += gridDim.x) {
        const int nti = t % nnt, kt = t / nnt;
        { const int k = tid >> 3, n8 = (tid & 7) * 8;
          const float* s = src + (size_t)(kt * 64 + k) * N + nti * 256 + n8; const float ks = kscale ? kscale[kt * 64 + k] : 1.0f;
          f32x4 v[8];
#pragma unroll
          for (int q = 0; q < 4; ++q) { v[2 * q] = *(const f32x4*)(s + q * 64); v[2 * q + 1] = *(const f32x4*)(s + q * 64 + 4); }
          asm volatile("" ::: "memory");
#pragma unroll
          for (int q = 0; q < 4; ++q)
#pragma unroll
              for (int j = 0; j < 4; ++j) { T[(q * 64 + n8 + j) * 72 + k] = f2bf(v[2 * q][j] * ks); T[(q * 64 + n8 + 4 + j) * 72 + k] = f2bf(v[2 * q + 1][j] * ks); } }
        __syncthreads();
#pragma unroll
        for (int q = 0; q < 4; ++q) { const int n = q * 64 + (tid >> 3), k8 = (tid & 7) * 8; const int nn = nti * 256 + n;
          const int drow = mode == 0 ? nn : ((nn >> 7) * 256 + (nn & 127) + (mode == 2 ? 128 : 0));
          *(u32x4*)(dst + (size_t)drow * ldd + kt * 64 + k8) = *(const u32x4*)(T + n * 72 + k8); }
        __syncthreads();
    }
}
__device__ void cvt_ffn(const Params& p, unsigned char* shm, int l, int sub) {
    bf16_t* W = (bf16_t*)(p.ws + WS_W); const size_t wo = (size_t)(l * 2 + sub) * DM * DFF;
    const float* gk = p.in[2] + (l * 6 + (sub ? 4 : 0)) * DM;
    cvt_job(shm, p.in[26] + wo, W + W_13, DM, DFF, 1, gk, LDX);
    cvt_job(shm, p.in[27] + wo, W + W_13, DM, DFF, 2, gk, LDX);
    cvt_job(shm, p.in[28] + wo, W + W_2, DFF, DM, 0);
}
__device__ void cvt_mixer(const Params& p, unsigned char* shm, int l) {
    bf16_t* W = (bf16_t*)(p.ws + WS_W);
    cvt_job(shm, p.in[3] + (size_t)l * DM * 13824, W + W_IN, DM, 13824, 0, p.in[2] + (l * 6 + 2) * DM, LDX);
    cvt_job(shm, p.in[19] + (size_t)l * 1024 * 1024, W + W_GLU, 1024, 1024, 0);
    cvt_job(shm, p.in[22] + (size_t)l * 1024 * DM, W + W_BRL, 1024, DM, 0);
    cvt_job(shm, p.in[23] + (size_t)l * 1024 * DM, W + W_BRS, 1024, DM, 0);
    cvt_job(shm, p.in[24] + (size_t)l * 512 * DM, W + W_BRA, 512, DM, 0);
    cvt_job(shm, p.in[25] + (size_t)l * DM * DM, W + W_OUT, DM, DM, 0);
}

__device__ void norm_rows(const Params& p, int mode, float scale, const float* gpost) {
    const int tid = ltid(), bid = lbid(), lane = tid & 63, wid = tid >> 6;
    bf16_t* X = (bf16_t*)(p.ws + WS_H); const bf16_t* Y = (const bf16_t*)(p.ws + B_Y); float* RS = (float*)(p.ws + SM_RS);
    for (int row = bid * 8 + wid; row < MT; row += gridDim.x * 8) {
        f32x4 xv[8];
        if (mode == 0) {
            const float* xr = row < 8192 ? p.in[0] + (size_t)row * DM : p.in[1] + (size_t)(row - 8192) * DM;
#pragma unroll
            for (int c = 0; c < 4; ++c) { xv[2 * c] = *(const f32x4*)(xr + (c * 64 + lane) * 8); xv[2 * c + 1] = *(const f32x4*)(xr + (c * 64 + lane) * 8 + 4); }
            asm volatile("" ::: "memory");
        } else {
            f32x4 yv[8]; float ss = 0.f; u32x4 xw[4], yw[4]; f32x4 gq[8];
#pragma unroll
            for (int c = 0; c < 4; ++c) { xw[c] = *(const u32x4*)(X + (size_t)row * LDX + (c * 64 + lane) * 8); yw[c] = *(const u32x4*)(Y + (size_t)row * DM + (c * 64 + lane) * 8); }
#pragma unroll
            for (int c = 0; c < 4; ++c) { gq[2 * c] = *(const f32x4*)(gpost + (c * 64 + lane) * 8); gq[2 * c + 1] = *(const f32x4*)(gpost + (c * 64 + lane) * 8 + 4); }
            asm volatile("" ::: "memory");
#pragma unroll
            for (int c = 0; c < 4; ++c) { unpack8(xw[c], xv[2 * c], xv[2 * c + 1]); unpack8(yw[c], yv[2 * c], yv[2 * c + 1]); }
#pragma unroll
            for (int c = 0; c < 8; ++c) ss += yv[c][0] * yv[c][0] + yv[c][1] * yv[c][1] + yv[c][2] * yv[c][2] + yv[c][3] * yv[c][3];
            ss = wave_sum(ss);
            const float rs = rsqrtf(ss * (1.0f / DM) + RMS_EPS) * scale;
#pragma unroll
            for (int c = 0; c < 4; ++c) { xv[2 * c] += yv[2 * c] * gq[2 * c] * rs; xv[2 * c + 1] += yv[2 * c + 1] * gq[2 * c + 1] * rs; }
        }
        if (mode == 2) {
#pragma unroll
            for (int c = 0; c < 4; ++c) { *(f32x4*)(p.out + (size_t)row * DM + (c * 64 + lane) * 8) = xv[2 * c]; *(f32x4*)(p.out + (size_t)row * DM + (c * 64 + lane) * 8 + 4) = xv[2 * c + 1]; }
        } else {
            float ss = 0.f;
#pragma unroll
            for (int c = 0; c < 8; ++c) ss += xv[c][0] * xv[c][0] + xv[c][1] * xv[c][1] + xv[c][2] * xv[c][2] + xv[c][3] * xv[c][3];
            ss = wave_sum(ss);
#pragma unroll
            for (int c = 0; c < 4; ++c) *(u32x4*)(X + (size_t)row * LDX + (c * 64 + lane) * 8) = pack8(xv[2 * c], xv[2 * c + 1]);
            if (lane == 0) RS[row] = rsqrtf(ss * (1.0f / DM) + RMS_EPS);
        }
    }
}

__device__ void s5_stage1(const Params& p, int l) {
    float2* Apow = (float2*)(p.ws + SM_APOW); float2* Bbar = (float2*)(p.ws + SM_BBAR);
    for (int idx = lbid() * 512 + ltid(); idx < 8192; idx += gridDim.x * 512) {
        const float lr = p.in[11][l * 8192 + idx], li = p.in[12][l * 8192 + idx], dt = expf(p.in[13][l * 128 + (idx >> 6)]);
        f32x4 br4[4], bi4[4];
#pragma unroll
        for (int c = 0; c < 4; ++c) { br4[c] = *(const f32x4*)(p.in[14] + (size_t)l * 131072 + idx * 16 + c * 4); bi4[c] = *(const f32x4*)(p.in[15] + (size_t)l * 131072 + idx * 16 + c * 4); }
        asm volatile("" ::: "memory");
        float ar = 1.f, ai = 0.f;
        for (int k = 0; k < 18; ++k) { const float mag = expf((float)k * lr * dt); float s, c; sincosf((float)k * li * dt, &s, &c); Apow[idx * 18 + k] = make_float2(mag * c, mag * s); if (k == 1) { ar = mag * c; ai = mag * s; } }
        const float den = lr * lr + li * li, cr = ((ar - 1.0f) * lr + ai * li) / den, ci = (ai * lr - (ar - 1.0f) * li) / den;
#pragma unroll
        for (int c = 0; c < 16; ++c) { const float br = br4[c >> 2][c & 3], bi = bi4[c >> 2][c & 3];
            Bbar[idx * 16 + c] = make_float2(cr * br - ci * bi, cr * bi + ci * br); }
    }
}
__device__ void s5_stage2(const Params& p, int l) {
    const float2* Apow = (const float2*)(p.ws + SM_APOW); const float2* Bbar = (const float2*)(p.ws + SM_BBAR);
    float* Kd = (float*)(p.ws + SM_KD); bf16_t* Gm = (bf16_t*)(p.ws + SM_G); bf16_t* Ym = (bf16_t*)(p.ws + SM_Y); bf16_t* LWT = (bf16_t*)(p.ws + SM_LWT);
    const float* cre = p.in[16] + (size_t)l * 131072; const float* cim = p.in[17] + (size_t)l * 131072;
    const int gs = gridDim.x * 512, t0 = lbid() * 512 + ltid();
    for (int o = t0; o < 524288; o += gs) {
        const int c2 = o & 15, c = (o >> 4) & 15, k = (o >> 8) & 15, dg = o >> 12;
        float acc = 0.f;
        for (int p0 = 0; p0 < 64; p0 += 8) {
            float2 A[8], Bb[8]; float Cr[8], Ci[8];
#pragma unroll
            for (int q = 0; q < 8; ++q) { const int sidx = dg * 64 + p0 + q; A[q] = Apow[sidx * 18 + k]; Bb[q] = Bbar[sidx * 16 + c2]; Cr[q] = cre[(dg * 16 + c) * 64 + p0 + q]; Ci[q] = cim[(dg * 16 + c) * 64 + p0 + q]; }
            asm volatile("" ::: "memory");
#pragma unroll
            for (int q = 0; q < 8; ++q) { const float abr = A[q].x * Bb[q].x - A[q].y * Bb[q].y, abi = A[q].x * Bb[q].y + A[q].y * Bb[q].x; acc += Cr[q] * abr - Ci[q] * abi; }
        }
        Kd[o] = acc;
    }
    for (int ob = t0; ob < 64 * 65536; ob += 4 * gs) {
        float2 A1[4], B1[4], A2v[4]; float Cr[4], Ci[4];
#pragma unroll
        for (int q = 0; q < 4; ++q) { const int o = min(ob + q * gs, 64 * 65536 - 1); const int kk = o & 255, n = (o >> 8) & 255, g = o >> 16;
            { const int d = n >> 7, pp = n & 63, s = kk >> 4, c2 = kk & 15, e = d == 0 ? 15 - s : s; const int sidx = (d * 64 + g) * 64 + pp; A1[q] = Apow[sidx * 18 + e]; B1[q] = Bbar[sidx * 16 + c2]; }
            { const int tau = n >> 4, c = n & 15, d = kk >> 7, pp = kk & 63, e = d == 0 ? tau + 1 : 16 - tau; const int sidx = (d * 64 + g) * 64 + pp;
              A2v[q] = Apow[sidx * 18 + e]; Cr[q] = cre[((d * 64 + g) * 16 + c) * 64 + pp]; Ci[q] = cim[((d * 64 + g) * 16 + c) * 64 + pp]; } }
        asm volatile("" ::: "memory");
#pragma unroll
        for (int q = 0; q < 4; ++q) { const int o = ob + q * gs; if (o >= 64 * 65536) break; const int kk = o & 255, n = (o >> 8) & 255, g = o >> 16;
            Gm[o] = f2bf(((n >> 6) & 1) ? A1[q].x * B1[q].y + A1[q].y * B1[q].x : A1[q].x * B1[q].x - A1[q].y * B1[q].y);
            Ym[((size_t)g * 256 + n) * 512 + 256 + kk] = f2bf(((kk >> 6) & 1) ? -(Cr[q] * A2v[q].y + Ci[q] * A2v[q].x) : Cr[q] * A2v[q].x - Ci[q] * A2v[q].y); }
    }
    for (int o = t0; o < 262144; o += gs) {
        const int i = o & 63, j = (o >> 6) & 63, n = (o >> 12) & 15, gate = (o >> 16) & 1, d = o >> 17;
        const float* src = gate ? p.in[8] : p.in[6];
        LWT[o] = f2bf(src[(size_t)((l * 2 + d) * 16 + n) * 4096 + i * 64 + j]);
    }
}
__device__ void s5_stage3(const Params& p, int l) {
    const float* Kd = (const float*)(p.ws + SM_KD); bf16_t* Ym = (bf16_t*)(p.ws + SM_Y); const float* Dk = p.in[18] + l * 1024;
    const int gs = gridDim.x * 512;
    for (int ob = lbid() * 512 + ltid(); ob < 64 * 65536; ob += 4 * gs) {
        float kf[4], kr[4], dd[4];
#pragma unroll
        for (int q = 0; q < 4; ++q) { const int o = min(ob + q * gs, 64 * 65536 - 1); const int kk = o & 255, n = (o >> 8) & 255, g = o >> 16, s = kk >> 4, c2 = kk & 15, tau = n >> 4, c = n & 15;
            const int df = s <= tau ? tau - s : 0, dr = s >= tau ? s - tau : 0;
            kf[q] = Kd[((0 * 64 + g) * 16 + df) * 256 + c * 16 + c2]; kr[q] = Kd[((1 * 64 + g) * 16 + dr) * 256 + c * 16 + c2]; dd[q] = Dk[g * 16 + c]; }
        asm volatile("" ::: "memory");
#pragma unroll
        for (int q = 0; q < 4; ++q) { const int o = ob + q * gs; if (o >= 64 * 65536) break; const int kk = o & 255, n = (o >> 8) & 255, g = o >> 16, s = kk >> 4, c2 = kk & 15, tau = n >> 4, c = n & 15;
            float v = 0.f; if (s <= tau) v += kf[q]; if (s >= tau) v += kr[q]; if (s == tau && c == c2) v += dd[q];
            Ym[((size_t)g * 256 + n) * 512 + kk] = f2bf(v); }
    }
}
__device__ void s5_bscan(const Params& p, unsigned char* shm) {
    const float2* Apow = (const float2*)(p.ws + SM_APOW); const float* S = (const float*)((const unsigned char*)p.out + O_S); bf16_t* A2 = (bf16_t*)(p.ws + B_A2);
    float2* Es = (float2*)shm;
    const int tid = ltid();
    for (int it = lbid(); it < 192; it += gridDim.x) {
        const bool lng = it < 128;
        const int pp = tid & 63, g = lng ? it >> 1 : it - 128, d = lng ? (it & 1) : ((tid >> 6) & 1), seg = lng ? tid >> 6 : 0, seq = lng ? 4 : tid >> 7;
        const int j0 = lng ? 512 + seg * 128 : seq * 128;
        const float2 A16 = Apow[((d * 64 + g) * 64 + pp) * 18 + 16];
        const float* Sg = S + (size_t)g * NSUB * 256 + d * 128 + pp; bf16_t* Xg = A2 + (size_t)g * NSUB * 512 + 256 + d * 128 + pp;
        float xr = 0.f, xi = 0.f;
        if (lng) {
            for (int jb = 0; jb < 128; jb += 16) {
                float sr[16], si[16];
#pragma unroll
                for (int u = 0; u < 16; ++u) { const int j = d ? (j0 + 127 - (jb + u)) : (j0 + jb + u); sr[u] = Sg[(size_t)j * 256]; si[u] = Sg[(size_t)j * 256 + 64]; }
                asm volatile("" ::: "memory");
#pragma unroll
                for (int u = 0; u < 16; ++u) { const float nr = A16.x * xr - A16.y * xi + sr[u], ni = A16.x * xi + A16.y * xr + si[u]; xr = nr; xi = ni; }
            }
            Es[seg * 64 + pp] = make_float2(xr, xi);
            float2 Ab = A16;
#pragma unroll
            for (int q = 0; q < 7; ++q) Ab = make_float2(Ab.x * Ab.x - Ab.y * Ab.y, 2.0f * Ab.x * Ab.y);
            __syncthreads();
            xr = 0.f; xi = 0.f;
            for (int q = 0; q < 8; ++q) { const int sq = d ? 7 - q : q; const bool use = d ? (sq > seg) : (sq < seg);
                if (use) { const float2 E = Es[sq * 64 + pp]; const float nr = Ab.x * xr - Ab.y * xi + E.x, ni = Ab.x * xi + Ab.y * xr + E.y; xr = nr; xi = ni; } }
        }
        for (int jb = 0; jb < 128; jb += 16) {
            float sr[16], si[16];
#pragma unroll
            for (int u = 0; u < 16; ++u) { const int j = d ? (j0 + 127 - (jb + u)) : (j0 + jb + u); sr[u] = Sg[(size_t)j * 256]; si[u] = Sg[(size_t)j * 256 + 64]; }
            asm volatile("" ::: "memory");
#pragma unroll
            for (int u = 0; u < 16; ++u) { const int j = d ? (j0 + 127 - (jb + u)) : (j0 + jb + u);
                Xg[(size_t)j * 512] = f2bf(xr); Xg[(size_t)j * 512 + 64] = f2bf(xi);
                const float nr = A16.x * xr - A16.y * xi + sr[u], ni = A16.x * xi + A16.y * xr + si[u]; xr = nr; xi = ni; }
        }
        __syncthreads();
    }
}

template <int PASS>
__device__ void lru_items(const Params& p, unsigned char* shm, int l) {
    bf16_t* xraw = (bf16_t*)shm;
    float* xcf = (float*)(shm + 8704);
    bf16_t* xcb = (bf16_t*)(shm + 25344);
    bf16_t* wt = (bf16_t*)(shm + 34560);
    float* As = (float*)(shm + 71424);
    float* Bs = (float*)(shm + 104192);
    float* Pq = (float*)(shm + 136960);
    float* Hq = (float*)(shm + 139008);
    const bf16_t* XL = (const bf16_t*)(p.ws + B_XL); bf16_t* GL = (bf16_t*)(p.ws + B_GL); const bf16_t* LWT = (const bf16_t*)(p.ws + SM_LWT);
    float* SA = (float*)(p.ws + SM_SA); float* SH = (float*)(p.ws + SM_SH); const float* CIN = (const float*)(p.ws + SM_CIN);
    const float* cw = p.in[4] + l * 4096; const float* cbias = p.in[5] + l * 1024;
    const int tid = ltid(), lane = tid & 63, w = tid >> 6, fr = lane & 15, fq = lane >> 4, G_ = gridDim.x, total = NCHK * 16;
    int n_loaded = -1;
    float c0 = 0.f, c1 = 0.f, c2 = 0.f, c3 = 0.f, cb = 0.f, gba[4], gbx[4], gsp[4];
#pragma unroll
    for (int jt = 0; jt < 4; ++jt) { gba[jt] = 0.f; gbx[jt] = 0.f; gsp[jt] = 0.f; }
    u32x4 xr0 = (u32x4){0u, 0u, 0u, 0u}, xr1 = (u32x4){0u, 0u, 0u, 0u};
#define LRU_LOAD(IT) do { const int ck_ = (IT) >> 4, n_ = (IT) & 15, t0_ = ck_ * 64; const int ss_ = t0_ < 8192 ? (t0_ & ~2047) : 8192, se_ = t0_ < 8192 ? ss_ + 2048 : MT; \
        { const int row = tid >> 3, c8 = tid & 7, tok = t0_ - 2 + row; xr0 = (u32x4){0u, 0u, 0u, 0u}; if (tok >= ss_ && tok < se_) xr0 = *(const u32x4*)(XL + (size_t)tok * 1024 + n_ * 64 + c8 * 8); } \
        if (tid < 24) { const int row = 64 + (tid >> 3), c8 = tid & 7, tok = t0_ - 2 + row; xr1 = (u32x4){0u, 0u, 0u, 0u}; if (tok >= ss_ && tok < se_) xr1 = *(const u32x4*)(XL + (size_t)tok * 1024 + n_ * 64 + c8 * 8); } } while (0)
    int it = lbid();
    if (it < total) LRU_LOAD(it);
    for (; it < total; it += G_) {
        const int ck = it >> 4, n = it & 15, t0 = ck * 64;
        *(u32x4*)(xraw + (tid >> 3) * 64 + (tid & 7) * 8) = xr0;
        if (tid < 24) *(u32x4*)(xraw + (64 + (tid >> 3)) * 64 + (tid & 7) * 8) = xr1;
        if (n != n_loaded) {
            n_loaded = n;
#pragma unroll
            for (int i = 0; i < 4; ++i) { const int e = tid + 512 * i, mtx = e >> 9, rem = e & 511, j = rem >> 3, c8 = rem & 7;
                *(u32x4*)(wt + (mtx * 64 + j) * 72 + c8 * 8) = *(const u32x4*)(LWT + ((size_t)(mtx * 16 + n) * 64 + j) * 64 + c8 * 8); }
            { const int ch = n * 64 + (tid & 63); c0 = cw[ch]; c1 = cw[1024 + ch]; c2 = cw[2048 + ch]; c3 = cw[3072 + ch]; cb = cbias[ch]; }
#pragma unroll
            for (int jt = 0; jt < 4; ++jt) { const int pi = (l * 2 + (w >> 2)) * 1024 + n * 64 + jt * 16 + fr; gba[jt] = p.in[7][pi]; gbx[jt] = p.in[9][pi]; gsp[jt] = -8.0f * log1pf(__expf(-p.in[10][pi])); }
        }
        u32x4 glv = (u32x4){0u, 0u, 0u, 0u}; float cin = 0.f;
        const size_t go = (size_t)(t0 + (tid >> 3)) * 1024 + n * 64 + (tid & 7) * 8;
        const size_t so = (size_t)(ck * 2 + ((tid >> 6) & 1)) * 1024 + n * 64 + (tid & 63);
        if (PASS == 1) { glv = *(const u32x4*)(GL + go); cin = CIN[so]; }
        asm volatile("" ::: "memory");
        __syncthreads();
        if (it + G_ < total) LRU_LOAD(it + G_);
        asm volatile("" ::: "memory");
        { const int j = tid & 63;
#pragma unroll
          for (int i = 0; i < 8; ++i) { const int t = (tid >> 6) + 8 * i;
              const float v = cb + bf2f(xraw[t * 64 + j]) * c0 + bf2f(xraw[(t + 1) * 64 + j]) * c1 + bf2f(xraw[(t + 2) * 64 + j]) * c2 + bf2f(xraw[(t + 3) * 64 + j]) * c3;
              xcf[t * 65 + j] = v; xcb[t * 72 + j] = f2bf(v); } }
        __syncthreads();
        { const int d = w >> 2, tt = w & 3;
          const bf16x8 a0 = *(const bf16x8*)(xcb + (tt * 16 + fr) * 72 + fq * 8), a1 = *(const bf16x8*)(xcb + (tt * 16 + fr) * 72 + 32 + fq * 8);
#pragma unroll
          for (int jt = 0; jt < 4; ++jt) {
              f32x4 accr = (f32x4){0.f, 0.f, 0.f, 0.f}, acci = (f32x4){0.f, 0.f, 0.f, 0.f};
              const bf16_t* wr_ = wt + ((d * 2 + 0) * 64 + jt * 16 + fr) * 72 + fq * 8; const bf16_t* wi_ = wt + ((d * 2 + 1) * 64 + jt * 16 + fr) * 72 + fq * 8;
              accr = __builtin_amdgcn_mfma_f32_16x16x32_bf16(a0, *(const bf16x8*)wr_, accr, 0, 0, 0);
              accr = __builtin_amdgcn_mfma_f32_16x16x32_bf16(a1, *(const bf16x8*)(wr_ + 32), accr, 0, 0, 0);
              acci = __builtin_amdgcn_mfma_f32_16x16x32_bf16(a0, *(const bf16x8*)wi_, acci, 0, 0, 0);
              acci = __builtin_amdgcn_mfma_f32_16x16x32_bf16(a1, *(const bf16x8*)(wi_ + 32), acci, 0, 0, 0);
              const int j = jt * 16 + fr;
#pragma unroll
              for (int i = 0; i < 4; ++i) { const int t = tt * 16 + fq * 4 + i;
                  const float r = sigm(accr[i] + gba[jt]), ig = sigm(acci[i] + gbx[jt]), a = __expf(r * gsp[jt]);
                  As[(d * 64 + t) * 64 + j] = a;
                  Bs[(d * 64 + t) * 64 + j] = sqrtf(fmaxf(1.0f - a * a, 0.f)) * ig * xcf[t * 65 + j]; }
          } }
        __syncthreads();
        {
            const int seg = tid >> 7, d = (tid >> 6) & 1, j = tid & 63;
            float h = 0.f, P = 1.f;
#pragma unroll
            for (int s = 0; s < 16; ++s) { const int st = seg * 16 + s, t = d ? 63 - st : st; const float a = As[(d * 64 + t) * 64 + j]; h = a * h + Bs[(d * 64 + t) * 64 + j]; P *= a; }
            Pq[seg * 128 + (tid & 127)] = P; Hq[seg * 128 + (tid & 127)] = h;
            __syncthreads();
            if (PASS == 0) {
                if (tid < 128) { float hh = Hq[tid], PP = Pq[tid];
#pragma unroll
                    for (int q = 1; q < 4; ++q) { const float pq = Pq[q * 128 + tid]; hh = pq * hh + Hq[q * 128 + tid]; PP *= pq; }
                    SA[so] = PP; SH[so] = hh; }
            } else {
                float c = cin;
#pragma unroll
                for (int q = 0; q < 3; ++q) if (q < seg) c = Pq[q * 128 + (tid & 127)] * c + Hq[q * 128 + (tid & 127)];
#pragma unroll
                for (int s = 0; s < 16; ++s) { const int st = seg * 16 + s, t = d ? 63 - st : st; c = As[(d * 64 + t) * 64 + j] * c + Bs[(d * 64 + t) * 64 + j]; Bs[(d * 64 + t) * 64 + j] = c; }
                __syncthreads();
                const int t = tid >> 3, c8 = tid & 7;
                f32x4 g0, g1; unpack8(glv, g0, g1);
                const f32x4 f0 = *(const f32x4*)(Bs + t * 64 + c8 * 8), f1 = *(const f32x4*)(Bs + t * 64 + c8 * 8 + 4), r0 = *(const f32x4*)(Bs + (64 + t) * 64 + c8 * 8), r1 = *(const f32x4*)(Bs + (64 + t) * 64 + c8 * 8 + 4);
                *(u32x4*)(GL + go) = pack8((f0 + r0) * g0, (f1 + r1) * g1);
            }
        }
        __syncthreads();
    }
#undef LRU_LOAD
}
__device__ void lru_carry(const Params& p) {
    const float* SA = (const float*)(p.ws + SM_SA); const float* SH = (const float*)(p.ws + SM_SH); float* CIN = (float*)(p.ws + SM_CIN);
    const int tid_ = ltid();
    const int G_ = gridDim.x, b0 = lbid(), first = G_ >= 212 ? 192 : 0;
    for (int it = (b0 - first + G_) % G_; it < 20; it += G_) {
        const int c = it * 512 + tid_, ch = c & 1023, d = (c >> 10) & 1, seq = c >> 11;
        const int k0 = seq < 4 ? seq * 32 : 128, nk = seq < 4 ? 32 : 256;
        float carry = 0.f;
        for (int kb = 0; kb < nk; kb += 16) {
            float a[16], h[16];
#pragma unroll
            for (int u = 0; u < 16; ++u) { const int k = d ? (k0 + nk - 1 - (kb + u)) : (k0 + kb + u); a[u] = SA[(size_t)(k * 2 + d) * 1024 + ch]; h[u] = SH[(size_t)(k * 2 + d) * 1024 + ch]; }
            asm volatile("" ::: "memory");
#pragma unroll
            for (int u = 0; u < 16; ++u) { const int k = d ? (k0 + nk - 1 - (kb + u)) : (k0 + kb + u); CIN[(size_t)(k * 2 + d) * 1024 + ch] = carry; carry = a[u] * carry + h[u]; }
        }
    }
}

struct AttnGeom { int hd, seq_start, dil, n_lat, r, q0; };
__device__ __forceinline__ AttnGeom attn_geom(int it) {
    AttnGeom G; G.hd = it / 192; const int qt = it % 192;
    int T, lt; if (qt < 64) { G.seq_start = (qt >> 4) * 2048; T = 2048; lt = qt & 15; } else { G.seq_start = 8192; T = 16384; lt = qt - 64; }
    const int g = G.hd >> 3; G.dil = g == 0 ? 1 : (g == 1 ? 4 : 16); G.n_lat = T / G.dil; const int tpr = G.n_lat >> 7; G.r = lt / tpr; G.q0 = (lt % tpr) << 7; return G;
}
__device__ void attn_items(const Params& p, unsigned char* shm) {
    bf16_t* Ks = (bf16_t*)shm;
    bf16_t* Vt = (bf16_t*)(shm + 36864);
    bf16_t* Ps = (bf16_t*)(shm + 77824);
    float* BT = (float*)(shm + 120832);
    bf16_t* Qb = (bf16_t*)(p.ws + B_Q); const bf16_t* Kb = (const bf16_t*)(p.ws + B_K); const bf16_t* Vb = (const bf16_t*)(p.ws + B_V);
    float* LSE = (float*)(p.ws + SM_LSE);
    const int tid = ltid(), lane = tid & 63, w = tid >> 6, fr = lane & 15, fq = lane >> 4, G_ = gridDim.x;
    for (int i = tid; i < 24 * 129; i += 512) { const int hd = i / 129, j = i % 129; BT[hd * 132 + j] = p.in[21][(int)BUCKET[hd >> 3][j] * 24 + hd]; }
    u32x4 kreg[5], vreg[5]; bf16x8 q0r, q1r;
    const int total = 24 * 192;
    int it = lbid();
#define ATT_LOAD(IT) do { const AttnGeom G = attn_geom(IT); \
        _Pragma("unroll") for (int i = 0; i < 5; ++i) { const int e = tid + 512 * i, kk = e >> 3, c8 = e & 7, lat = G.q0 - 64 + kk; const bool ok = e < 2176 && kk < 256 && lat >= 0 && lat < G.n_lat; \
            kreg[i] = (u32x4){0u, 0u, 0u, 0u}; vreg[i] = (u32x4){0u, 0u, 0u, 0u}; \
            if (ok) { const size_t go = (size_t)(G.seq_start + G.r + G.dil * lat) * 1536 + G.hd * 64 + c8 * 8; kreg[i] = *(const u32x4*)(Kb + go); vreg[i] = *(const u32x4*)(Vb + go); } } \
        const size_t qo = (size_t)(G.seq_start + G.r + G.dil * (G.q0 + 16 * w + fr)) * 1536 + G.hd * 64; \
        q0r = *(const bf16x8*)(Qb + qo + fq * 8); q1r = *(const bf16x8*)(Qb + qo + 32 + fq * 8); } while (0)
    if (it < total) ATT_LOAD(it);
    for (; it < total; it += G_) {
        const AttnGeom G = attn_geom(it);
#pragma unroll
        for (int i = 0; i < 5; ++i) { const int e = tid + 512 * i, kk = e >> 3, c8 = e & 7;
            if (e < 2176) {
                if (kk < 256) *(u32x4*)(Ks + kk * 72 + c8 * 8) = kreg[i];
#pragma unroll
                for (int j = 0; j < 8; ++j) Vt[(c8 * 8 + j) * 320 + (kk ^ (c8 << 3))] = (bf16_t)((vreg[i][j >> 1] >> ((j & 1) * 16)) & 0xffffu); } }
        const bf16x8 aq0 = q0r, aq1 = q1r;
        __syncthreads();
        if (it + G_ < total) ATT_LOAD(it + G_);
        asm volatile("" ::: "memory");
        const float* bs = BT + G.hd * 132;
        f32x4 s[9];
#pragma unroll
        for (int kt = 0; kt < 9; ++kt) { const bf16_t* kr = Ks + (16 * w + 16 * kt + fr) * 72 + fq * 8;
            f32x4 a = (f32x4){0.f, 0.f, 0.f, 0.f};
            a = __builtin_amdgcn_mfma_f32_16x16x32_bf16(aq0, *(const bf16x8*)kr, a, 0, 0, 0);
            a = __builtin_amdgcn_mfma_f32_16x16x32_bf16(aq1, *(const bf16x8*)(kr + 32), a, 0, 0, 0); s[kt] = a; }
        float mx[4], ls[4];
#pragma unroll
        for (int i = 0; i < 4; ++i) { const int qi = fq * 4 + i; float m = -3.0e38f;
#pragma unroll
            for (int kt = 0; kt < 9; ++kt) { const int rel = 16 * kt + fr - 64 - qi, klat = G.q0 - 64 + 16 * w + 16 * kt + fr;
                const bool ok = rel >= -64 && rel <= 64 && klat >= 0 && klat < G.n_lat; const int bi = min(max(rel + 64, 0), 128);
                const float v = ok ? s[kt][i] + bs[bi] : -1.0e30f; s[kt][i] = v; m = fmaxf(m, v); }
            m = fmaxf(m, __shfl_xor(m, 1)); m = fmaxf(m, __shfl_xor(m, 2)); m = fmaxf(m, __shfl_xor(m, 4)); m = fmaxf(m, __shfl_xor(m, 8));
            float sum = 0.f;
#pragma unroll
            for (int kt = 0; kt < 9; ++kt) { const float pv = __expf(s[kt][i] - m); s[kt][i] = pv; sum += pv; }
            sum += __shfl_xor(sum, 1); sum += __shfl_xor(sum, 2); sum += __shfl_xor(sum, 4); sum += __shfl_xor(sum, 8);
            mx[i] = m; ls[i] = sum; }
        bf16_t* Pw = Ps + w * 16 * 168;
#pragma unroll
        for (int i = 0; i < 4; ++i) {
#pragma unroll
            for (int kt = 0; kt < 9; ++kt) Pw[(fq * 4 + i) * 168 + 16 * kt + fr] = f2bf(s[kt][i]);
            Pw[(fq * 4 + i) * 168 + 144 + fr] = 0; }
        __syncthreads();
        f32x4 o[4];
#pragma unroll
        for (int nt = 0; nt < 4; ++nt) o[nt] = (f32x4){0.f, 0.f, 0.f, 0.f};
#pragma unroll
        for (int ks = 0; ks < 5; ++ks) { const bf16x8 ap = *(const bf16x8*)(Pw + fr * 168 + ks * 32 + fq * 8);
#pragma unroll
            for (int nt = 0; nt < 4; ++nt) { const int dim = nt * 16 + fr; o[nt] = __builtin_amdgcn_mfma_f32_16x16x32_bf16(ap, *(const bf16x8*)(Vt + dim * 320 + ((16 * w + ks * 32 + fq * 8) ^ ((dim >> 3) << 3))), o[nt], 0, 0, 0); } }
        __syncthreads();
#pragma unroll
        for (int i = 0; i < 4; ++i) { const float inv = 1.0f / ls[i];
#pragma unroll
            for (int nt = 0; nt < 4; ++nt) Pw[(fq * 4 + i) * 168 + nt * 16 + fr] = f2bf(o[nt][i] * inv);
            if (fr == 0) LSE[(size_t)(G.seq_start + G.r + G.dil * (G.q0 + 16 * w + fq * 4 + i)) * 24 + G.hd] = mx[i] + __logf(ls[i]); }
        __syncthreads();
#pragma unroll
        for (int h = 0; h < 2; ++h) { const int c = lane + 64 * h, row = c >> 3, c8 = c & 7;
            *(u32x4*)(Qb + (size_t)(G.seq_start + G.r + G.dil * (G.q0 + 16 * w + row)) * 1536 + G.hd * 64 + c8 * 8) = *(const u32x4*)(Pw + row * 168 + c8 * 8); }
        __syncthreads();
    }
#undef ATT_LOAD
}
__device__ void attn_combine(const Params& p) {
    const bf16_t* Ab = (const bf16_t*)(p.ws + B_Q); const float* LSE = (const float*)(p.ws + SM_LSE); bf16_t* YA = (bf16_t*)(p.ws + B_YATT);
    for (int e = lbid() * 512 + ltid(); e < MT * 64; e += gridDim.x * 512) {
        const int tok = e >> 6, h = (e >> 3) & 7, c8 = e & 7;
        const float l0 = LSE[(size_t)tok * 24 + h], l1 = LSE[(size_t)tok * 24 + 8 + h], l2 = LSE[(size_t)tok * 24 + 16 + h];
        const float m = fmaxf(l0, fmaxf(l1, l2)); float w0 = __expf(l0 - m), w1 = __expf(l1 - m), w2 = __expf(l2 - m); const float inv = 1.0f / (w0 + w1 + w2); w0 *= inv; w1 *= inv; w2 *= inv;
        f32x4 a0, a1, b0, b1, c0, c1;
        const u32x4 ua = *(const u32x4*)(Ab + (size_t)tok * 1536 + h * 64 + c8 * 8), ub = *(const u32x4*)(Ab + (size_t)tok * 1536 + (8 + h) * 64 + c8 * 8), uc = *(const u32x4*)(Ab + (size_t)tok * 1536 + (16 + h) * 64 + c8 * 8);
        asm volatile("" ::: "memory");
        unpack8(ua, a0, a1); unpack8(ub, b0, b1); unpack8(uc, c0, c1);
        *(u32x4*)(YA + (size_t)tok * 512 + h * 64 + c8 * 8) = pack8(a0 * w0 + b0 * w1 + c0 * w2, a1 * w0 + b1 * w1 + c1 * w2);
    }
}


#define XB_TMO      128
#define XB_XCNT(j)  (256  + 64 * (j))
#define XB_XSUB(j)  (1280 + 64 * (j))
#define XB_XGEN(j)  (2304 + 64 * (j))
#define XB_TOP      3328
#define XB_TOPGEN   3392
#define XCD_BAR_WORDS 3456
#define XB_SPIN_CAP (1u << 18)
__device__ __forceinline__ unsigned xb_ld(unsigned* p)              { return __hip_atomic_load(p, __ATOMIC_RELAXED, __HIP_MEMORY_SCOPE_AGENT); }
__device__ __forceinline__ unsigned xb_add(unsigned* p, unsigned v) { return __hip_atomic_fetch_add(p, v, __ATOMIC_RELAXED, __HIP_MEMORY_SCOPE_AGENT); }
__device__ __forceinline__ unsigned xb_xcc_id() { return (unsigned)__builtin_amdgcn_s_getreg((3 << 11) | 20) & 0xFu; }
#define XB_SPIN(cond, bar) do { unsigned _sp = 0; while (cond) { __builtin_amdgcn_s_sleep(1); \
    if ((++_sp & 255u) == 0u) { if (xb_ld(&(bar)[XB_TMO])) break; if (_sp > XB_SPIN_CAP) { atomicAdd(&(bar)[XB_TMO], 1u); break; } } } } while (0)
struct XcdBarrier { unsigned* bar; unsigned x; volatile LAS unsigned* st; };
__device__ __forceinline__ XcdBarrier xcd_barrier_post(unsigned* bar, volatile LAS unsigned* st) {
    XcdBarrier b; b.bar = bar; b.x = xb_xcc_id(); b.st = st;
    if (threadIdx.x == 0) (void)xb_add(&bar[XB_XCNT(b.x)], 1u);
    return b;
}
__device__ __forceinline__ void xcd_barrier_complete(unsigned* bar, unsigned x, unsigned& nloc, unsigned& nx) {
    const unsigned G = gridDim.x * gridDim.y * gridDim.z;
    unsigned sum, cnt, mine, sp = 0u;
    for (;;) {
        sum = 0u; cnt = 0u; mine = 0u;
#pragma unroll
        for (unsigned j = 0; j < 16; ++j) { const unsigned c = xb_ld(&bar[XB_XCNT(j)]); sum += c; cnt += (c > 0u) ? 1u : 0u; mine = (j == x) ? c : mine; }
        if (sum == G) break;
        __builtin_amdgcn_s_sleep(1);
        if ((++sp & 255u) == 0u) { if (xb_ld(&bar[XB_TMO])) break; if (sp > XB_SPIN_CAP) { atomicAdd(&bar[XB_TMO], 1u); break; } }
    }
    nloc = mine > 0u ? mine : 1u; nx = cnt > 0u ? cnt : 1u;
}
__device__ __forceinline__ void xcd_barrier(const XcdBarrier& b) {
    asm volatile("s_waitcnt vmcnt(0)" ::: "memory");
    __syncthreads();
    if (threadIdx.x == 0) {
        unsigned* bar = b.bar;
        __builtin_amdgcn_s_waitcnt(0);
        unsigned nloc = b.st[0], nx = b.st[1];
        if (nloc == 0u) { xcd_barrier_complete(bar, b.x, nloc, nx); b.st[0] = nloc; b.st[1] = nx; }
        const unsigned old = xb_add(&bar[XB_XSUB(b.x)], 1u);
        const unsigned gen = old / nloc;
        if (old + 1u == (gen + 1u) * nloc) {
            __builtin_amdgcn_fence(__ATOMIC_RELEASE, "agent");
            asm volatile("s_waitcnt vmcnt(0)" ::: "memory");
            const unsigned og = xb_add(&bar[XB_TOP], 1u);
            const unsigned tg = og / nx;
            if (og + 1u == (tg + 1u) * nx) xb_add(&bar[XB_TOPGEN], 1u);
            else XB_SPIN(xb_ld(&bar[XB_TOPGEN]) == tg, bar);
            __builtin_amdgcn_fence(__ATOMIC_ACQUIRE, "agent");
            xb_add(&bar[XB_XGEN(b.x)], 1u);
            asm volatile("s_waitcnt vmcnt(0)" ::: "memory");
        } else {
            XB_SPIN(xb_ld(&bar[XB_XGEN(b.x)]) == gen, bar);
            __builtin_amdgcn_fence(__ATOMIC_ACQUIRE, "agent");
            asm volatile("s_waitcnt vmcnt(0)" ::: "memory");
        }
    }
    __syncthreads();
}

__device__ __forceinline__ Gemm mk_gemm(const bf16_t* A, int lda, const bf16_t* Bt, int ldb, int K, int nM, int nN, int nb = 1, size_t sA = 0, size_t sB = 0) {
    Gemm g; g.A = A; g.Bt = Bt; g.lda = lda; g.ldb = ldb; g.K = K; g.nM = nM; g.nN = nN; g.nb = nb; g.sA = sA; g.sB = sB; return g; }

__global__ __launch_bounds__(512, 2) void mega(Params p) {
    extern __shared__ __attribute__((aligned(16))) unsigned char shm[];
    LAS unsigned char* lds = (LAS unsigned char*)shm;
    cg::grid_group grid = cg::this_grid();
    volatile LAS unsigned* xst = (volatile LAS unsigned*)(lds + LDS_BYTES - 16);
    XcdBarrier xb; xb.bar = (unsigned*)(p.ws + SM_BAR); xb.x = 0; xb.st = xst;
    if (p.ph_hi - p.ph_lo > 1) { if (threadIdx.x == 0) { xst[0] = 0u; xst[1] = 0u; } __syncthreads(); xb = xcd_barrier_post((unsigned*)(p.ws + SM_BAR), xst); }
#pragma nounroll
    for (int ph = p.ph_lo; ph < p.ph_hi; ++ph) {
        unsigned char* ws = p.ws; asm volatile("" : "+s"(ws));
        const int l = ph == 0 ? 0 : (ph - 1) / 14, kind = ph == 0 ? 0 : (ph - 1) % 14 + 1;
        bf16_t* W = (bf16_t*)(ws + WS_W); bf16_t* H = (bf16_t*)(ws + WS_H);
        bf16_t* HID = (bf16_t*)(ws + B_HID); bf16_t* Y = (bf16_t*)(ws + B_Y); bf16_t* A2 = (bf16_t*)(ws + B_A2);
        bf16_t* Y1 = (bf16_t*)(ws + B_Y1); bf16_t* Mb = (bf16_t*)(ws + B_M);
        unsigned char* ob = (unsigned char*)p.out; asm volatile("" : "+s"(ob));
        bf16_t* YS5 = (bf16_t*)(ob + O_YS5); const float* RSp = (const float*)(ws + SM_RS);
        const float* ng = p.in[2]; const float* gl_ = ng + l * 6 * DM;
        unsigned* dynq = (unsigned*)(ws + SM_BAR) + XCD_BAR_WORDS;
#ifdef PROBE_MASK
        for (int rep = 0, reps = ((PROBE_MASK >> kind) & 1) ? 2 : 1; rep < reps; ++rep)
#endif
        switch (kind) {
        case 0:
            PREP(0) cvt_ffn(p, shm, 0, 0); s5_stage1(p, 0);
            PREP(1) norm_rows(p, 0, 0.f, nullptr);
            break;
        case 1: case 12: {
            EpiSwiglu e; e.O = HID; e.rs = RSp; gemm_phase<EpiSwiglu, true>(lds, mk_gemm(H, LDX, W + W_13, LDX, DM, MT / 256, 44), e, dynq + (l * 6 + (kind == 1 ? 0 : 4)) * 128);
        } break;
        case 2: case 13: {
            EpiBf16 e; e.O = Y; e.ldc = DM; gemm_phase<EpiBf16, true>(lds, mk_gemm(HID, DFF, W + W_2, DFF, DFF, MT / 256, 8), e, dynq + (l * 6 + (kind == 2 ? 1 : 5)) * 128);
        } break;
        case 3:
            PREP(0) cvt_mixer(p, shm, l);
            s5_stage2(p, l);
            norm_rows(p, 1, 0.5f, gl_ + 1 * DM);
            if ((PROBE2 >> 1) & 1) norm_rows(p, 1, 0.0f, gl_ + 1 * DM);
            break;
        case 4: {
            EpiWin e; e.ws = ws; e.rs = RSp; gemm_phase<EpiWin, true>(lds, mk_gemm(H, LDX, W + W_IN, LDX, DM, MT / 256, 54), e, dynq + (l * 6 + 2) * 128);
        } break;
        case 5: {
            PREP(3) { EpiS e; e.S = (float*)(ob + O_S); gemm_phase(lds, mk_gemm(A2, 512, (const bf16_t*)(ws + SM_G), 256, 256, NSUB / 256, 1, 64, (size_t)NSUB * 512, 65536), e); }
            __syncthreads();
            PREP(4) lru_items<0>(p, shm, l);
            attn_items(p, shm);
        } break;
        case 6:
            PREP(5) { lru_carry(p); s5_bscan(p, shm); attn_combine(p); }
            s5_stage3(p, l);
            break;
        case 7: {
            PREP(3) { EpiY e; e.Y1 = Y1; gemm_phase(lds, mk_gemm(A2, 512, (const bf16_t*)(ws + SM_Y), 512, 512, NSUB / 256, 1, 64, (size_t)NSUB * 512, 131072), e); }
            __syncthreads();
            lru_items<1>(p, shm, l);
        } break;
        case 8: {
            EpiGlu e; e.Y1 = Y1; e.O = YS5; e.bias = p.in[20] + l * 1024; gemm_phase(lds, mk_gemm(Y1, 1024, W + W_GLU, 1024, 1024, MT / 256, 4), e);
        } break;
        case 9: {
            { EpiMerge<true> e; e.Gt = (const bf16_t*)(ws + B_GA); e.Mo = Mb; gemm_phase(lds, mk_gemm((const bf16_t*)(ws + B_GL), 1024, W + W_BRL, 1024, 1024, MT / 256, 8), e); }
            { EpiMerge<false> e; e.Gt = (const bf16_t*)(ws + B_GB); e.Mo = Mb; gemm_phase(lds, mk_gemm(YS5, 1024, W + W_BRS, 1024, 1024, MT / 256, 8), e); }
            { EpiMerge<false> e; e.Gt = (const bf16_t*)(ws + B_GC); e.Mo = Mb; gemm_phase(lds, mk_gemm((const bf16_t*)(ws + B_YATT), 512, W + W_BRA, 512, 512, MT / 256, 8), e); }
        } break;
        case 10: {
            EpiBf16 e; e.O = Y; e.ldc = DM; gemm_phase<EpiBf16, true>(lds, mk_gemm(Mb, DM, W + W_OUT, DM, DM, MT / 256, 8), e, dynq + (l * 6 + 3) * 128);
        } break;
        case 11:
            PREP(0) cvt_ffn(p, shm, l, 1);
            norm_rows(p, 1, 1.0f, gl_ + 3 * DM);
            if ((PROBE2 >> 1) & 1) norm_rows(p, 1, 0.0f, gl_ + 3 * DM);
            break;
        default:
            if (l == 0) { PREP(0) cvt_ffn(p, shm, 1, 0); s5_stage1(p, 1); }
            norm_rows(p, l == 0 ? 1 : 2, 0.5f, gl_ + 5 * DM);
            break;
        }
        if (ph + 1 < p.ph_hi) { if (p.ph_hi > 4096) grid.sync(); else xcd_barrier(xb); }
    }
}
constexpr int N_PHASES = 1 + 2 * 14;

extern "C" void kernel_launch(void* const* d_in, const int* in_sizes, int n_in, void* d_out, int out_size, void* d_ws, size_t ws_size, hipStream_t stream) {
    static int grid = 0;
    if (grid == 0) {
        if (n_in != 29 || ws_size < WS_END) { fprintf(stderr, "kernel_launch: need 29 inputs and %zu bytes of workspace (got %d, %zu)\n", (size_t)WS_END, n_in, ws_size); grid = -1; return; }
        if (hipFuncSetAttribute((const void*)mega, hipFuncAttributeMaxDynamicSharedMemorySize, LDS_BYTES) != hipSuccess) { fprintf(stderr, "hipFuncSetAttribute failed\n"); grid = -1; return; }
        int dev = 0, cus = 0, per_cu = 0;
        (void)hipGetDevice(&dev); (void)hipDeviceGetAttribute(&cus, hipDeviceAttributeMultiprocessorCount, dev);
        (void)hipOccupancyMaxActiveBlocksPerMultiprocessor(&per_cu, (const void*)mega, 512, LDS_BYTES);
        if (per_cu < 1) per_cu = 1;
        (void)hipGetLastError();
        grid = cus * 1;
    }
    if (grid < 0) return;
    Params p{};
    for (int i = 0; i < 29; ++i) p.in[i] = (const float*)d_in[i];
    p.out = (float*)d_out; p.ws = (unsigned char*)d_ws;
    if (hipMemsetAsync((char*)d_ws + SM_BAR, 0, (XCD_BAR_WORDS + 12 * 128) * sizeof(unsigned), stream) != hipSuccess) { fprintf(stderr, "memset of the barrier / ticket words failed\n"); return; }
#if ONE_LAUNCH
    p.ph_lo = 0; p.ph_hi = N_PHASES;
    void* args[] = {&p};
    hipError_t e = hipLaunchCooperativeKernel((void*)mega, dim3(grid), dim3(512), args, LDS_BYTES, stream);
    if (e != hipSuccess) fprintf(stderr, "cooperative launch failed: %s (grid %d)\n", hipGetErrorString(e), grid);
#else
    for (int ph = 0; ph < N_PHASES; ++ph) { p.ph_lo = ph; p.ph_hi = ph + 1; hipLaunchKernelGGL(mega, dim3(grid), dim3(512), LDS_BYTES, stream, p); }
#endif
}
```

```cpp
#include <hip/hip_runtime.h>
#include <hip/hip_cooperative_groups.h>
#include <cstdio>
namespace cg = cooperative_groups;

#ifndef PROBE2
#define PROBE2 0
#endif
#define PREP(bit) for (int _r = 0; _r < (((PROBE2 >> (bit)) & 1) ? 2 : 1); ++_r)
#ifndef ONE_LAUNCH
#define ONE_LAUNCH 1
#endif

#define LAS __attribute__((address_space(3)))
typedef unsigned short bf16_t;
typedef short bf16x8 __attribute__((ext_vector_type(8)));
typedef float f32x4 __attribute__((ext_vector_type(4)));
typedef unsigned u32x4 __attribute__((ext_vector_type(4)));
typedef unsigned u32x2 __attribute__((ext_vector_type(2)));

constexpr int DM = 2048, MT = 24576, DFF = 5632, NSUB = MT / 16, NCHK = MT / 64;
constexpr float RMS_EPS = 1e-6f;
constexpr int LDS_BYTES = 147456;
constexpr int LDX = 2048 + 64;

constexpr size_t MiB = (size_t)1 << 20;
constexpr size_t SM_G = 0, SM_Y = 8 * MiB, SM_APOW = 24 * MiB, SM_BBAR = 26 * MiB, SM_KD = 27 * MiB, SM_LWT = 29 * MiB,
                 SM_SA = 30 * MiB, SM_SH = 33 * MiB, SM_CIN = 36 * MiB, SM_LSE = 39 * MiB, SM_RS = 41 * MiB + 512 * 1024, SM_BAR = 41 * MiB + 768 * 1024;
constexpr size_t WS_W = 42 * MiB, WS_H = 122 * MiB, WS_BIG = 222 * MiB, WS_END = 918 * MiB;
constexpr size_t B_XL = WS_BIG, B_GL = WS_BIG + 48 * MiB, B_A2 = WS_BIG + 96 * MiB, B_Q = WS_BIG + 192 * MiB, B_K = WS_BIG + 264 * MiB,
                 B_V = WS_BIG + 336 * MiB, B_GA = WS_BIG + 408 * MiB, B_GB = WS_BIG + 504 * MiB, B_GC = WS_BIG + 600 * MiB;
constexpr size_t B_HID = WS_BIG, B_Y = B_GA, B_Y1 = B_K, B_YATT = B_K + 48 * MiB, B_M = B_A2;
constexpr size_t O_S = 0, O_YS5 = 96 * MiB;
constexpr size_t W_13 = 0, W_2 = (size_t)11264 * LDX;
constexpr size_t W_IN = 0, W_GLU = (size_t)13824 * LDX, W_BRL = W_GLU + 1048576, W_BRS = W_BRL + 2097152, W_BRA = W_BRS + 2097152, W_OUT = W_BRA + 1048576;

struct Params { const float* in[29]; float* out; unsigned char* ws; int ph_lo, ph_hi; };

__device__ const unsigned char BUCKET[3][132] = {
 {11,11,11,11,11,11,11,11,11,11,11,11,11,11,11,10,10,10,10,10,10,10,10,10,10,10,10,10,10,10,10,10,10,10,10,10,10,10,9,9,9,9,9,9,9,9,9,9,9,9,8,8,8,8,8,8,8,7,6,5,4,3,2,1,0,17,18,19,20,21,22,23,24,24,24,24,24,24,24,25,25,25,25,25,25,25,25,25,25,25,25,26,26,26,26,26,26,26,26,26,26,26,26,26,26,26,26,26,26,26,26,26,26,26,27,27,27,27,27,27,27,27,27,27,27,27,27,27,27,0,0,0},
 {13,13,13,13,13,13,13,13,13,13,13,13,13,13,13,13,13,13,13,13,13,13,13,12,12,12,12,12,12,12,12,12,12,12,12,12,12,12,12,12,12,12,11,11,11,11,11,11,11,11,11,11,10,10,10,10,10,10,9,9,9,8,8,4,0,20,24,24,25,25,25,26,26,26,26,26,26,27,27,27,27,27,27,27,27,27,27,28,28,28,28,28,28,28,28,28,28,28,28,28,28,28,28,28,28,28,29,29,29,29,29,29,29,29,29,29,29,29,29,29,29,29,29,29,29,29,29,29,29,0,0,0},
 {15,15,15,15,15,15,15,15,15,15,15,15,15,15,15,15,15,15,15,15,15,15,15,15,15,15,15,15,15,15,14,14,14,14,14,14,14,14,14,14,14,14,14,14,14,13,13,13,13,13,13,13,13,13,12,12,12,12,12,11,11,10,10,9,0,25,26,26,27,27,28,28,28,28,28,29,29,29,29,29,29,29,29,29,30,30,30,30,30,30,30,30,30,30,30,30,30,30,30,31,31,31,31,31,31,31,31,31,31,31,31,31,31,31,31,31,31,31,31,31,31,31,31,31,31,31,31,31,31,0,0,0}};

__device__ __forceinline__ unsigned cvt_pk_bf16(float lo, float hi) { unsigned r; asm("v_cvt_pk_bf16_f32 %0, %1, %2" : "=v"(r) : "v"(lo), "v"(hi)); return r; }
__device__ __forceinline__ bf16_t f2bf(float f) { return (bf16_t)(cvt_pk_bf16(f, 0.f) & 0xffffu); }
__device__ __forceinline__ float bf2f(bf16_t b) { return __uint_as_float(((unsigned)b) << 16); }
__device__ __forceinline__ float bflo(unsigned w) { return __uint_as_float(w << 16); }
__device__ __forceinline__ float bfhi(unsigned w) { return __uint_as_float(w & 0xffff0000u); }
__device__ __forceinline__ float sigm(float x) { return __builtin_amdgcn_rcpf(1.0f + __expf(-x)); }
__device__ __forceinline__ float silu(float x) { return x * sigm(x); }
__device__ __forceinline__ float gelu_t(float x) { return x * sigm(1.5957691216057308f * (x + 0.044715f * x * x * x)); }
__device__ __forceinline__ float wave_sum(float v) {
#pragma unroll
    for (int o = 32; o >= 1; o >>= 1) v += __shfl_xor(v, o);
    return v;
}

__device__ __forceinline__ int ltid() { int t = threadIdx.x; asm volatile("" : "+v"(t)); return t; }
__device__ __forceinline__ int lbid() { int b = blockIdx.x; asm volatile("" : "+s"(b)); return b; }

typedef float f32x2 __attribute__((ext_vector_type(2)));
__device__ __forceinline__ f32x2 exp2_2(f32x2 v) { f32x2 r; r.x = __builtin_amdgcn_exp2f(v.x); r.y = __builtin_amdgcn_exp2f(v.y); return r; }
__device__ __forceinline__ f32x2 rcp_2(f32x2 v) { f32x2 r; r.x = __builtin_amdgcn_rcpf(v.x); r.y = __builtin_amdgcn_rcpf(v.y); return r; }
__device__ __forceinline__ f32x2 swiglu2(f32x2 a, f32x2 b, float rn, float r2) { const f32x2 q = rcp_2(exp2_2(a * rn) + 1.0f); return (a * b) * (q * r2); }
__device__ __forceinline__ f32x2 gelu2(f32x2 v) { const f32x2 z = v * ((v * v) * (-0.10294324f) + (-2.3022082f)); return v * rcp_2(exp2_2(z) + 1.0f); }
__device__ __forceinline__ f32x2 sigm2(f32x2 a, float rn) { return rcp_2(exp2_2(a * rn) + 1.0f); }

constexpr int BM = 256, BK = 64, HALF = 128, HTB = HALF * BK * 2, NXCD = 8, WGM = 4;
__device__ __forceinline__ int lds_byte(int r, int c) { const int st = (r >> 4) * 2 + (c >> 5), rr = r & 15, cc = c & 31, ob = rr * 64 + cc * 2; return st * 1024 + (ob ^ (((ob >> 9) & 1) << 5)); }
__device__ __forceinline__ void stage_rc(int b, int& R, int& C) { const int st = b / 1024, sb = b % 1024, swz = sb ^ (((sb >> 9) & 1) << 5); R = (st >> 1) * 16 + swz / 64; C = (st & 1) * 32 + (swz % 64) / 2; }
__device__ __forceinline__ int perm32(int rho) { const int n = rho >> 4, i = rho & 15; return 8 * (i >> 2) + 4 * n + (i & 3); }

struct Unit { int pm, pn, b; };
struct Gemm { const bf16_t* A; const bf16_t* Bt; int lda, ldb, K, nM, nN, nb; size_t sA, sB; };
struct Order {
    int nM, nN, nwg, tot, G, c, nb;
    __device__ void init(const Gemm& g, int G_, int c_) { nM = g.nM; nN = g.nN; nwg = nM * nN; nb = g.nb; tot = nwg * nb; G = G_; c = c_; }
    __device__ bool next(int i, Unit& u) const {
        const long L = (long)i * G + c; if (L >= tot) return false;
        if (nb > 1) { const int b = (int)(L / nwg), rem = (int)(L % nwg); u.b = b; u.pm = rem % nM; u.pn = rem / nM; return true; }
        int wgid = (int)L; { const int q = nwg / NXCD, r = nwg % NXCD, xcd = wgid % NXCD, off = wgid / NXCD; wgid = (xcd < r ? xcd * (q + 1) : r * (q + 1) + (xcd - r) * q) + off; }
        const int nig = WGM * nN, gid = wgid / nig, fm = gid * WGM, gsz = (nM - fm) < WGM ? (nM - fm) : WGM;
        u.pm = fm + ((wgid % nig) % gsz); u.pn = (wgid % nig) / gsz; u.b = 0; return true;
    }
};

__device__ __forceinline__ unsigned hw_xcc_id() { return (unsigned)__builtin_amdgcn_s_getreg((3 << 11) | 20) & 0xFu; }
template <class Epi, bool DYN = false>
__device__ __forceinline__ void gemm_phase(LAS unsigned char* lds, const Gemm g, const Epi& E, unsigned* ctr = nullptr) {
    Order S; S.init(g, (int)gridDim.x, lbid());
    const int tid = ltid(), wid = __builtin_amdgcn_readfirstlane(tid >> 6), lane = tid & 63, wr = wid >> 2, wc = wid & 3, fr = lane & 15, fq = lane >> 4;
    const int K = g.K, nt = K / BK;
    unsigned voffA[2], voffB[2];
#pragma unroll
    for (int i = 0; i < 2; ++i) { int R, C; stage_rc(tid * 16 + i * 8192, R, C); const int Rb = Epi::PERM ? ((R & ~31) + perm32(R & 31)) : R;
        voffA[i] = (unsigned)(R * g.lda + C) * 2u; voffB[i] = (unsigned)(Rb * g.ldb + C) * 2u; }
    const size_t kstep = (size_t)(BK * 2);
    const size_t hstepA = (size_t)HALF * g.lda * 2, hstepB = (size_t)HALF * g.ldb * 2;
    const size_t tstepA = 2 * hstepA, tstepB = 2 * hstepB;
    const unsigned ldsw = (unsigned)wid * 1024u;
    const int aoff = lds_byte(wr * 64 + fr, fq * 8), boff = lds_byte(wc * 32 + fr, fq * 8);
#define PG8_SA(b, h) (((b) * 2 + (h)) * HTB)
#define PG8_SB(b, h) ((4 + (b) * 2 + (h)) * HTB)
#define PG8_STAGE(bufoff, gbase, voff) do { _Pragma("unroll") for (int _i = 0; _i < 2; ++_i) \
        __builtin_amdgcn_global_load_lds((const unsigned*)((const char*)(gbase) + (voff)[_i]), (LAS unsigned*)(lds + (bufoff) + ldsw + _i * 8192), 16, 0, 0); } while (0)
#define PG8_LDA(dst, b, h) do { _Pragma("unroll") for (int m = 0; m < 4; ++m) _Pragma("unroll") for (int k = 0; k < 2; ++k) dst[m][k] = *(const LAS bf16x8*)(lds + PG8_SA(b, h) + aoff + m * 2048 + k * 1024); } while (0)
#define PG8_LDB(dst, b, h) do { _Pragma("unroll") for (int n = 0; n < 2; ++n) _Pragma("unroll") for (int k = 0; k < 2; ++k) dst[n][k] = *(const LAS bf16x8*)(lds + PG8_SB(b, h) + boff + n * 2048 + k * 1024); } while (0)
#define PG8_MMA(ai, bj, At, Bt) do { __builtin_amdgcn_s_setprio(1); _Pragma("unroll") for (int m = 0; m < 4; ++m) _Pragma("unroll") for (int n = 0; n < 2; ++n) _Pragma("unroll") for (int k = 0; k < 2; ++k) \
        acc[ai][bj][m][n] = __builtin_amdgcn_mfma_f32_16x16x32_bf16(Bt[n][k], At[m][k], acc[ai][bj][m][n], 0, 0, 0); __builtin_amdgcn_s_setprio(0); } while (0)
#define PG8_WAIT_V(n) asm volatile("s_waitcnt vmcnt(" #n ")" ::: "memory")
#define PG8_WAIT_L(n) asm volatile("s_waitcnt lgkmcnt(" #n ")" ::: "memory")
#define PG8_BAR __builtin_amdgcn_s_barrier()
#define PG8_SCHED __builtin_amdgcn_sched_barrier(0)
    Unit cur, nxt; int ui = 0;
    LAS int* slot = (LAS int*)(lds + 131072 + 64);
    const int xcd = (int)(hw_xcc_id() & 7u); int ticket = 0;
    auto rng_cnt = [&](int x) { const int q = S.nwg / NXCD, r = S.nwg % NXCD; return q + (x < r ? 1 : 0); };
    auto rng_start = [&](int x) { const int q = S.nwg / NXCD, r = S.nwg % NXCD; return x < r ? x * (q + 1) : r * (q + 1) + (x - r) * q; };
    auto decode = [&](int wgid, Unit& u) { const int nig = WGM * S.nN, gid = wgid / nig, fm = gid * WGM, gsz = (S.nM - fm) < WGM ? (S.nM - fm) : WGM; u.pm = fm + ((wgid % nig) % gsz); u.pn = (wgid % nig) / gsz; u.b = 0; };
    auto issue = [&]() { if (tid == 0) ticket = (int)__hip_atomic_fetch_add(ctr + xcd * 16, 1u, __ATOMIC_RELAXED, __HIP_MEMORY_SCOPE_AGENT); };
    auto publish = [&](int si) { if (tid == 0) { int wg = -1;
            if (ticket < rng_cnt(xcd)) wg = rng_start(xcd) + ticket;
            else { for (int k = 1; k < 8; ++k) { const int x2 = (xcd + k) & 7; const int t2 = (int)__hip_atomic_fetch_add(ctr + x2 * 16, 1u, __ATOMIC_RELAXED, __HIP_MEMORY_SCOPE_AGENT); if (t2 < rng_cnt(x2)) { wg = rng_start(x2) + t2; break; } } }
            slot[si] = wg; } };
    if (DYN) { issue(); publish(0); __syncthreads(); const int w0 = __builtin_amdgcn_readfirstlane(slot[0]); if (w0 < 0) return; decode(w0, cur); issue(); }
    else if (!S.next(0, cur)) return;
    f32x4 acc[2][2][4][2];
#pragma unroll
    for (int a = 0; a < 2; ++a)
#pragma unroll
        for (int b = 0; b < 2; ++b)
#pragma unroll
            for (int m = 0; m < 4; ++m)
#pragma unroll
                for (int n = 0; n < 2; ++n) acc[a][b][m][n] = (f32x4){0.f, 0.f, 0.f, 0.f};
    bf16x8 At[4][2], B0[2][2], B1[2][2];
    const char* cA = (const char*)(g.A + (size_t)cur.b * g.sA) + (size_t)cur.pm * tstepA; const char* cB = (const char*)(g.Bt + (size_t)cur.b * g.sB) + (size_t)cur.pn * tstepB;
    float pre[8];
    E.prefetch(pre, cur, wr, fr);
    PG8_STAGE(PG8_SB(0, 0), cB, voffB); PG8_STAGE(PG8_SA(0, 0), cA, voffA); PG8_STAGE(PG8_SB(0, 1), cB + hstepB, voffB); PG8_STAGE(PG8_SA(0, 1), cA + hstepA, voffA);
    if (wr == 1) PG8_BAR;
    PG8_WAIT_V(4); PG8_BAR;
    PG8_STAGE(PG8_SB(1, 0), cB + kstep, voffB); PG8_STAGE(PG8_SA(1, 0), cA + kstep, voffA); PG8_STAGE(PG8_SB(1, 1), cB + hstepB + kstep, voffB);
    PG8_WAIT_V(6); PG8_BAR;
    for (;;) {
        bool has_next = DYN ? false : S.next(ui + 1, nxt);
        const char* nA = has_next ? (const char*)(g.A + (size_t)nxt.b * g.sA) + (size_t)nxt.pm * tstepA : cA; const char* nB = has_next ? (const char*)(g.Bt + (size_t)nxt.b * g.sB) + (size_t)nxt.pn * tstepB : cB;
        for (int t = 0; t < nt; t += 2) {
            const bool last = (t == nt - 2);
            if (DYN && last) { const int nw = __builtin_amdgcn_readfirstlane(slot[(ui + 1) & 1]); has_next = nw >= 0;
                if (has_next) { decode(nw, nxt); nA = (const char*)g.A + (size_t)nxt.pm * tstepA; nB = (const char*)g.Bt + (size_t)nxt.pn * tstepB; } }
            const char* a1 = cA + (size_t)(t + 1) * kstep;
            const char* a2 = last ? nA : cA + (size_t)(t + 2) * kstep; const char* b2 = last ? nB : cB + (size_t)(t + 2) * kstep;
            const char* a3 = a2 + kstep; const char* b3 = b2 + kstep;
            PG8_LDB(B0, 0, 0); PG8_SCHED; PG8_LDA(At, 0, 0); PG8_STAGE(PG8_SA(1, 1), a1 + hstepA, voffA);
            PG8_WAIT_L(8); PG8_BAR; PG8_WAIT_L(0); PG8_MMA(0, 0, At, B0); PG8_BAR; PG8_SCHED;
            PG8_LDB(B1, 0, 1); PG8_STAGE(PG8_SB(0, 0), b2, voffB);
            PG8_BAR; PG8_WAIT_L(0); PG8_MMA(0, 1, At, B1); PG8_BAR;
            PG8_LDA(At, 0, 1); PG8_STAGE(PG8_SA(0, 0), a2, voffA);
            PG8_BAR; PG8_WAIT_L(0); PG8_MMA(1, 0, At, B0); PG8_BAR; PG8_SCHED;
            PG8_STAGE(PG8_SB(0, 1), b2 + hstepB, voffB);
            PG8_WAIT_V(6); PG8_BAR; PG8_MMA(1, 1, At, B1); PG8_BAR;
            PG8_LDB(B0, 1, 0); PG8_SCHED; PG8_LDA(At, 1, 0); PG8_STAGE(PG8_SA(0, 1), a2 + hstepA, voffA);
            PG8_WAIT_L(8); PG8_BAR; PG8_WAIT_L(0); PG8_MMA(0, 0, At, B0); PG8_BAR; PG8_SCHED;
            PG8_LDB(B1, 1, 1); PG8_STAGE(PG8_SB(1, 0), b3, voffB);
            PG8_BAR; PG8_WAIT_L(0); PG8_MMA(0, 1, At, B1); PG8_BAR;
            PG8_LDA(At, 1, 1); PG8_STAGE(PG8_SA(1, 0), a3, voffA);
            PG8_BAR; PG8_WAIT_L(0); PG8_MMA(1, 0, At, B0); PG8_BAR; PG8_SCHED;
            if (DYN && t == 0) publish((ui + 1) & 1);
            PG8_STAGE(PG8_SB(1, 1), b3 + hstepB, voffB);
            PG8_WAIT_V(6); PG8_BAR; PG8_MMA(1, 1, At, B1); PG8_BAR;
        }
        E(acc, cur, wr, wc, fr, fq, pre);
        if (!has_next) break;
#pragma unroll
        for (int a = 0; a < 2; ++a)
#pragma unroll
            for (int b = 0; b < 2; ++b)
#pragma unroll
                for (int m = 0; m < 4; ++m)
#pragma unroll
                    for (int n = 0; n < 2; ++n) acc[a][b][m][n] = (f32x4){0.f, 0.f, 0.f, 0.f};
        cur = nxt; cA = nA; cB = nB; ++ui;
        if (DYN) issue();
        E.prefetch(pre, cur, wr, fr);
    }
    PG8_WAIT_V(0);
    if (wr == 0) PG8_BAR;
    PG8_BAR;
#undef PG8_SA
#undef PG8_SB
#undef PG8_STAGE
#undef PG8_LDA
#undef PG8_LDB
#undef PG8_MMA
#undef PG8_WAIT_V
#undef PG8_WAIT_L
#undef PG8_BAR
#undef PG8_SCHED
}

#define GAS __attribute__((address_space(1)))
__device__ __forceinline__ u32x4 gld16(const void* p) { return *(const GAS u32x4*)(unsigned long long)p; }
__device__ __forceinline__ void gst16(void* p, u32x4 v) { *(GAS u32x4*)(unsigned long long)p = v; }
__device__ __forceinline__ void gst16nt(void* p, u32x4 v) { __builtin_nontemporal_store(v, (GAS u32x4*)(unsigned long long)p); }
typedef const f32x4 (&AccRef)[2][2][4][2];
__device__ __forceinline__ u32x4 pack8(f32x4 v0, f32x4 v1) { u32x4 w; w.x = cvt_pk_bf16(v0[0], v0[1]); w.y = cvt_pk_bf16(v0[2], v0[3]); w.z = cvt_pk_bf16(v1[0], v1[1]); w.w = cvt_pk_bf16(v1[2], v1[3]); return w; }
__device__ __forceinline__ void unpack8(u32x4 w, f32x4& v0, f32x4& v1) { v0 = (f32x4){bflo(w.x), bfhi(w.x), bflo(w.y), bfhi(w.y)}; v1 = (f32x4){bflo(w.z), bfhi(w.z), bflo(w.w), bfhi(w.w)}; }

struct EpiSwiglu {
    static constexpr bool PERM = true; bf16_t* O; const float* rs;
    __device__ __forceinline__ void prefetch(float (&pre)[8], const Unit& u, int wr, int fr) const {
#pragma unroll
        for (int i = 0; i < 8; ++i) pre[i] = rs[u.pm * BM + wr * 64 + fr + (i >> 2) * HALF + (i & 3) * 16]; }
    __device__ __forceinline__ void operator()(AccRef acc, const Unit& u, int wr, int wc, int fr, int fq, const float (&pre)[8]) const {
        const int row0 = u.pm * BM + wr * 64 + fr, col = u.pn * 128 + wc * 32 + 8 * fq;
#pragma unroll
        for (int ai = 0; ai < 2; ++ai)
#pragma unroll
            for (int m = 0; m < 4; ++m) {
                f32x4 v0, v1; const float r = pre[ai * 4 + m], rn = r * -1.4426950408889634f, r2 = r * r;
                { const f32x4 a0 = acc[ai][0][m][0], a1 = acc[ai][0][m][1], b0 = acc[ai][1][m][0], b1 = acc[ai][1][m][1];
                  const f32x2 o0 = swiglu2((f32x2){a0[0], a0[1]}, (f32x2){b0[0], b0[1]}, rn, r2), o1 = swiglu2((f32x2){a0[2], a0[3]}, (f32x2){b0[2], b0[3]}, rn, r2);
                  const f32x2 o2 = swiglu2((f32x2){a1[0], a1[1]}, (f32x2){b1[0], b1[1]}, rn, r2), o3 = swiglu2((f32x2){a1[2], a1[3]}, (f32x2){b1[2], b1[3]}, rn, r2);
                  v0 = (f32x4){o0.x, o0.y, o1.x, o1.y}; v1 = (f32x4){o2.x, o2.y, o3.x, o3.y}; }
                gst16nt(O + (size_t)(row0 + ai * HALF + m * 16) * DFF + col, pack8(v0, v1));
            }
    }
};
struct EpiBf16 {
    static constexpr bool PERM = true; bf16_t* O; int ldc;
    __device__ __forceinline__ void prefetch(float (&pre)[8], const Unit&, int, int) const {
#pragma unroll
        for (int i = 0; i < 8; ++i) pre[i] = 0.f; }
    __device__ __forceinline__ void operator()(AccRef acc, const Unit& u, int wr, int wc, int fr, int fq, const float (&pre)[8]) const {
        const int row0 = u.pm * BM + wr * 64 + fr, col0 = u.pn * BM + wc * 32 + 8 * fq;
#pragma unroll
        for (int ai = 0; ai < 2; ++ai)
#pragma unroll
            for (int m = 0; m < 4; ++m)
#pragma unroll
                for (int bj = 0; bj < 2; ++bj)
                    gst16(O + (size_t)(row0 + ai * HALF + m * 16) * ldc + col0 + bj * HALF, pack8(acc[ai][bj][m][0], acc[ai][bj][m][1]));
    }
};
struct EpiWin {
    static constexpr bool PERM = true; unsigned char* ws; const float* rs;
    __device__ __forceinline__ void prefetch(float (&pre)[8], const Unit& u, int wr, int fr) const {
#pragma unroll
        for (int i = 0; i < 8; ++i) pre[i] = rs[u.pm * BM + wr * 64 + fr + (i >> 2) * HALF + (i & 3) * 16]; }
    __device__ __forceinline__ void operator()(AccRef acc, const Unit& u, int wr, int wc, int fr, int fq, const float (&pre)[8]) const {
        const int pn = u.pn; int act, ld, cb; size_t base;
        if (pn < 4) { act = 0; ld = 1024; cb = pn * 256; base = B_XL; }
        else if (pn < 8) { act = 1; ld = 1024; cb = (pn - 4) * 256; base = B_GL; }
        else if (pn < 12) { act = 2; ld = 0; cb = (pn - 8) * 256; base = B_A2; }
        else if (pn < 18) { act = 3; ld = 1536; cb = (pn - 12) * 256; base = B_Q; }
        else if (pn < 24) { act = 0; ld = 1536; cb = (pn - 18) * 256; base = B_K; }
        else if (pn < 30) { act = 0; ld = 1536; cb = (pn - 24) * 256; base = B_V; }
        else if (pn < 38) { act = 4; ld = 2048; cb = (pn - 30) * 256; base = B_GA; }
        else if (pn < 46) { act = 4; ld = 2048; cb = (pn - 38) * 256; base = B_GB; }
        else { act = 4; ld = 2048; cb = (pn - 46) * 256; base = B_GC; }
        bf16_t* O = (bf16_t*)(ws + base);
        const int row0 = u.pm * BM + wr * 64 + fr, col0 = cb + wc * 32 + 8 * fq;
#pragma unroll
        for (int ai = 0; ai < 2; ++ai)
#pragma unroll
            for (int m = 0; m < 4; ++m)
#pragma unroll
                for (int bj = 0; bj < 2; ++bj) {
                    const int row = row0 + ai * HALF + m * 16, col = col0 + bj * HALF;
                    const float r = pre[ai * 4 + m]; f32x4 v0 = acc[ai][bj][m][0], v1 = acc[ai][bj][m][1];
                    if (act == 1) { v0 *= r; v1 *= r;
                        const f32x2 o0 = gelu2((f32x2){v0[0], v0[1]}), o1 = gelu2((f32x2){v0[2], v0[3]}), o2 = gelu2((f32x2){v1[0], v1[1]}), o3 = gelu2((f32x2){v1[2], v1[3]});
                        v0 = (f32x4){o0.x, o0.y, o1.x, o1.y}; v1 = (f32x4){o2.x, o2.y, o3.x, o3.y}; }
                    else if (act == 4) { const float rn = r * -1.4426950408889634f;
                        const f32x2 o0 = sigm2((f32x2){v0[0], v0[1]}, rn), o1 = sigm2((f32x2){v0[2], v0[3]}, rn), o2 = sigm2((f32x2){v1[0], v1[1]}, rn), o3 = sigm2((f32x2){v1[2], v1[3]}, rn);
                        v0 = (f32x4){o0.x, o0.y, o1.x, o1.y}; v1 = (f32x4){o2.x, o2.y, o3.x, o3.y}; }
                    else { const float rr = act == 3 ? r * 0.125f : r; v0 *= rr; v1 *= rr; }
                    size_t off;
                    if (act == 2) off = ((size_t)(col >> 4) * NSUB + (row >> 4)) * 512 + (row & 15) * 16 + (col & 15);
                    else off = (size_t)row * ld + col;
                    gst16nt(O + off, pack8(v0, v1));
                }
    }
};
struct EpiS {
    static constexpr bool PERM = false; float* S;
    __device__ __forceinline__ void prefetch(float (&pre)[8], const Unit&, int, int) const {
#pragma unroll
        for (int i = 0; i < 8; ++i) pre[i] = 0.f; }
    __device__ __forceinline__ void operator()(AccRef acc, const Unit& u, int wr, int wc, int fr, int fq, const float (&pre)[8]) const {
        const int row0 = u.pm * BM + wr * 64 + fr, col0 = wc * 32 + 4 * fq;
        float* base = S + (size_t)u.b * NSUB * 256;
#pragma unroll
        for (int ai = 0; ai < 2; ++ai)
#pragma unroll
            for (int m = 0; m < 4; ++m)
#pragma unroll
                for (int bj = 0; bj < 2; ++bj)
#pragma unroll
                    for (int n = 0; n < 2; ++n)
                        *(f32x4*)(base + (size_t)(row0 + ai * HALF + m * 16) * 256 + col0 + bj * HALF + n * 16) = acc[ai][bj][m][n];
    }
};
struct EpiY {
    static constexpr bool PERM = true; bf16_t* Y1;
    __device__ __forceinline__ void prefetch(float (&pre)[8], const Unit&, int, int) const {
#pragma unroll
        for (int i = 0; i < 8; ++i) pre[i] = 0.f; }
    __device__ __forceinline__ void operator()(AccRef acc, const Unit& u, int wr, int wc, int fr, int fq, const float (&pre)[8]) const {
        const int row0 = u.pm * BM + wr * 64 + fr, n0 = wc * 32 + 8 * fq;
#pragma unroll
        for (int ai = 0; ai < 2; ++ai)
#pragma unroll
            for (int m = 0; m < 4; ++m)
#pragma unroll
                for (int bj = 0; bj < 2; ++bj) {
                    const int j = row0 + ai * HALF + m * 16, nn = n0 + bj * HALF, tok = j * 16 + (nn >> 4);
                    f32x4 v0 = acc[ai][bj][m][0], v1 = acc[ai][bj][m][1];
#pragma unroll
                    for (int q = 0; q < 4; ++q) { v0[q] = gelu_t(v0[q]); v1[q] = gelu_t(v1[q]); }
                    gst16(Y1 + (size_t)tok * 1024 + u.b * 16 + (nn & 15), pack8(v0, v1));
                }
    }
};
struct EpiGlu {
    static constexpr bool PERM = true; const bf16_t* Y1; bf16_t* O; const float* bias;
    __device__ __forceinline__ void prefetch(float (&pre)[8], const Unit&, int, int) const {
#pragma unroll
        for (int i = 0; i < 8; ++i) pre[i] = 0.f; }
    __device__ __forceinline__ void operator()(AccRef acc, const Unit& u, int wr, int wc, int fr, int fq, const float (&pre)[8]) const {
        const int row0 = u.pm * BM + wr * 64 + fr, col0 = u.pn * BM + wc * 32 + 8 * fq;
        f32x4 bv[2][2];
#pragma unroll
        for (int bj = 0; bj < 2; ++bj) { bv[bj][0] = *(const GAS f32x4*)(unsigned long long)(bias + col0 + bj * HALF); bv[bj][1] = *(const GAS f32x4*)(unsigned long long)(bias + col0 + bj * HALF + 4); }
#pragma unroll
        for (int ai = 0; ai < 2; ++ai) {
            u32x4 yv[4][2];
#pragma unroll
            for (int m = 0; m < 4; ++m)
#pragma unroll
                for (int bj = 0; bj < 2; ++bj) yv[m][bj] = gld16(Y1 + (size_t)(row0 + ai * HALF + m * 16) * 1024 + col0 + bj * HALF);
#pragma unroll
            for (int m = 0; m < 4; ++m)
#pragma unroll
                for (int bj = 0; bj < 2; ++bj) {
                    f32x4 y0, y1v; unpack8(yv[m][bj], y0, y1v);
                    f32x4 v0 = acc[ai][bj][m][0] + bv[bj][0], v1 = acc[ai][bj][m][1] + bv[bj][1];
#pragma unroll
                    for (int q = 0; q < 4; ++q) { v0[q] = y0[q] * sigm(v0[q]); v1[q] = y1v[q] * sigm(v1[q]); }
                    gst16(O + (size_t)(row0 + ai * HALF + m * 16) * 1024 + col0 + bj * HALF, pack8(v0, v1));
                }
        }
    }
};
template <bool FIRST> struct EpiMerge {
    static constexpr bool PERM = true; const bf16_t* Gt; bf16_t* Mo;
    __device__ __forceinline__ void prefetch(float (&pre)[8], const Unit&, int, int) const {
#pragma unroll
        for (int i = 0; i < 8; ++i) pre[i] = 0.f; }
    __device__ __forceinline__ void operator()(AccRef acc, const Unit& u, int wr, int wc, int fr, int fq, const float (&pre)[8]) const {
        const int row0 = u.pm * BM + wr * 64 + fr, col0 = u.pn * BM + wc * 32 + 8 * fq;
#pragma unroll
        for (int ai = 0; ai < 2; ++ai) {
            u32x4 gv[4][2], mv[4][2];
#pragma unroll
            for (int m = 0; m < 4; ++m)
#pragma unroll
                for (int bj = 0; bj < 2; ++bj) { const size_t off = (size_t)(row0 + ai * HALF + m * 16) * 2048 + col0 + bj * HALF;
                    gv[m][bj] = gld16(Gt + off); mv[m][bj] = FIRST ? (u32x4){0u, 0u, 0u, 0u} : gld16(Mo + off); }
#pragma unroll
            for (int m = 0; m < 4; ++m)
#pragma unroll
                for (int bj = 0; bj < 2; ++bj) { const size_t off = (size_t)(row0 + ai * HALF + m * 16) * 2048 + col0 + bj * HALF;
                    f32x4 g0, g1; unpack8(gv[m][bj], g0, g1);
                    f32x4 v0 = g0 * acc[ai][bj][m][0], v1 = g1 * acc[ai][bj][m][1];
                    if (!FIRST) { f32x4 p0, p1; unpack8(mv[m][bj], p0, p1); v0 += p0; v1 += p1; }
                    gst16(Mo + off, pack8(v0, v1)); }
        }
    }
};

__device__ void cvt_job(unsigned char* shm, const float* src, bf16_t* dst, int K, int N, int mode, const float* kscale = nullptr, int ldd = 0) {
    if (ldd == 0) ldd = K;
    bf16_t* T = (bf16_t*)shm;
    const int tid = ltid(), bid = lbid(), nkt = K / 64, nnt = N / 256, tot = nkt * nnt;
    for (int t = bid; t < tot; t += gridDim.x) {
        const int nti = t % nnt, kt = t / nnt;
        { const int k = tid >> 3, n8 = (tid & 7) * 8;
          const float* s = src + (size_t)(kt * 64 + k) * N + nti * 256 + n8; const float ks = kscale ? kscale[kt * 64 + k] : 1.0f;
          f32x4 v[8];
#pragma unroll
          for (int q = 0; q < 4; ++q) { v[2 * q] = *(const f32x4*)(s + q * 64); v[2 * q + 1] = *(const f32x4*)(s + q * 64 + 4); }
          asm volatile("" ::: "memory");
#pragma unroll
          for (int q = 0; q < 4; ++q)
#pragma unroll
              for (int j = 0; j < 4; ++j) { T[(q * 64 + n8 + j) * 72 + k] = f2bf(v[2 * q][j] * ks); T[(q * 64 + n8 + 4 + j) * 72 + k] = f2bf(v[2 * q + 1][j] * ks); } }
        __syncthreads();
#pragma unroll
        for (int q = 0; q < 4; ++q) { const int n = q * 64 + (tid >> 3), k8 = (tid & 7) * 8; const int nn = nti * 256 + n;
          const int drow = mode == 0 ? nn : ((nn >> 7) * 256 + (nn & 127) + (mode == 2 ? 128 : 0));
          *(u32x4*)(dst + (size_t)drow * ldd + kt * 64 + k8) = *(const u32x4*)(T + n * 72 + k8); }
        __syncthreads();
    }
}
__device__ void cvt_ffn(const Params& p, unsigned char* shm, int l, int sub) {
    bf16_t* W = (bf16_t*)(p.ws + WS_W); const size_t wo = (size_t)(l * 2 + sub) * DM * DFF;
    const float* gk = p.in[2] + (l * 6 + (sub ? 4 : 0)) * DM;
    cvt_job(shm, p.in[26] + wo, W + W_13, DM, DFF, 1, gk, LDX);
    cvt_job(shm, p.in[27] + wo, W + W_13, DM, DFF, 2, gk, LDX);
    cvt_job(shm, p.in[28] + wo, W + W_2, DFF, DM, 0);
}
__device__ void cvt_mixer(const Params& p, unsigned char* shm, int l) {
    bf16_t* W = (bf16_t*)(p.ws + WS_W);
    cvt_job(shm, p.in[3] + (size_t)l * DM * 13824, W + W_IN, DM, 13824, 0, p.in[2] + (l * 6 + 2) * DM, LDX);
    cvt_job(shm, p.in[19] + (size_t)l * 1024 * 1024, W + W_GLU, 1024, 1024, 0);
    cvt_job(shm, p.in[22] + (size_t)l * 1024 * DM, W + W_BRL, 1024, DM, 0);
    cvt_job(shm, p.in[23] + (size_t)l * 1024 * DM, W + W_BRS, 1024, DM, 0);
    cvt_job(shm, p.in[24] + (size_t)l * 512 * DM, W + W_BRA, 512, DM, 0);
    cvt_job(shm, p.in[25] + (size_t)l * DM * DM, W + W_OUT, DM, DM, 0);
}

__device__ void norm_rows(const Params& p, int mode, float scale, const float* gpost) {
    const int tid = ltid(), bid = lbid(), lane = tid & 63, wid = tid >> 6;
    bf16_t* X = (bf16_t*)(p.ws + WS_H); const bf16_t* Y = (const bf16_t*)(p.ws + B_Y); float* RS = (float*)(p.ws + SM_RS);
    for (int row = bid * 8 + wid; row < MT; row += gridDim.x * 8) {
        f32x4 xv[8];
        if (mode == 0) {
            const float* xr = row < 8192 ? p.in[0] + (size_t)row * DM : p.in[1] + (size_t)(row - 8192) * DM;
#pragma unroll
            for (int c = 0; c < 4; ++c) { xv[2 * c] = *(const f32x4*)(xr + (c * 64 + lane) * 8); xv[2 * c + 1] = *(const f32x4*)(xr + (c * 64 + lane) * 8 + 4); }
            asm volatile("" ::: "memory");
        } else {
            f32x4 yv[8]; float ss = 0.f; u32x4 xw[4], yw[4]; f32x4 gq[8];
#pragma unroll
            for (int c = 0; c < 4; ++c) { xw[c] = *(const u32x4*)(X + (size_t)row * LDX + (c * 64 + lane) * 8); yw[c] = *(const u32x4*)(Y + (size_t)row * DM + (c * 64 + lane) * 8); }
#pragma unroll
            for (int c = 0; c < 4; ++c) { gq[2 * c] = *(const f32x4*)(gpost + (c * 64 + lane) * 8); gq[2 * c + 1] = *(const f32x4*)(gpost + (c * 64 + lane) * 8 + 4); }
            asm volatile("" ::: "memory");
#pragma unroll
            for (int c = 0; c < 4; ++c) { unpack8(xw[c], xv[2 * c], xv[2 * c + 1]); unpack8(yw[c], yv[2 * c], yv[2 * c + 1]); }
#pragma unroll
            for (int c = 0; c < 8; ++c) ss += yv[c][0] * yv[c][0] + yv[c][1] * yv[c][1] + yv[c][2] * yv[c][2] + yv[c][3] * yv[c][3];
            ss = wave_sum(ss);
            const float rs = rsqrtf(ss * (1.0f / DM) + RMS_EPS) * scale;
#pragma unroll
            for (int c = 0; c < 4; ++c) { xv[2 * c] += yv[2 * c] * gq[2 * c] * rs; xv[2 * c + 1] += yv[2 * c + 1] * gq[2 * c + 1] * rs; }
        }
        if (mode == 2) {
#pragma unroll
            for (int c = 0; c < 4; ++c) { *(f32x4*)(p.out + (size_t)row * DM + (c * 64 + lane) * 8) = xv[2 * c]; *(f32x4*)(p.out + (size_t)row * DM + (c * 64 + lane) * 8 + 4) = xv[2 * c + 1]; }
        } else {
            float ss = 0.f;
#pragma unroll
            for (int c = 0; c < 8; ++c) ss += xv[c][0] * xv[c][0] + xv[c][1] * xv[c][1] + xv[c][2] * xv[c][2] + xv[c][3] * xv[c][3];
            ss = wave_sum(ss);
#pragma unroll
            for (int c = 0; c < 4; ++c) *(u32x4*)(X + (size_t)row * LDX + (c * 64 + lane) * 8) = pack8(xv[2 * c], xv[2 * c + 1]);
            if (lane == 0) RS[row] = rsqrtf(ss * (1.0f / DM) + RMS_EPS);
        }
    }
}

__device__ void s5_stage1(const Params& p, int l) {
    float2* Apow = (float2*)(p.ws + SM_APOW); float2* Bbar = (float2*)(p.ws + SM_BBAR);
    for (int idx = lbid() * 512 + ltid(); idx < 8192; idx += gridDim.x * 512) {
        const float lr = p.in[11][l * 8192 + idx], li = p.in[12][l * 8192 + idx], dt = expf(p.in[13][l * 128 + (idx >> 6)]);
        f32x4 br4[4], bi4[4];
#pragma unroll
        for (int c = 0; c < 4; ++c) { br4[c] = *(const f32x4*)(p.in[14] + (size_t)l * 131072 + idx * 16 + c * 4); bi4[c] = *(const f32x4*)(p.in[15] + (size_t)l * 131072 + idx * 16 + c * 4); }
        asm volatile("" ::: "memory");
        float ar = 1.f, ai = 0.f;
        for (int k = 0; k < 18; ++k) { const float mag = expf((float)k * lr * dt); float s, c; sincosf((float)k * li * dt, &s, &c); Apow[idx * 18 + k] = make_float2(mag * c, mag * s); if (k == 1) { ar = mag * c; ai = mag * s; } }
        const float den = lr * lr + li * li, cr = ((ar - 1.0f) * lr + ai * li) / den, ci = (ai * lr - (ar - 1.0f) * li) / den;
#pragma unroll
        for (int c = 0; c < 16; ++c) { const float br = br4[c >> 2][c & 3], bi = bi4[c >> 2][c & 3];
            Bbar[idx * 16 + c] = make_float2(cr * br - ci * bi, cr * bi + ci * br); }
    }
}
__device__ void s5_stage2(const Params& p, int l) {
    const float2* Apow = (const float2*)(p.ws + SM_APOW); const float2* Bbar = (const float2*)(p.ws + SM_BBAR);
    float* Kd = (float*)(p.ws + SM_KD); bf16_t* Gm = (bf16_t*)(p.ws + SM_G); bf16_t* Ym = (bf16_t*)(p.ws + SM_Y); bf16_t* LWT = (bf16_t*)(p.ws + SM_LWT);
    const float* cre = p.in[16] + (size_t)l * 131072; const float* cim = p.in[17] + (size_t)l * 131072;
    const int gs = gridDim.x * 512, t0 = lbid() * 512 + ltid();
    for (int o = t0; o < 524288; o += gs) {
        const int c2 = o & 15, c = (o >> 4) & 15, k = (o >> 8) & 15, dg = o >> 12;
        float acc = 0.f;
        for (int p0 = 0; p0 < 64; p0 += 8) {
            float2 A[8], Bb[8]; float Cr[8], Ci[8];
#pragma unroll
            for (int q = 0; q < 8; ++q) { const int sidx = dg * 64 + p0 + q; A[q] = Apow[sidx * 18 + k]; Bb[q] = Bbar[sidx * 16 + c2]; Cr[q] = cre[(dg * 16 + c) * 64 + p0 + q]; Ci[q] = cim[(dg * 16 + c) * 64 + p0 + q]; }
            asm volatile("" ::: "memory");
#pragma unroll
            for (int q = 0; q < 8; ++q) { const float abr = A[q].x * Bb[q].x - A[q].y * Bb[q].y, abi = A[q].x * Bb[q].y + A[q].y * Bb[q].x; acc += Cr[q] * abr - Ci[q] * abi; }
        }
        Kd[o] = acc;
    }
    for (int ob = t0; ob < 64 * 65536; ob += 4 * gs) {
        float2 A1[4], B1[4], A2v[4]; float Cr[4], Ci[4];
#pragma unroll
        for (int q = 0; q < 4; ++q) { const int o = min(ob + q * gs, 64 * 65536 - 1); const int kk = o & 255, n = (o >> 8) & 255, g = o >> 16;
            { const int d = n >> 7, pp = n & 63, s = kk >> 4, c2 = kk & 15, e = d == 0 ? 15 - s : s; const int sidx = (d * 64 + g) * 64 + pp; A1[q] = Apow[sidx * 18 + e]; B1[q] = Bbar[sidx * 16 + c2]; }
            { const int tau = n >> 4, c = n & 15, d = kk >> 7, pp = kk & 63, e = d == 0 ? tau + 1 : 16 - tau; const int sidx = (d * 64 + g) * 64 + pp;
              A2v[q] = Apow[sidx * 18 + e]; Cr[q] = cre[((d * 64 + g) * 16 + c) * 64 + pp]; Ci[q] = cim[((d * 64 + g) * 16 + c) * 64 + pp]; } }
        asm volatile("" ::: "memory");
#pragma unroll
        for (int q = 0; q < 4; ++q) { const int o = ob + q * gs; if (o >= 64 * 65536) break; const int kk = o & 255, n = (o >> 8) & 255, g = o >> 16;
            Gm[o] = f2bf(((n >> 6) & 1) ? A1[q].x * B1[q].y + A1[q].y * B1[q].x : A1[q].x * B1[q].x - A1[q].y * B1[q].y);
            Ym[((size_t)g * 256 + n) * 512 + 256 + kk] = f2bf(((kk >> 6) & 1) ? -(Cr[q] * A2v[q].y + Ci[q] * A2v[q].x) : Cr[q] * A2v[q].x - Ci[q] * A2v[q].y); }
    }
    for (int o = t0; o < 262144; o += gs) {
        const int i = o & 63, j = (o >> 6) & 63, n = (o >> 12) & 15, gate = (o >> 16) & 1, d = o >> 17;
        const float* src = gate ? p.in[8] : p.in[6];
        LWT[o] = f2bf(src[(size_t)((l * 2 + d) * 16 + n) * 4096 + i * 64 + j]);
    }
}
__device__ void s5_stage3(const Params& p, int l) {
    const float* Kd = (const float*)(p.ws + SM_KD); bf16_t* Ym = (bf16_t*)(p.ws + SM_Y); const float* Dk = p.in[18] + l * 1024;
    const int gs = gridDim.x * 512;
    for (int ob = lbid() * 512 + ltid(); ob < 64 * 65536; ob += 4 * gs) {
        float kf[4], kr[4], dd[4];
#pragma unroll
        for (int q = 0; q < 4; ++q) { const int o = min(ob + q * gs, 64 * 65536 - 1); const int kk = o & 255, n = (o >> 8) & 255, g = o >> 16, s = kk >> 4, c2 = kk & 15, tau = n >> 4, c = n & 15;
            const int df = s <= tau ? tau - s : 0, dr = s >= tau ? s - tau : 0;
            kf[q] = Kd[((0 * 64 + g) * 16 + df) * 256 + c * 16 + c2]; kr[q] = Kd[((1 * 64 + g) * 16 + dr) * 256 + c * 16 + c2]; dd[q] = Dk[g * 16 + c]; }
        asm volatile("" ::: "memory");
#pragma unroll
        for (int q = 0; q < 4; ++q) { const int o = ob + q * gs; if (o >= 64 * 65536) break; const int kk = o & 255, n = (o >> 8) & 255, g = o >> 16, s = kk >> 4, c2 = kk & 15, tau = n >> 4, c = n & 15;
            float v = 0.f; if (s <= tau) v += kf[q]; if (s >= tau) v += kr[q]; if (s == tau && c == c2) v += dd[q];
            Ym[((size_t)g * 256 + n) * 512 + kk] = f2bf(v); }
    }
}
__device__ void s5_bscan(const Params& p, unsigned char* shm) {
    const float2* Apow = (const float2*)(p.ws + SM_APOW); const float* S = (const float*)((const unsigned char*)p.out + O_S); bf16_t* A2 = (bf16_t*)(p.ws + B_A2);
    float2* Es = (float2*)shm;
    const int tid = ltid();
    for (int it = lbid(); it < 192; it += gridDim.x) {
        const bool lng = it < 128;
        const int pp = tid & 63, g = lng ? it >> 1 : it - 128, d = lng ? (it & 1) : ((tid >> 6) & 1), seg = lng ? tid >> 6 : 0, seq = lng ? 4 : tid >> 7;
        const int j0 = lng ? 512 + seg * 128 : seq * 128;
        const float2 A16 = Apow[((d * 64 + g) * 64 + pp) * 18 + 16];
        const float* Sg = S + (size_t)g * NSUB * 256 + d * 128 + pp; bf16_t* Xg = A2 + (size_t)g * NSUB * 512 + 256 + d * 128 + pp;
        float xr = 0.f, xi = 0.f;
        if (lng) {
            for (int jb = 0; jb < 128; jb += 16) {
                float sr[16], si[16];
#pragma unroll
                for (int u = 0; u < 16; ++u) { const int j = d ? (j0 + 127 - (jb + u)) : (j0 + jb + u); sr[u] = Sg[(size_t)j * 256]; si[u] = Sg[(size_t)j * 256 + 64]; }
                asm volatile("" ::: "memory");
#pragma unroll
                for (int u = 0; u < 16; ++u) { const float nr = A16.x * xr - A16.y * xi + sr[u], ni = A16.x * xi + A16.y * xr + si[u]; xr = nr; xi = ni; }
            }
            Es[seg * 64 + pp] = make_float2(xr, xi);
            float2 Ab = A16;
#pragma unroll
            for (int q = 0; q < 7; ++q) Ab = make_float2(Ab.x * Ab.x - Ab.y * Ab.y, 2.0f * Ab.x * Ab.y);
            __syncthreads();
            xr = 0.f; xi = 0.f;
            for (int q = 0; q < 8; ++q) { const int sq = d ? 7 - q : q; const bool use = d ? (sq > seg) : (sq < seg);
                if (use) { const float2 E = Es[sq * 64 + pp]; const float nr = Ab.x * xr - Ab.y * xi + E.x, ni = Ab.x * xi + Ab.y * xr + E.y; xr = nr; xi = ni; } }
        }
        for (int jb = 0; jb < 128; jb += 16) {
            float sr[16], si[16];
#pragma unroll
            for (int u = 0; u < 16; ++u) { const int j = d ? (j0 + 127 - (jb + u)) : (j0 + jb + u); sr[u] = Sg[(size_t)j * 256]; si[u] = Sg[(size_t)j * 256 + 64]; }
            asm volatile("" ::: "memory");
#pragma unroll
            for (int u = 0; u < 16; ++u) { const int j = d ? (j0 + 127 - (jb + u)) : (j0 + jb + u);
                Xg[(size_t)j * 512] = f2bf(xr); Xg[(size_t)j * 512 + 64] = f2bf(xi);
                const float nr = A16.x * xr - A16.y * xi + sr[u], ni = A16.x * xi + A16.y * xr + si[u]; xr = nr; xi = ni; }
        }
        __syncthreads();
    }
}

template <int PASS>
__device__ void lru_items(const Params& p, unsigned char* shm, int l) {
    bf16_t* xraw = (bf16_t*)shm;
    float* xcf = (float*)(shm + 8704);
    bf16_t* xcb = (bf16_t*)(shm + 25344);
    bf16_t* wt = (bf16_t*)(shm + 34560);
    float* As = (float*)(shm + 71424);
    float* Bs = (float*)(shm + 104192);
    float* Pq = (float*)(shm + 136960);
    float* Hq = (float*)(shm + 139008);
    const bf16_t* XL = (const bf16_t*)(p.ws + B_XL); bf16_t* GL = (bf16_t*)(p.ws + B_GL); const bf16_t* LWT = (const bf16_t*)(p.ws + SM_LWT);
    float* SA = (float*)(p.ws + SM_SA); float* SH = (float*)(p.ws + SM_SH); const float* CIN = (const float*)(p.ws + SM_CIN);
    const float* cw = p.in[4] + l * 4096; const float* cbias = p.in[5] + l * 1024;
    const int tid = ltid(), lane = tid & 63, w = tid >> 6, fr = lane & 15, fq = lane >> 4, G_ = gridDim.x, total = NCHK * 16;
    int n_loaded = -1;
    float c0 = 0.f, c1 = 0.f, c2 = 0.f, c3 = 0.f, cb = 0.f, gba[4], gbx[4], gsp[4];
#pragma unroll
    for (int jt = 0; jt < 4; ++jt) { gba[jt] = 0.f; gbx[jt] = 0.f; gsp[jt] = 0.f; }
    u32x4 xr0 = (u32x4){0u, 0u, 0u, 0u}, xr1 = (u32x4){0u, 0u, 0u, 0u};
#define LRU_LOAD(IT) do { const int ck_ = (IT) >> 4, n_ = (IT) & 15, t0_ = ck_ * 64; const int ss_ = t0_ < 8192 ? (t0_ & ~2047) : 8192, se_ = t0_ < 8192 ? ss_ + 2048 : MT; \
        { const int row = tid >> 3, c8 = tid & 7, tok = t0_ - 2 + row; xr0 = (u32x4){0u, 0u, 0u, 0u}; if (tok >= ss_ && tok < se_) xr0 = *(const u32x4*)(XL + (size_t)tok * 1024 + n_ * 64 + c8 * 8); } \
        if (tid < 24) { const int row = 64 + (tid >> 3), c8 = tid & 7, tok = t0_ - 2 + row; xr1 = (u32x4){0u, 0u, 0u, 0u}; if (tok >= ss_ && tok < se_) xr1 = *(const u32x4*)(XL + (size_t)tok * 1024 + n_ * 64 + c8 * 8); } } while (0)
    int it = lbid();
    if (it < total) LRU_LOAD(it);
    for (; it < total; it += G_) {
        const int ck = it >> 4, n = it & 15, t0 = ck * 64;
        *(u32x4*)(xraw + (tid >> 3) * 64 + (tid & 7) * 8) = xr0;
        if (tid < 24) *(u32x4*)(xraw + (64 + (tid >> 3)) * 64 + (tid & 7) * 8) = xr1;
        if (n != n_loaded) {
            n_loaded = n;
#pragma unroll
            for (int i = 0; i < 4; ++i) { const int e = tid + 512 * i, mtx = e >> 9, rem = e & 511, j = rem >> 3, c8 = rem & 7;
                *(u32x4*)(wt + (mtx * 64 + j) * 72 + c8 * 8) = *(const u32x4*)(LWT + ((size_t)(mtx * 16 + n) * 64 + j) * 64 + c8 * 8); }
            { const int ch = n * 64 + (tid & 63); c0 = cw[ch]; c1 = cw[1024 + ch]; c2 = cw[2048 + ch]; c3 = cw[3072 + ch]; cb = cbias[ch]; }
#pragma unroll
            for (int jt = 0; jt < 4; ++jt) { const int pi = (l * 2 + (w >> 2)) * 1024 + n * 64 + jt * 16 + fr; gba[jt] = p.in[7][pi]; gbx[jt] = p.in[9][pi]; gsp[jt] = -8.0f * log1pf(__expf(-p.in[10][pi])); }
        }
        u32x4 glv = (u32x4){0u, 0u, 0u, 0u}; float cin = 0.f;
        const size_t go = (size_t)(t0 + (tid >> 3)) * 1024 + n * 64 + (tid & 7) * 8;
        const size_t so = (size_t)(ck * 2 + ((tid >> 6) & 1)) * 1024 + n * 64 + (tid & 63);
        if (PASS == 1) { glv = *(const u32x4*)(GL + go); cin = CIN[so]; }
        asm volatile("" ::: "memory");
        __syncthreads();
        if (it + G_ < total) LRU_LOAD(it + G_);
        asm volatile("" ::: "memory");
        { const int j = tid & 63;
#pragma unroll
          for (int i = 0; i < 8; ++i) { const int t = (tid >> 6) + 8 * i;
              const float v = cb + bf2f(xraw[t * 64 + j]) * c0 + bf2f(xraw[(t + 1) * 64 + j]) * c1 + bf2f(xraw[(t + 2) * 64 + j]) * c2 + bf2f(xraw[(t + 3) * 64 + j]) * c3;
              xcf[t * 65 + j] = v; xcb[t * 72 + j] = f2bf(v); } }
        __syncthreads();
        { const int d = w >> 2, tt = w & 3;
          const bf16x8 a0 = *(const bf16x8*)(xcb + (tt * 16 + fr) * 72 + fq * 8), a1 = *(const bf16x8*)(xcb + (tt * 16 + fr) * 72 + 32 + fq * 8);
#pragma unroll
          for (int jt = 0; jt < 4; ++jt) {
              f32x4 accr = (f32x4){0.f, 0.f, 0.f, 0.f}, acci = (f32x4){0.f, 0.f, 0.f, 0.f};
              const bf16_t* wr_ = wt + ((d * 2 + 0) * 64 + jt * 16 + fr) * 72 + fq * 8; const bf16_t* wi_ = wt + ((d * 2 + 1) * 64 + jt * 16 + fr) * 72 + fq * 8;
              accr = __builtin_amdgcn_mfma_f32_16x16x32_bf16(a0, *(const bf16x8*)wr_, accr, 0, 0, 0);
              accr = __builtin_amdgcn_mfma_f32_16x16x32_bf16(a1, *(const bf16x8*)(wr_ + 32), accr, 0, 0, 0);
              acci = __builtin_amdgcn_mfma_f32_16x16x32_bf16(a0, *(const bf16x8*)wi_, acci, 0, 0, 0);
              acci = __builtin_amdgcn_mfma_f32_16x16x32_bf16(a1, *(const bf16x8*)(wi_ + 32), acci, 0, 0, 0);
              const int j = jt * 16 + fr;
#pragma unroll
              for (int i = 0; i < 4; ++i) { const int t = tt * 16 + fq * 4 + i;
                  const float r = sigm(accr[i] + gba[jt]), ig = sigm(acci[i] + gbx[jt]), a = __expf(r * gsp[jt]);
                  As[(d * 64 + t) * 64 + j] = a;
                  Bs[(d * 64 + t) * 64 + j] = sqrtf(fmaxf(1.0f - a * a, 0.f)) * ig * xcf[t * 65 + j]; }
          } }
        __syncthreads();
        {
            const int seg = tid >> 7, d = (tid >> 6) & 1, j = tid & 63;
            float h = 0.f, P = 1.f;
#pragma unroll
            for (int s = 0; s < 16; ++s) { const int st = seg * 16 + s, t = d ? 63 - st : st; const float a = As[(d * 64 + t) * 64 + j]; h = a * h + Bs[(d * 64 + t) * 64 + j]; P *= a; }
            Pq[seg * 128 + (tid & 127)] = P; Hq[seg * 128 + (tid & 127)] = h;
            __syncthreads();
            if (PASS == 0) {
                if (tid < 128) { float hh = Hq[tid], PP = Pq[tid];
#pragma unroll
                    for (int q = 1; q < 4; ++q) { const float pq = Pq[q * 128 + tid]; hh = pq * hh + Hq[q * 128 + tid]; PP *= pq; }
                    SA[so] = PP; SH[so] = hh; }
            } else {
                float c = cin;
#pragma unroll
                for (int q = 0; q < 3; ++q) if (q < seg) c = Pq[q * 128 + (tid & 127)] * c + Hq[q * 128 + (tid & 127)];
#pragma unroll
                for (int s = 0; s < 16; ++s) { const int st = seg * 16 + s, t = d ? 63 - st : st; c = As[(d * 64 + t) * 64 + j] * c + Bs[(d * 64 + t) * 64 + j]; Bs[(d * 64 + t) * 64 + j] = c; }
                __syncthreads();
                const int t = tid >> 3, c8 = tid & 7;
                f32x4 g0, g1; unpack8(glv, g0, g1);
                const f32x4 f0 = *(const f32x4*)(Bs + t * 64 + c8 * 8), f1 = *(const f32x4*)(Bs + t * 64 + c8 * 8 + 4), r0 = *(const f32x4*)(Bs + (64 + t) * 64 + c8 * 8), r1 = *(const f32x4*)(Bs + (64 + t) * 64 + c8 * 8 + 4);
                *(u32x4*)(GL + go) = pack8((f0 + r0) * g0, (f1 + r1) * g1);
            }
        }
        __syncthreads();
    }
#undef LRU_LOAD
}
__device__ void lru_carry(const Params& p) {
    const float* SA = (const float*)(p.ws + SM_SA); const float* SH = (const float*)(p.ws + SM_SH); float* CIN = (float*)(p.ws + SM_CIN);
    const int tid_ = ltid();
    const int G_ = gridDim.x, b0 = lbid(), first = G_ >= 212 ? 192 : 0;
    for (int it = (b0 - first + G_) % G_; it < 20; it += G_) {
        const int c = it * 512 + tid_, ch = c & 1023, d = (c >> 10) & 1, seq = c >> 11;
        const int k0 = seq < 4 ? seq * 32 : 128, nk = seq < 4 ? 32 : 256;
        float carry = 0.f;
        for (int kb = 0; kb < nk; kb += 16) {
            float a[16], h[16];
#pragma unroll
            for (int u = 0; u < 16; ++u) { const int k = d ? (k0 + nk - 1 - (kb + u)) : (k0 + kb + u); a[u] = SA[(size_t)(k * 2 + d) * 1024 + ch]; h[u] = SH[(size_t)(k * 2 + d) * 1024 + ch]; }
            asm volatile("" ::: "memory");
#pragma unroll
            for (int u = 0; u < 16; ++u) { const int k = d ? (k0 + nk - 1 - (kb + u)) : (k0 + kb + u); CIN[(size_t)(k * 2 + d) * 1024 + ch] = carry; carry = a[u] * carry + h[u]; }
        }
    }
}

struct AttnGeom { int hd, seq_start, dil, n_lat, r, q0; };
__device__ __forceinline__ AttnGeom attn_geom(int it) {
    AttnGeom G; G.hd = it / 192; const int qt = it % 192;
    int T, lt; if (qt < 64) { G.seq_start = (qt >> 4) * 2048; T = 2048; lt = qt & 15; } else { G.seq_start = 8192; T = 16384; lt = qt - 64; }
    const int g = G.hd >> 3; G.dil = g == 0 ? 1 : (g == 1 ? 4 : 16); G.n_lat = T / G.dil; const int tpr = G.n_lat >> 7; G.r = lt / tpr; G.q0 = (lt % tpr) << 7; return G;
}
__device__ void attn_items(const Params& p, unsigned char* shm) {
    bf16_t* Ks = (bf16_t*)shm;
    bf16_t* Vt = (bf16_t*)(shm + 36864);
    bf16_t* Ps = (bf16_t*)(shm + 77824);
    float* BT = (float*)(shm + 120832);
    bf16_t* Qb = (bf16_t*)(p.ws + B_Q); const bf16_t* Kb = (const bf16_t*)(p.ws + B_K); const bf16_t* Vb = (const bf16_t*)(p.ws + B_V);
    float* LSE = (float*)(p.ws + SM_LSE);
    const int tid = ltid(), lane = tid & 63, w = tid >> 6, fr = lane & 15, fq = lane >> 4, G_ = gridDim.x;
    for (int i = tid; i < 24 * 129; i += 512) { const int hd = i / 129, j = i % 129; BT[hd * 132 + j] = p.in[21][(int)BUCKET[hd >> 3][j] * 24 + hd]; }
    u32x4 kreg[5], vreg[5]; bf16x8 q0r, q1r;
    const int total = 24 * 192;
    int it = lbid();
#define ATT_LOAD(IT) do { const AttnGeom G = attn_geom(IT); \
        _Pragma("unroll") for (int i = 0; i < 5; ++i) { const int e = tid + 512 * i, kk = e >> 3, c8 = e & 7, lat = G.q0 - 64 + kk; const bool ok = e < 2176 && kk < 256 && lat >= 0 && lat < G.n_lat; \
            kreg[i] = (u32x4){0u, 0u, 0u, 0u}; vreg[i] = (u32x4){0u, 0u, 0u, 0u}; \
            if (ok) { const size_t go = (size_t)(G.seq_start + G.r + G.dil * lat) * 1536 + G.hd * 64 + c8 * 8; kreg[i] = *(const u32x4*)(Kb + go); vreg[i] = *(const u32x4*)(Vb + go); } } \
        const size_t qo = (size_t)(G.seq_start + G.r + G.dil * (G.q0 + 16 * w + fr)) * 1536 + G.hd * 64; \
        q0r = *(const bf16x8*)(Qb + qo + fq * 8); q1r = *(const bf16x8*)(Qb + qo + 32 + fq * 8); } while (0)
    if (it < total) ATT_LOAD(it);
    for (; it < total; it += G_) {
        const AttnGeom G = attn_geom(it);
#pragma unroll
        for (int i = 0; i < 5; ++i) { const int e = tid + 512 * i, kk = e >> 3, c8 = e & 7;
            if (e < 2176) {
                if (kk < 256) *(u32x4*)(Ks + kk * 72 + c8 * 8) = kreg[i];
#pragma unroll
                for (int j = 0; j < 8; ++j) Vt[(c8 * 8 + j) * 320 + (kk ^ (c8 << 3))] = (bf16_t)((vreg[i][j >> 1] >> ((j & 1) * 16)) & 0xffffu); } }
        const bf16x8 aq0 = q0r, aq1 = q1r;
        __syncthreads();
        if (it + G_ < total) ATT_LOAD(it + G_);
        asm volatile("" ::: "memory");
        const float* bs = BT + G.hd * 132;
        f32x4 s[9];
#pragma unroll
        for (int kt = 0; kt < 9; ++kt) { const bf16_t* kr = Ks + (16 * w + 16 * kt + fr) * 72 + fq * 8;
            f32x4 a = (f32x4){0.f, 0.f, 0.f, 0.f};
            a = __builtin_amdgcn_mfma_f32_16x16x32_bf16(aq0, *(const bf16x8*)kr, a, 0, 0, 0);
            a = __builtin_amdgcn_mfma_f32_16x16x32_bf16(aq1, *(const bf16x8*)(kr + 32), a, 0, 0, 0); s[kt] = a; }
        float mx[4], ls[4];
#pragma unroll
        for (int i = 0; i < 4; ++i) { const int qi = fq * 4 + i; float m = -3.0e38f;
#pragma unroll
            for (int kt = 0; kt < 9; ++kt) { const int rel = 16 * kt + fr - 64 - qi, klat = G.q0 - 64 + 16 * w + 16 * kt + fr;
                const bool ok = rel >= -64 && rel <= 64 && klat >= 0 && klat < G.n_lat; const int bi = min(max(rel + 64, 0), 128);
                const float v = ok ? s[kt][i] + bs[bi] : -1.0e30f; s[kt][i] = v; m = fmaxf(m, v); }
            m = fmaxf(m, __shfl_xor(m, 1)); m = fmaxf(m, __shfl_xor(m, 2)); m = fmaxf(m, __shfl_xor(m, 4)); m = fmaxf(m, __shfl_xor(m, 8));
            float sum = 0.f;
#pragma unroll
            for (int kt = 0; kt < 9; ++kt) { const float pv = __expf(s[kt][i] - m); s[kt][i] = pv; sum += pv; }
            sum += __shfl_xor(sum, 1); sum += __shfl_xor(sum, 2); sum += __shfl_xor(sum, 4); sum += __shfl_xor(sum, 8);
            mx[i] = m; ls[i] = sum; }
        bf16_t* Pw = Ps + w * 16 * 168;
#pragma unroll
        for (int i = 0; i < 4; ++i) {
#pragma unroll
            for (int kt = 0; kt < 9; ++kt) Pw[(fq * 4 + i) * 168 + 16 * kt + fr] = f2bf(s[kt][i]);
            Pw[(fq * 4 + i) * 168 + 144 + fr] = 0; }
        __syncthreads();
        f32x4 o[4];
#pragma unroll
        for (int nt = 0; nt < 4; ++nt) o[nt] = (f32x4){0.f, 0.f, 0.f, 0.f};
#pragma unroll
        for (int ks = 0; ks < 5; ++ks) { const bf16x8 ap = *(const bf16x8*)(Pw + fr * 168 + ks * 32 + fq * 8);
#pragma unroll
            for (int nt = 0; nt < 4; ++nt) { const int dim = nt * 16 + fr; o[nt] = __builtin_amdgcn_mfma_f32_16x16x32_bf16(ap, *(const bf16x8*)(Vt + dim * 320 + ((16 * w + ks * 32 + fq * 8) ^ ((dim >> 3) << 3))), o[nt], 0, 0, 0); } }
        __syncthreads();
#pragma unroll
        for (int i = 0; i < 4; ++i) { const float inv = 1.0f / ls[i];
#pragma unroll
            for (int nt = 0; nt < 4; ++nt) Pw[(fq * 4 + i) * 168 + nt * 16 + fr] = f2bf(o[nt][i] * inv);
            if (fr == 0) LSE[(size_t)(G.seq_start + G.r + G.dil * (G.q0 + 16 * w + fq * 4 + i)) * 24 + G.hd] = mx[i] + __logf(ls[i]); }
        __syncthreads();
#pragma unroll
        for (int h = 0; h < 2; ++h) { const int c = lane + 64 * h, row = c >> 3, c8 = c & 7;
            *(u32x4*)(Qb + (size_t)(G.seq_start + G.r + G.dil * (G.q0 + 16 * w + row)) * 1536 + G.hd * 64 + c8 * 8) = *(const u32x4*)(Pw + row * 168 + c8 * 8); }
        __syncthreads();
    }
#undef ATT_LOAD
}
__device__ void attn_combine(const Params& p) {
    const bf16_t* Ab = (const bf16_t*)(p.ws + B_Q); const float* LSE = (const float*)(p.ws + SM_LSE); bf16_t* YA = (bf16_t*)(p.ws + B_YATT);
    for (int e = lbid() * 512 + ltid(); e < MT * 64; e += gridDim.x * 512) {
        const int tok = e >> 6, h = (e >> 3) & 7, c8 = e & 7;
        const float l0 = LSE[(size_t)tok * 24 + h], l1 = LSE[(size_t)tok * 24 + 8 + h], l2 = LSE[(size_t)tok * 24 + 16 + h];
        const float m = fmaxf(l0, fmaxf(l1, l2)); float w0 = __expf(l0 - m), w1 = __expf(l1 - m), w2 = __expf(l2 - m); const float inv = 1.0f / (w0 + w1 + w2); w0 *= inv; w1 *= inv; w2 *= inv;
        f32x4 a0, a1, b0, b1, c0, c1;
        const u32x4 ua = *(const u32x4*)(Ab + (size_t)tok * 1536 + h * 64 + c8 * 8), ub = *(const u32x4*)(Ab + (size_t)tok * 1536 + (8 + h) * 64 + c8 * 8), uc = *(const u32x4*)(Ab + (size_t)tok * 1536 + (16 + h) * 64 + c8 * 8);
        asm volatile("" ::: "memory");
        unpack8(ua, a0, a1); unpack8(ub, b0, b1); unpack8(uc, c0, c1);
        *(u32x4*)(YA + (size_t)tok * 512 + h * 64 + c8 * 8) = pack8(a0 * w0 + b0 * w1 + c0 * w2, a1 * w0 + b1 * w1 + c1 * w2);
    }
}


#define XB_TMO      128
#define XB_XCNT(j)  (256  + 64 * (j))
#define XB_XSUB(j)  (1280 + 64 * (j))
#define XB_XGEN(j)  (2304 + 64 * (j))
#define XB_TOP      3328
#define XB_TOPGEN   3392
#define XCD_BAR_WORDS 3456
#define XB_SPIN_CAP (1u << 18)
__device__ __forceinline__ unsigned xb_ld(unsigned* p)              { return __hip_atomic_load(p, __ATOMIC_RELAXED, __HIP_MEMORY_SCOPE_AGENT); }
__device__ __forceinline__ unsigned xb_add(unsigned* p, unsigned v) { return __hip_atomic_fetch_add(p, v, __ATOMIC_RELAXED, __HIP_MEMORY_SCOPE_AGENT); }
__device__ __forceinline__ unsigned xb_xcc_id() { return (unsigned)__builtin_amdgcn_s_getreg((3 << 11) | 20) & 0xFu; }
#define XB_SPIN(cond, bar) do { unsigned _sp = 0; while (cond) { __builtin_amdgcn_s_sleep(1); \
    if ((++_sp & 255u) == 0u) { if (xb_ld(&(bar)[XB_TMO])) break; if (_sp > XB_SPIN_CAP) { atomicAdd(&(bar)[XB_TMO], 1u); break; } } } } while (0)
struct XcdBarrier { unsigned* bar; unsigned x; volatile LAS unsigned* st; };
__device__ __forceinline__ XcdBarrier xcd_barrier_post(unsigned* bar, volatile LAS unsigned* st) {
    XcdBarrier b; b.bar = bar; b.x = xb_xcc_id(); b.st = st;
    if (threadIdx.x == 0) (void)xb_add(&bar[XB_XCNT(b.x)], 1u);
    return b;
}
__device__ __forceinline__ void xcd_barrier_complete(unsigned* bar, unsigned x, unsigned& nloc, unsigned& nx) {
    const unsigned G = gridDim.x * gridDim.y * gridDim.z;
    unsigned sum, cnt, mine, sp = 0u;
    for (;;) {
        sum = 0u; cnt = 0u; mine = 0u;
#pragma unroll
        for (unsigned j = 0; j < 16; ++j) { const unsigned c = xb_ld(&bar[XB_XCNT(j)]); sum += c; cnt += (c > 0u) ? 1u : 0u; mine = (j == x) ? c : mine; }
        if (sum == G) break;
        __builtin_amdgcn_s_sleep(1);
        if ((++sp & 255u) == 0u) { if (xb_ld(&bar[XB_TMO])) break; if (sp > XB_SPIN_CAP) { atomicAdd(&bar[XB_TMO], 1u); break; } }
    }
    nloc = mine > 0u ? mine : 1u; nx = cnt > 0u ? cnt : 1u;
}
__device__ __forceinline__ void xcd_barrier(const XcdBarrier& b) {
    asm volatile("s_waitcnt vmcnt(0)" ::: "memory");
    __syncthreads();
    if (threadIdx.x == 0) {
        unsigned* bar = b.bar;
        __builtin_amdgcn_s_waitcnt(0);
        unsigned nloc = b.st[0], nx = b.st[1];
        if (nloc == 0u) { xcd_barrier_complete(bar, b.x, nloc, nx); b.st[0] = nloc; b.st[1] = nx; }
        const unsigned old = xb_add(&bar[XB_XSUB(b.x)], 1u);
        const unsigned gen = old / nloc;
        if (old + 1u == (gen + 1u) * nloc) {
            __builtin_amdgcn_fence(__ATOMIC_RELEASE, "agent");
            asm volatile("s_waitcnt vmcnt(0)" ::: "memory");
            const unsigned og = xb_add(&bar[XB_TOP], 1u);
            const unsigned tg = og / nx;
            if (og + 1u == (tg + 1u) * nx) xb_add(&bar[XB_TOPGEN], 1u);
            else XB_SPIN(xb_ld(&bar[XB_TOPGEN]) == tg, bar);
            __builtin_amdgcn_fence(__ATOMIC_ACQUIRE, "agent");
            xb_add(&bar[XB_XGEN(b.x)], 1u);
            asm volatile("s_waitcnt vmcnt(0)" ::: "memory");
        } else {
            XB_SPIN(xb_ld(&bar[XB_XGEN(b.x)]) == gen, bar);
            __builtin_amdgcn_fence(__ATOMIC_ACQUIRE, "agent");
            asm volatile("s_waitcnt vmcnt(0)" ::: "memory");
        }
    }
    __syncthreads();
}

__device__ __forceinline__ Gemm mk_gemm(const bf16_t* A, int lda, const bf16_t* Bt, int ldb, int K, int nM, int nN, int nb = 1, size_t sA = 0, size_t sB = 0) {
    Gemm g; g.A = A; g.Bt = Bt; g.lda = lda; g.ldb = ldb; g.K = K; g.nM = nM; g.nN = nN; g.nb = nb; g.sA = sA; g.sB = sB; return g; }

__global__ __launch_bounds__(512, 2) void mega(Params p) {
    extern __shared__ __attribute__((aligned(16))) unsigned char shm[];
    LAS unsigned char* lds = (LAS unsigned char*)shm;
    cg::grid_group grid = cg::this_grid();
    volatile LAS unsigned* xst = (volatile LAS unsigned*)(lds + LDS_BYTES - 16);
    XcdBarrier xb; xb.bar = (unsigned*)(p.ws + SM_BAR); xb.x = 0; xb.st = xst;
    if (p.ph_hi - p.ph_lo > 1) { if (threadIdx.x == 0) { xst[0] = 0u; xst[1] = 0u; } __syncthreads(); xb = xcd_barrier_post((unsigned*)(p.ws + SM_BAR), xst); }
#pragma nounroll
    for (int ph = p.ph_lo; ph < p.ph_hi; ++ph) {
        unsigned char* ws = p.ws; asm volatile("" : "+s"(ws));
        const int l = ph == 0 ? 0 : (ph - 1) / 14, kind = ph == 0 ? 0 : (ph - 1) % 14 + 1;
        bf16_t* W = (bf16_t*)(ws + WS_W); bf16_t* H = (bf16_t*)(ws + WS_H);
        bf16_t* HID = (bf16_t*)(ws + B_HID); bf16_t* Y = (bf16_t*)(ws + B_Y); bf16_t* A2 = (bf16_t*)(ws + B_A2);
        bf16_t* Y1 = (bf16_t*)(ws + B_Y1); bf16_t* Mb = (bf16_t*)(ws + B_M);
        unsigned char* ob = (unsigned char*)p.out; asm volatile("" : "+s"(ob));
        bf16_t* YS5 = (bf16_t*)(ob + O_YS5); const float* RSp = (const float*)(ws + SM_RS);
        const float* ng = p.in[2]; const float* gl_ = ng + l * 6 * DM;
        unsigned* dynq = (unsigned*)(ws + SM_BAR) + XCD_BAR_WORDS;
#ifdef PROBE_MASK
        for (int rep = 0, reps = ((PROBE_MASK >> kind) & 1) ? 2 : 1; rep < reps; ++rep)
#endif
        switch (kind) {
        case 0:
            PREP(0) cvt_ffn(p, shm, 0, 0); s5_stage1(p, 0);
            PREP(1) norm_rows(p, 0, 0.f, nullptr);
            break;
        case 1: case 12: {
            EpiSwiglu e; e.O = HID; e.rs = RSp; gemm_phase<EpiSwiglu, true>(lds, mk_gemm(H, LDX, W + W_13, LDX, DM, MT / 256, 44), e, dynq + (l * 6 + (kind == 1 ? 0 : 4)) * 128);
        } break;
        case 2: case 13: {
            EpiBf16 e; e.O = Y; e.ldc = DM; gemm_phase<EpiBf16, true>(lds, mk_gemm(HID, DFF, W + W_2, DFF, DFF, MT / 256, 8), e, dynq + (l * 6 + (kind == 2 ? 1 : 5)) * 128);
        } break;
        case 3:
            PREP(0) cvt_mixer(p, shm, l);
            s5_stage2(p, l);
            norm_rows(p, 1, 0.5f, gl_ + 1 * DM);
            if ((PROBE2 >> 1) & 1) norm_rows(p, 1, 0.0f, gl_ + 1 * DM);
            break;
        case 4: {
            EpiWin e; e.ws = ws; e.rs = RSp; gemm_phase<EpiWin, true>(lds, mk_gemm(H, LDX, W + W_IN, LDX, DM, MT / 256, 54), e, dynq + (l * 6 + 2) * 128);
        } break;
        case 5: {
            PREP(3) { EpiS e; e.S = (float*)(ob + O_S); gemm_phase(lds, mk_gemm(A2, 512, (const bf16_t*)(ws + SM_G), 256, 256, NSUB / 256, 1, 64, (size_t)NSUB * 512, 65536), e); }
            __syncthreads();
            PREP(4) lru_items<0>(p, shm, l);
            attn_items(p, shm);
        } break;
        case 6:
            PREP(5) { lru_carry(p); s5_bscan(p, shm); attn_combine(p); }
            s5_stage3(p, l);
            break;
        case 7: {
            PREP(3) { EpiY e; e.Y1 = Y1; gemm_phase(lds, mk_gemm(A2, 512, (const bf16_t*)(ws + SM_Y), 512, 512, NSUB / 256, 1, 64, (size_t)NSUB * 512, 131072), e); }
            __syncthreads();
            lru_items<1>(p, shm, l);
        } break;
        case 8: {
            EpiGlu e; e.Y1 = Y1; e.O = YS5; e.bias = p.in[20] + l * 1024; gemm_phase(lds, mk_gemm(Y1, 1024, W + W_GLU, 1024, 1024, MT / 256, 4), e);
        } break;
        case 9: {
            { EpiMerge<true> e; e.Gt = (const bf16_t*)(ws + B_GA); e.Mo = Mb; gemm_phase(lds, mk_gemm((const bf16_t*)(ws + B_GL), 1024, W + W_BRL, 1024, 1024, MT / 256, 8), e); }
            { EpiMerge<false> e; e.Gt = (const bf16_t*)(ws + B_GB); e.Mo = Mb; gemm_phase(lds, mk_gemm(YS5, 1024, W + W_BRS, 1024, 1024, MT / 256, 8), e); }
            { EpiMerge<false> e; e.Gt = (const bf16_t*)(ws + B_GC); e.Mo = Mb; gemm_phase(lds, mk_gemm((const bf16_t*)(ws + B_YATT), 512, W + W_BRA, 512, 512, MT / 256, 8), e); }
        } break;
        case 10: {
            EpiBf16 e; e.O = Y; e.ldc = DM; gemm_phase<EpiBf16, true>(lds, mk_gemm(Mb, DM, W + W_OUT, DM, DM, MT / 256, 8), e, dynq + (l * 6 + 3) * 128);
        } break;
        case 11:
            PREP(0) cvt_ffn(p, shm, l, 1);
            norm_rows(p, 1, 1.0f, gl_ + 3 * DM);
            if ((PROBE2 >> 1) & 1) norm_rows(p, 1, 0.0f, gl_ + 3 * DM);
            break;
        default:
            if (l == 0) { PREP(0) cvt_ffn(p, shm, 1, 0); s5_stage1(p, 1); }
            norm_rows(p, l == 0 ? 1 : 2, 0.5f, gl_ + 5 * DM);
            break;
        }
        if (ph + 1 < p.ph_hi) { if (p.ph_hi > 4096) grid.sync(); else xcd_barrier(xb); }
    }
}
constexpr int N_PHASES = 1 + 2 * 14;

extern "C" void kernel_launch(void* const* d_in, const int* in_sizes, int n_in, void* d_out, int out_size, void* d_ws, size_t ws_size, hipStream_t stream) {
    static int grid = 0;
    if (grid == 0) {
        if (n_in != 29 || ws_size < WS_END) { fprintf(stderr, "kernel_launch: need 29 inputs and %zu bytes of workspace (got %d, %zu)\n", (size_t)WS_END, n_in, ws_size); grid = -1; return; }
        if (hipFuncSetAttribute((const void*)mega, hipFuncAttributeMaxDynamicSharedMemorySize, LDS_BYTES) != hipSuccess) { fprintf(stderr, "hipFuncSetAttribute failed\n"); grid = -1; return; }
        int dev = 0, cus = 0, per_cu = 0;
        (void)hipGetDevice(&dev); (void)hipDeviceGetAttribute(&cus, hipDeviceAttributeMultiprocessorCount, dev);
        (void)hipOccupancyMaxActiveBlocksPerMultiprocessor(&per_cu, (const void*)mega, 512, LDS_BYTES);
        if (per_cu < 1) per_cu = 1;
        (void)hipGetLastError();
        grid = cus * 1;
    }
    if (grid < 0) return;
    Params p{};
    for (int i = 0; i < 29; ++i) p.in[i] = (const float*)d_in[i];
    p.out = (float*)d_out; p.ws = (unsigned char*)d_ws;
    if (hipMemsetAsync((char*)d_ws + SM_BAR, 0, (XCD_BAR_WORDS + 12 * 128) * sizeof(unsigned), stream) != hipSuccess) { fprintf(stderr, "memset of the barrier / ticket words failed\n"); return; }
#if ONE_LAUNCH
    p.ph_lo = 0; p.ph_hi = N_PHASES;
    void* args[] = {&p};
    hipError_t e = hipLaunchCooperativeKernel((void*)mega, dim3(grid), dim3(512), args, LDS_BYTES, stream);
    if (e != hipSuccess) fprintf(stderr, "cooperative launch failed: %s (grid %d)\n", hipGetErrorString(e), grid);
#else
    for (int ph = 0; ph < N_PHASES; ++ph) { p.ph_lo = ph; p.ph_hi = ph + 1; hipLaunchKernelGGL(mega, dim3(grid), dim3(512), LDS_BYTES, stream, p); }
#endif
}
```

```cpp
#include <hip/hip_runtime.h>
#include <hip/hip_cooperative_groups.h>
#include <cstdio>
namespace cg = cooperative_groups;

#ifndef PROBE2
#define PROBE2 0
#endif
#define PREP(bit) for (int _r = 0; _r < (((PROBE2 >> (bit)) & 1) ? 2 : 1); ++_r)
#ifndef ONE_LAUNCH
#define ONE_LAUNCH 1
#endif

#define LAS __attribute__((address_space(3)))
typedef unsigned short bf16_t;
typedef short bf16x8 __attribute__((ext_vector_type(8)));
typedef float f32x4 __attribute__((ext_vector_type(4)));
typedef unsigned u32x4 __attribute__((ext_vector_type(4)));
typedef unsigned u32x2 __attribute__((ext_vector_type(2)));

constexpr int DM = 2048, MT = 24576, DFF = 5632, NSUB = MT / 16, NCHK = MT / 64;
constexpr float RMS_EPS = 1e-6f;
constexpr int LDS_BYTES = 147456;
constexpr int LDX = 2048 + 64;

constexpr size_t MiB = (size_t)1 << 20;
constexpr size_t SM_G = 0, SM_Y = 8 * MiB, SM_APOW = 24 * MiB, SM_BBAR = 26 * MiB, SM_KD = 27 * MiB, SM_LWT = 29 * MiB,
                 SM_SA = 30 * MiB, SM_SH = 33 * MiB, SM_CIN = 36 * MiB, SM_LSE = 39 * MiB, SM_RS = 41 * MiB + 512 * 1024, SM_BAR = 41 * MiB + 768 * 1024;
constexpr size_t WS_W = 42 * MiB, WS_WSZ = 80 * MiB, WS_H = 202 * MiB, WS_BIG = 302 * MiB, WS_END = 998 * MiB;
constexpr size_t B_XL = WS_BIG, B_GL = WS_BIG + 48 * MiB, B_A2 = WS_BIG + 96 * MiB, B_Q = WS_BIG + 192 * MiB, B_K = WS_BIG + 264 * MiB,
                 B_V = WS_BIG + 336 * MiB, B_GA = WS_BIG + 408 * MiB, B_GB = WS_BIG + 504 * MiB, B_GC = WS_BIG + 600 * MiB;
constexpr size_t B_HID = WS_BIG, B_Y = B_GA, B_Y1 = B_K, B_YATT = B_K + 48 * MiB, B_M = B_A2;
constexpr size_t O_S = 0, O_YS5 = 96 * MiB;
constexpr size_t W_13 = 0, W_2 = (size_t)11264 * LDX;
constexpr size_t W_IN = 0, W_GLU = (size_t)13824 * LDX, W_BRL = W_GLU + 1048576, W_BRS = W_BRL + 2097152, W_BRA = W_BRS + 2097152, W_OUT = W_BRA + 1048576;

struct Params { const float* in[29]; float* out; unsigned char* ws; int ph_lo, ph_hi; int wave, pad_; };

__device__ const unsigned char BUCKET[3][132] = {
 {11,11,11,11,11,11,11,11,11,11,11,11,11,11,11,10,10,10,10,10,10,10,10,10,10,10,10,10,10,10,10,10,10,10,10,10,10,10,9,9,9,9,9,9,9,9,9,9,9,9,8,8,8,8,8,8,8,7,6,5,4,3,2,1,0,17,18,19,20,21,22,23,24,24,24,24,24,24,24,25,25,25,25,25,25,25,25,25,25,25,25,26,26,26,26,26,26,26,26,26,26,26,26,26,26,26,26,26,26,26,26,26,26,26,27,27,27,27,27,27,27,27,27,27,27,27,27,27,27,0,0,0},
 {13,13,13,13,13,13,13,13,13,13,13,13,13,13,13,13,13,13,13,13,13,13,13,12,12,12,12,12,12,12,12,12,12,12,12,12,12,12,12,12,12,12,11,11,11,11,11,11,11,11,11,11,10,10,10,10,10,10,9,9,9,8,8,4,0,20,24,24,25,25,25,26,26,26,26,26,26,27,27,27,27,27,27,27,27,27,27,28,28,28,28,28,28,28,28,28,28,28,28,28,28,28,28,28,28,28,29,29,29,29,29,29,29,29,29,29,29,29,29,29,29,29,29,29,29,29,29,29,29,0,0,0},
 {15,15,15,15,15,15,15,15,15,15,15,15,15,15,15,15,15,15,15,15,15,15,15,15,15,15,15,15,15,15,14,14,14,14,14,14,14,14,14,14,14,14,14,14,14,13,13,13,13,13,13,13,13,13,12,12,12,12,12,11,11,10,10,9,0,25,26,26,27,27,28,28,28,28,28,29,29,29,29,29,29,29,29,29,30,30,30,30,30,30,30,30,30,30,30,30,30,30,30,31,31,31,31,31,31,31,31,31,31,31,31,31,31,31,31,31,31,31,31,31,31,31,31,31,31,31,31,31,31,0,0,0}};

__device__ __forceinline__ unsigned cvt_pk_bf16(float lo, float hi) { unsigned r; asm("v_cvt_pk_bf16_f32 %0, %1, %2" : "=v"(r) : "v"(lo), "v"(hi)); return r; }
__device__ __forceinline__ bf16_t f2bf(float f) { return (bf16_t)(cvt_pk_bf16(f, 0.f) & 0xffffu); }
__device__ __forceinline__ float bf2f(bf16_t b) { return __uint_as_float(((unsigned)b) << 16); }
__device__ __forceinline__ float bflo(unsigned w) { return __uint_as_float(w << 16); }
__device__ __forceinline__ float bfhi(unsigned w) { return __uint_as_float(w & 0xffff0000u); }
__device__ __forceinline__ float sigm(float x) { return __builtin_amdgcn_rcpf(1.0f + __expf(-x)); }
__device__ __forceinline__ float silu(float x) { return x * sigm(x); }
__device__ __forceinline__ float gelu_t(float x) { return x * sigm(1.5957691216057308f * (x + 0.044715f * x * x * x)); }
__device__ __forceinline__ float wave_sum(float v) {
#pragma unroll
    for (int o = 32; o >= 1; o >>= 1) v += __shfl_xor(v, o);
    return v;
}

__device__ __forceinline__ int ltid(int wave) { int t = (wave << 6) | (int)__builtin_amdgcn_mbcnt_hi(~0u, __builtin_amdgcn_mbcnt_lo(~0u, 0u)); asm volatile("" : "+v"(t)); return t; }
__device__ __forceinline__ int lbid() { int b = blockIdx.x; asm volatile("" : "+s"(b)); return b; }

typedef float f32x2 __attribute__((ext_vector_type(2)));
__device__ __forceinline__ f32x2 exp2_2(f32x2 v) { f32x2 r; r.x = __builtin_amdgcn_exp2f(v.x); r.y = __builtin_amdgcn_exp2f(v.y); return r; }
__device__ __forceinline__ f32x2 rcp_2(f32x2 v) { f32x2 r; r.x = __builtin_amdgcn_rcpf(v.x); r.y = __builtin_amdgcn_rcpf(v.y); return r; }
__device__ __forceinline__ f32x2 swiglu2(f32x2 a, f32x2 b, float rn, float r2) { const f32x2 q = rcp_2(exp2_2(a * rn) + 1.0f); return (a * b) * (q * r2); }
__device__ __forceinline__ f32x2 gelu2(f32x2 v) { const f32x2 z = v * ((v * v) * (-0.10294324f) + (-2.3022082f)); return v * rcp_2(exp2_2(z) + 1.0f); }
__device__ __forceinline__ f32x2 sigm2(f32x2 a, float rn) { return rcp_2(exp2_2(a * rn) + 1.0f); }

constexpr int BM = 256, BK = 64, HALF = 128, HTB = HALF * BK * 2, NXCD = 8, WGM = 4;
__device__ __forceinline__ int lds_byte(int r, int c) { const int st = (r >> 4) * 2 + (c >> 5), rr = r & 15, cc = c & 31, ob = rr * 64 + cc * 2; return st * 1024 + (ob ^ (((ob >> 9) & 1) << 5)); }
__device__ __forceinline__ void stage_rc(int b, int& R, int& C) { const int st = b / 1024, sb = b % 1024, swz = sb ^ (((sb >> 9) & 1) << 5); R = (st >> 1) * 16 + swz / 64; C = (st & 1) * 32 + (swz % 64) / 2; }
__device__ __forceinline__ int perm32(int rho) { const int n = rho >> 4, i = rho & 15; return 8 * (i >> 2) + 4 * n + (i & 3); }

struct Unit { int pm, pn, b; };
struct Gemm { const bf16_t* A; const bf16_t* Bt; int lda, ldb, K, nM, nN, nb; size_t sA, sB; };
struct Order {
    int nM, nN, nwg, tot, G, c, nb;
    __device__ void init(const Gemm& g, int G_, int c_) { nM = g.nM; nN = g.nN; nwg = nM * nN; nb = g.nb; tot = nwg * nb; G = G_; c = c_; }
    __device__ bool next(int i, Unit& u) const {
        const long L = (long)i * G + c; if (L >= tot) return false;
        if (nb > 1) { const int b = (int)(L / nwg), rem = (int)(L % nwg); u.b = b; u.pm = rem % nM; u.pn = rem / nM; return true; }
        int wgid = (int)L; { const int q = nwg / NXCD, r = nwg % NXCD, xcd = wgid % NXCD, off = wgid / NXCD; wgid = (xcd < r ? xcd * (q + 1) : r * (q + 1) + (xcd - r) * q) + off; }
        const int nig = WGM * nN, gid = wgid / nig, fm = gid * WGM, gsz = (nM - fm) < WGM ? (nM - fm) : WGM;
        u.pm = fm + ((wgid % nig) % gsz); u.pn = (wgid % nig) / gsz; u.b = 0; return true;
    }
};

__device__ __forceinline__ unsigned hw_xcc_id() { return (unsigned)__builtin_amdgcn_s_getreg((3 << 11) | 20) & 0xFu; }
template <class Epi, bool DYN = false>
__device__ __forceinline__ void gemm_phase(LAS unsigned char* lds, const Gemm g, const Epi& E, int wave, unsigned* ctr = nullptr) {
    Order S; S.init(g, (int)gridDim.x, lbid());
    const int tid = ltid(wave), wid = __builtin_amdgcn_readfirstlane(tid >> 6), lane = tid & 63, wr = wid >> 2, wc = wid & 3, fr = lane & 15, fq = lane >> 4;
    const int K = g.K, nt = K / BK;
    unsigned voffA[2], voffB[2];
#pragma unroll
    for (int i = 0; i < 2; ++i) { int R, C; stage_rc(tid * 16 + i * 8192, R, C); const int Rb = Epi::PERM ? ((R & ~31) + perm32(R & 31)) : R;
        voffA[i] = (unsigned)(R * g.lda + C) * 2u; voffB[i] = (unsigned)(Rb * g.ldb + C) * 2u; }
    const size_t kstep = (size_t)(BK * 2);
    const size_t hstepA = (size_t)HALF * g.lda * 2, hstepB = (size_t)HALF * g.ldb * 2;
    const size_t tstepA = 2 * hstepA, tstepB = 2 * hstepB;
    const unsigned ldsw = (unsigned)wid * 1024u;
    const int aoff = lds_byte(wr * 64 + fr, fq * 8), boff = lds_byte(wc * 32 + fr, fq * 8);
#define PG8_SA(b, h) (((b) * 2 + (h)) * HTB)
#define PG8_SB(b, h) ((4 + (b) * 2 + (h)) * HTB)
#define PG8_STAGE(bufoff, gbase, voff) do { _Pragma("unroll") for (int _i = 0; _i < 2; ++_i) \
        __builtin_amdgcn_global_load_lds((const unsigned*)((const char*)(gbase) + (voff)[_i]), (LAS unsigned*)(lds + (bufoff) + ldsw + _i * 8192), 16, 0, 0); } while (0)
#define PG8_LDA(dst, b, h) do { _Pragma("unroll") for (int m = 0; m < 4; ++m) _Pragma("unroll") for (int k = 0; k < 2; ++k) dst[m][k] = *(const LAS bf16x8*)(lds + PG8_SA(b, h) + aoff + m * 2048 + k * 1024); } while (0)
#define PG8_LDB(dst, b, h) do { _Pragma("unroll") for (int n = 0; n < 2; ++n) _Pragma("unroll") for (int k = 0; k < 2; ++k) dst[n][k] = *(const LAS bf16x8*)(lds + PG8_SB(b, h) + boff + n * 2048 + k * 1024); } while (0)
#define PG8_MMA(ai, bj, At, Bt) do { __builtin_amdgcn_s_setprio(1); _Pragma("unroll") for (int m = 0; m < 4; ++m) _Pragma("unroll") for (int n = 0; n < 2; ++n) _Pragma("unroll") for (int k = 0; k < 2; ++k) \
        acc[ai][bj][m][n] = __builtin_amdgcn_mfma_f32_16x16x32_bf16(Bt[n][k], At[m][k], acc[ai][bj][m][n], 0, 0, 0); __builtin_amdgcn_s_setprio(0); } while (0)
#define PG8_WAIT_V(n) asm volatile("s_waitcnt vmcnt(" #n ")" ::: "memory")
#define PG8_WAIT_L(n) asm volatile("s_waitcnt lgkmcnt(" #n ")" ::: "memory")
#define PG8_BAR __builtin_amdgcn_s_barrier()
#define PG8_SCHED __builtin_amdgcn_sched_barrier(0)
    Unit cur, nxt; int ui = 0;
    LAS int* slot = (LAS int*)(lds + 131072 + 64);
    const int xcd = (int)(hw_xcc_id() & 7u); int ticket = 0;
    auto rng_cnt = [&](int x) { const int q = S.nwg / NXCD, r = S.nwg % NXCD; return q + (x < r ? 1 : 0); };
    auto rng_start = [&](int x) { const int q = S.nwg / NXCD, r = S.nwg % NXCD; return x < r ? x * (q + 1) : r * (q + 1) + (x - r) * q; };
    auto decode = [&](int wgid, Unit& u) { const int nig = WGM * S.nN, gid = wgid / nig, fm = gid * WGM, gsz = (S.nM - fm) < WGM ? (S.nM - fm) : WGM; u.pm = fm + ((wgid % nig) % gsz); u.pn = (wgid % nig) / gsz; u.b = 0; };
    auto issue = [&]() { if (tid == 0) ticket = (int)__hip_atomic_fetch_add(ctr + xcd * 16, 1u, __ATOMIC_RELAXED, __HIP_MEMORY_SCOPE_AGENT); };
    auto publish = [&](int si) { if (tid == 0) { int wg = -1;
            if (ticket < rng_cnt(xcd)) wg = rng_start(xcd) + ticket;
            else { for (int k = 1; k < 8; ++k) { const int x2 = (xcd + k) & 7; const int t2 = (int)__hip_atomic_fetch_add(ctr + x2 * 16, 1u, __ATOMIC_RELAXED, __HIP_MEMORY_SCOPE_AGENT); if (t2 < rng_cnt(x2)) { wg = rng_start(x2) + t2; break; } } }
            slot[si] = wg; } };
    if (DYN) { issue(); publish(0); __syncthreads(); const int w0 = __builtin_amdgcn_readfirstlane(slot[0]); if (w0 < 0) return; decode(w0, cur); issue(); }
    else if (!S.next(0, cur)) return;
    f32x4 acc[2][2][4][2];
#pragma unroll
    for (int a = 0; a < 2; ++a)
#pragma unroll
        for (int b = 0; b < 2; ++b)
#pragma unroll
            for (int m = 0; m < 4; ++m)
#pragma unroll
                for (int n = 0; n < 2; ++n) acc[a][b][m][n] = (f32x4){0.f, 0.f, 0.f, 0.f};
    bf16x8 At[4][2], B0[2][2], B1[2][2];
    const char* cA = (const char*)(g.A + (size_t)cur.b * g.sA) + (size_t)cur.pm * tstepA; const char* cB = (const char*)(g.Bt + (size_t)cur.b * g.sB) + (size_t)cur.pn * tstepB;
    float pre[8];
    E.prefetch(pre, cur, wr, fr);
    PG8_STAGE(PG8_SB(0, 0), cB, voffB); PG8_STAGE(PG8_SA(0, 0), cA, voffA); PG8_STAGE(PG8_SB(0, 1), cB + hstepB, voffB); PG8_STAGE(PG8_SA(0, 1), cA + hstepA, voffA);
    if (wr == 1) PG8_BAR;
    PG8_WAIT_V(4); PG8_BAR;
    PG8_STAGE(PG8_SB(1, 0), cB + kstep, voffB); PG8_STAGE(PG8_SA(1, 0), cA + kstep, voffA); PG8_STAGE(PG8_SB(1, 1), cB + hstepB + kstep, voffB);
    PG8_WAIT_V(6); PG8_BAR;
    for (;;) {
        bool has_next = DYN ? false : S.next(ui + 1, nxt);
        const char* nA = has_next ? (const char*)(g.A + (size_t)nxt.b * g.sA) + (size_t)nxt.pm * tstepA : cA; const char* nB = has_next ? (const char*)(g.Bt + (size_t)nxt.b * g.sB) + (size_t)nxt.pn * tstepB : cB;
        for (int t = 0; t < nt; t += 2) {
            const bool last = (t == nt - 2);
            if (DYN && last) { const int nw = __builtin_amdgcn_readfirstlane(slot[(ui + 1) & 1]); has_next = nw >= 0;
                if (has_next) { decode(nw, nxt); nA = (const char*)g.A + (size_t)nxt.pm * tstepA; nB = (const char*)g.Bt + (size_t)nxt.pn * tstepB; } }
            const char* a1 = cA + (size_t)(t + 1) * kstep;
            const char* a2 = last ? nA : cA + (size_t)(t + 2) * kstep; const char* b2 = last ? nB : cB + (size_t)(t + 2) * kstep;
            const char* a3 = a2 + kstep; const char* b3 = b2 + kstep;
            PG8_LDB(B0, 0, 0); PG8_SCHED; PG8_LDA(At, 0, 0); PG8_STAGE(PG8_SA(1, 1), a1 + hstepA, voffA);
            PG8_WAIT_L(8); PG8_BAR; PG8_WAIT_L(0); PG8_MMA(0, 0, At, B0); PG8_BAR; PG8_SCHED;
            PG8_LDB(B1, 0, 1); PG8_STAGE(PG8_SB(0, 0), b2, voffB);
            PG8_BAR; PG8_WAIT_L(0); PG8_MMA(0, 1, At, B1); PG8_BAR;
            PG8_LDA(At, 0, 1); PG8_STAGE(PG8_SA(0, 0), a2, voffA);
            PG8_BAR; PG8_WAIT_L(0); PG8_MMA(1, 0, At, B0); PG8_BAR; PG8_SCHED;
            PG8_STAGE(PG8_SB(0, 1), b2 + hstepB, voffB);
            PG8_WAIT_V(6); PG8_BAR; PG8_MMA(1, 1, At, B1); PG8_BAR;
            PG8_LDB(B0, 1, 0); PG8_SCHED; PG8_LDA(At, 1, 0); PG8_STAGE(PG8_SA(0, 1), a2 + hstepA, voffA);
            PG8_WAIT_L(8); PG8_BAR; PG8_WAIT_L(0); PG8_MMA(0, 0, At, B0); PG8_BAR; PG8_SCHED;
            PG8_LDB(B1, 1, 1); PG8_STAGE(PG8_SB(1, 0), b3, voffB);
            PG8_BAR; PG8_WAIT_L(0); PG8_MMA(0, 1, At, B1); PG8_BAR;
            PG8_LDA(At, 1, 1); PG8_STAGE(PG8_SA(1, 0), a3, voffA);
            PG8_BAR; PG8_WAIT_L(0); PG8_MMA(1, 0, At, B0); PG8_BAR; PG8_SCHED;
            if (DYN && t == 0) publish((ui + 1) & 1);
            PG8_STAGE(PG8_SB(1, 1), b3 + hstepB, voffB);
            PG8_WAIT_V(6); PG8_BAR; PG8_MMA(1, 1, At, B1); PG8_BAR;
        }
        E(acc, cur, wr, wc, fr, fq, pre);
        if (!has_next) break;
#pragma unroll
        for (int a = 0; a < 2; ++a)
#pragma unroll
            for (int b = 0; b < 2; ++b)
#pragma unroll
                for (int m = 0; m < 4; ++m)
#pragma unroll
                    for (int n = 0; n < 2; ++n) acc[a][b][m][n] = (f32x4){0.f, 0.f, 0.f, 0.f};
        cur = nxt; cA = nA; cB = nB; ++ui;
        if (DYN) issue();
        E.prefetch(pre, cur, wr, fr);
    }
    PG8_WAIT_V(0);
    if (wr == 0) PG8_BAR;
    PG8_BAR;
#undef PG8_SA
#undef PG8_SB
#undef PG8_STAGE
#undef PG8_LDA
#undef PG8_LDB
#undef PG8_MMA
#undef PG8_WAIT_V
#undef PG8_WAIT_L
#undef PG8_BAR
#undef PG8_SCHED
}

#define GAS __attribute__((address_space(1)))
__device__ __forceinline__ u32x4 gld16(const void* p) { return *(const GAS u32x4*)(unsigned long long)p; }
__device__ __forceinline__ void gst16(void* p, u32x4 v) { *(GAS u32x4*)(unsigned long long)p = v; }
__device__ __forceinline__ void gst16nt(void* p, u32x4 v) { __builtin_nontemporal_store(v, (GAS u32x4*)(unsigned long long)p); }
typedef const f32x4 (&AccRef)[2][2][4][2];
__device__ __forceinline__ u32x4 pack8(f32x4 v0, f32x4 v1) { u32x4 w; w.x = cvt_pk_bf16(v0[0], v0[1]); w.y = cvt_pk_bf16(v0[2], v0[3]); w.z = cvt_pk_bf16(v1[0], v1[1]); w.w = cvt_pk_bf16(v1[2], v1[3]); return w; }
__device__ __forceinline__ void unpack8(u32x4 w, f32x4& v0, f32x4& v1) { v0 = (f32x4){bflo(w.x), bfhi(w.x), bflo(w.y), bfhi(w.y)}; v1 = (f32x4){bflo(w.z), bfhi(w.z), bflo(w.w), bfhi(w.w)}; }

struct EpiSwiglu {
    static constexpr bool PERM = true; bf16_t* O; const float* rs;
    __device__ __forceinline__ void prefetch(float (&pre)[8], const Unit& u, int wr, int fr) const {
#pragma unroll
        for (int i = 0; i < 8; ++i) pre[i] = rs[u.pm * BM + wr * 64 + fr + (i >> 2) * HALF + (i & 3) * 16]; }
    __device__ __forceinline__ void operator()(AccRef acc, const Unit& u, int wr, int wc, int fr, int fq, const float (&pre)[8]) const {
        const int row0 = u.pm * BM + wr * 64 + fr, col = u.pn * 128 + wc * 32 + 8 * fq;
#pragma unroll
        for (int ai = 0; ai < 2; ++ai)
#pragma unroll
            for (int m = 0; m < 4; ++m) {
                f32x4 v0, v1; const float r = pre[ai * 4 + m], rn = r * -1.4426950408889634f, r2 = r * r;
                { const f32x4 a0 = acc[ai][0][m][0], a1 = acc[ai][0][m][1], b0 = acc[ai][1][m][0], b1 = acc[ai][1][m][1];
                  const f32x2 o0 = swiglu2((f32x2){a0[0], a0[1]}, (f32x2){b0[0], b0[1]}, rn, r2), o1 = swiglu2((f32x2){a0[2], a0[3]}, (f32x2){b0[2], b0[3]}, rn, r2);
                  const f32x2 o2 = swiglu2((f32x2){a1[0], a1[1]}, (f32x2){b1[0], b1[1]}, rn, r2), o3 = swiglu2((f32x2){a1[2], a1[3]}, (f32x2){b1[2], b1[3]}, rn, r2);
                  v0 = (f32x4){o0.x, o0.y, o1.x, o1.y}; v1 = (f32x4){o2.x, o2.y, o3.x, o3.y}; }
                gst16nt(O + (size_t)(row0 + ai * HALF + m * 16) * DFF + col, pack8(v0, v1));
            }
    }
};
struct EpiBf16 {
    static constexpr bool PERM = true; bf16_t* O; int ldc;
    __device__ __forceinline__ void prefetch(float (&pre)[8], const Unit&, int, int) const {
#pragma unroll
        for (int i = 0; i < 8; ++i) pre[i] = 0.f; }
    __device__ __forceinline__ void operator()(AccRef acc, const Unit& u, int wr, int wc, int fr, int fq, const float (&pre)[8]) const {
        const int row0 = u.pm * BM + wr * 64 + fr, col0 = u.pn * BM + wc * 32 + 8 * fq;
#pragma unroll
        for (int ai = 0; ai < 2; ++ai)
#pragma unroll
            for (int m = 0; m < 4; ++m)
#pragma unroll
                for (int bj = 0; bj < 2; ++bj)
                    gst16(O + (size_t)(row0 + ai * HALF + m * 16) * ldc + col0 + bj * HALF, pack8(acc[ai][bj][m][0], acc[ai][bj][m][1]));
    }
};
struct EpiWin {
    static constexpr bool PERM = true; unsigned char* ws; const float* rs;
    __device__ __forceinline__ void prefetch(float (&pre)[8], const Unit& u, int wr, int fr) const {
#pragma unroll
        for (int i = 0; i < 8; ++i) pre[i] = rs[u.pm * BM + wr * 64 + fr + (i >> 2) * HALF + (i & 3) * 16]; }
    __device__ __forceinline__ void operator()(AccRef acc, const Unit& u, int wr, int wc, int fr, int fq, const float (&pre)[8]) const {
        const int pn = u.pn; int act, ld, cb; size_t base;
        if (pn < 4) { act = 0; ld = 1024; cb = pn * 256; base = B_XL; }
        else if (pn < 8) { act = 1; ld = 1024; cb = (pn - 4) * 256; base = B_GL; }
        else if (pn < 12) { act = 2; ld = 0; cb = (pn - 8) * 256; base = B_A2; }
        else if (pn < 18) { act = 3; ld = 1536; cb = (pn - 12) * 256; base = B_Q; }
        else if (pn < 24) { act = 0; ld = 1536; cb = (pn - 18) * 256; base = B_K; }
        else if (pn < 30) { act = 0; ld = 1536; cb = (pn - 24) * 256; base = B_V; }
        else if (pn < 38) { act = 4; ld = 2048; cb = (pn - 30) * 256; base = B_GA; }
        else if (pn < 46) { act = 4; ld = 2048; cb = (pn - 38) * 256; base = B_GB; }
        else { act = 4; ld = 2048; cb = (pn - 46) * 256; base = B_GC; }
        bf16_t* O = (bf16_t*)(ws + base);
        const int row0 = u.pm * BM + wr * 64 + fr, col0 = cb + wc * 32 + 8 * fq;
#pragma unroll
        for (int ai = 0; ai < 2; ++ai)
#pragma unroll
            for (int m = 0; m < 4; ++m)
#pragma unroll
                for (int bj = 0; bj < 2; ++bj) {
                    const int row = row0 + ai * HALF + m * 16, col = col0 + bj * HALF;
                    const float r = pre[ai * 4 + m]; f32x4 v0 = acc[ai][bj][m][0], v1 = acc[ai][bj][m][1];
                    if (act == 1) { v0 *= r; v1 *= r;
                        const f32x2 o0 = gelu2((f32x2){v0[0], v0[1]}), o1 = gelu2((f32x2){v0[2], v0[3]}), o2 = gelu2((f32x2){v1[0], v1[1]}), o3 = gelu2((f32x2){v1[2], v1[3]});
                        v0 = (f32x4){o0.x, o0.y, o1.x, o1.y}; v1 = (f32x4){o2.x, o2.y, o3.x, o3.y}; }
                    else if (act == 4) { const float rn = r * -1.4426950408889634f;
                        const f32x2 o0 = sigm2((f32x2){v0[0], v0[1]}, rn), o1 = sigm2((f32x2){v0[2], v0[3]}, rn), o2 = sigm2((f32x2){v1[0], v1[1]}, rn), o3 = sigm2((f32x2){v1[2], v1[3]}, rn);
                        v0 = (f32x4){o0.x, o0.y, o1.x, o1.y}; v1 = (f32x4){o2.x, o2.y, o3.x, o3.y}; }
                    else { const float rr = act == 3 ? r * 0.125f : r; v0 *= rr; v1 *= rr; }
                    size_t off;
                    if (act == 2) off = ((size_t)(col >> 4) * NSUB + (row >> 4)) * 512 + (row & 15) * 16 + (col & 15);
                    else off = (size_t)row * ld + col;
                    gst16nt(O + off, pack8(v0, v1));
                }
    }
};
struct EpiS {
    static constexpr bool PERM = false; float* S;
    __device__ __forceinline__ void prefetch(float (&pre)[8], const Unit&, int, int) const {
#pragma unroll
        for (int i = 0; i < 8; ++i) pre[i] = 0.f; }
    __device__ __forceinline__ void operator()(AccRef acc, const Unit& u, int wr, int wc, int fr, int fq, const float (&pre)[8]) const {
        const int row0 = u.pm * BM + wr * 64 + fr, col0 = wc * 32 + 4 * fq;
        float* base = S + (size_t)u.b * NSUB * 256;
#pragma unroll
        for (int ai = 0; ai < 2; ++ai)
#pragma unroll
            for (int m = 0; m < 4; ++m)
#pragma unroll
                for (int bj = 0; bj < 2; ++bj)
#pragma unroll
                    for (int n = 0; n < 2; ++n)
                        *(f32x4*)(base + (size_t)(row0 + ai * HALF + m * 16) * 256 + col0 + bj * HALF + n * 16) = acc[ai][bj][m][n];
    }
};
struct EpiY {
    static constexpr bool PERM = true; bf16_t* Y1;
    __device__ __forceinline__ void prefetch(float (&pre)[8], const Unit&, int, int) const {
#pragma unroll
        for (int i = 0; i < 8; ++i) pre[i] = 0.f; }
    __device__ __forceinline__ void operator()(AccRef acc, const Unit& u, int wr, int wc, int fr, int fq, const float (&pre)[8]) const {
        const int row0 = u.pm * BM + wr * 64 + fr, n0 = wc * 32 + 8 * fq;
#pragma unroll
        for (int ai = 0; ai < 2; ++ai)
#pragma unroll
            for (int m = 0; m < 4; ++m)
#pragma unroll
                for (int bj = 0; bj < 2; ++bj) {
                    const int j = row0 + ai * HALF + m * 16, nn = n0 + bj * HALF, tok = j * 16 + (nn >> 4);
                    f32x4 v0 = acc[ai][bj][m][0], v1 = acc[ai][bj][m][1];
#pragma unroll
                    for (int q = 0; q < 4; ++q) { v0[q] = gelu_t(v0[q]); v1[q] = gelu_t(v1[q]); }
                    gst16(Y1 + (size_t)tok * 1024 + u.b * 16 + (nn & 15), pack8(v0, v1));
                }
    }
};
struct EpiGlu {
    static constexpr bool PERM = true; const bf16_t* Y1; bf16_t* O; const float* bias;
    __device__ __forceinline__ void prefetch(float (&pre)[8], const Unit&, int, int) const {
#pragma unroll
        for (int i = 0; i < 8; ++i) pre[i] = 0.f; }
    __device__ __forceinline__ void operator()(AccRef acc, const Unit& u, int wr, int wc, int fr, int fq, const float (&pre)[8]) const {
        const int row0 = u.pm * BM + wr * 64 + fr, col0 = u.pn * BM + wc * 32 + 8 * fq;
        f32x4 bv[2][2];
#pragma unroll
        for (int bj = 0; bj < 2; ++bj) { bv[bj][0] = *(const GAS f32x4*)(unsigned long long)(bias + col0 + bj * HALF); bv[bj][1] = *(const GAS f32x4*)(unsigned long long)(bias + col0 + bj * HALF + 4); }
#pragma unroll
        for (int ai = 0; ai < 2; ++ai) {
            u32x4 yv[4][2];
#pragma unroll
            for (int m = 0; m < 4; ++m)
#pragma unroll
                for (int bj = 0; bj < 2; ++bj) yv[m][bj] = gld16(Y1 + (size_t)(row0 + ai * HALF + m * 16) * 1024 + col0 + bj * HALF);
#pragma unroll
            for (int m = 0; m < 4; ++m)
#pragma unroll
                for (int bj = 0; bj < 2; ++bj) {
                    f32x4 y0, y1v; unpack8(yv[m][bj], y0, y1v);
                    f32x4 v0 = acc[ai][bj][m][0] + bv[bj][0], v1 = acc[ai][bj][m][1] + bv[bj][1];
#pragma unroll
                    for (int q = 0; q < 4; ++q) { v0[q] = y0[q] * sigm(v0[q]); v1[q] = y1v[q] * sigm(v1[q]); }
                    gst16(O + (size_t)(row0 + ai * HALF + m * 16) * 1024 + col0 + bj * HALF, pack8(v0, v1));
                }
        }
    }
};
template <bool FIRST> struct EpiMerge {
    static constexpr bool PERM = true; const bf16_t* Gt; bf16_t* Mo;
    __device__ __forceinline__ void prefetch(float (&pre)[8], const Unit&, int, int) const {
#pragma unroll
        for (int i = 0; i < 8; ++i) pre[i] = 0.f; }
    __device__ __forceinline__ void operator()(AccRef acc, const Unit& u, int wr, int wc, int fr, int fq, const float (&pre)[8]) const {
        const int row0 = u.pm * BM + wr * 64 + fr, col0 = u.pn * BM + wc * 32 + 8 * fq;
#pragma unroll
        for (int ai = 0; ai < 2; ++ai) {
            u32x4 gv[4][2], mv[4][2];
#pragma unroll
            for (int m = 0; m < 4; ++m)
#pragma unroll
                for (int bj = 0; bj < 2; ++bj) { const size_t off = (size_t)(row0 + ai * HALF + m * 16) * 2048 + col0 + bj * HALF;
                    gv[m][bj] = gld16(Gt + off); mv[m][bj] = FIRST ? (u32x4){0u, 0u, 0u, 0u} : gld16(Mo + off); }
#pragma unroll
            for (int m = 0; m < 4; ++m)
#pragma unroll
                for (int bj = 0; bj < 2; ++bj) { const size_t off = (size_t)(row0 + ai * HALF + m * 16) * 2048 + col0 + bj * HALF;
                    f32x4 g0, g1; unpack8(gv[m][bj], g0, g1);
                    f32x4 v0 = g0 * acc[ai][bj][m][0], v1 = g1 * acc[ai][bj][m][1];
                    if (!FIRST) { f32x4 p0, p1; unpack8(mv[m][bj], p0, p1); v0 += p0; v1 += p1; }
                    gst16(Mo + off, pack8(v0, v1)); }
        }
    }
};

__device__ __forceinline__ void cvt_tile(unsigned char* shm, int tid, const float* src, bf16_t* dst, int K, int N, int mode, const float* kscale, int ldd, int t) {
    bf16_t* T = (bf16_t*)shm;
    const int nnt = N / 256, nti = t % nnt, kt = t / nnt;
    { const int k = tid >> 3, n8 = (tid & 7) * 8;
      const float* s = src + (size_t)(kt * 64 + k) * N + nti * 256 + n8; const float ks = kscale ? kscale[kt * 64 + k] : 1.0f;
      f32x4 v[8];
#pragma unroll
      for (int q = 0; q < 4; ++q) { v[2 * q] = *(const f32x4*)(s + q * 64); v[2 * q + 1] = *(const f32x4*)(s + q * 64 + 4); }
      asm volatile("" ::: "memory");
#pragma unroll
      for (int q = 0; q < 4; ++q)
#pragma unroll
          for (int j = 0; j < 4; ++j) { T[(q * 64 + n8 + j) * 72 + k] = f2bf(v[2 * q][j] * ks); T[(q * 64 + n8 + 4 + j) * 72 + k] = f2bf(v[2 * q + 1][j] * ks); } }
    __syncthreads();
#pragma unroll
    for (int q = 0; q < 4; ++q) { const int n = q * 64 + (tid >> 3), k8 = (tid & 7) * 8; const int nn = nti * 256 + n;
      const int drow = mode == 0 ? nn : ((nn >> 7) * 256 + (nn & 127) + (mode == 2 ? 128 : 0));
      *(u32x4*)(dst + (size_t)drow * ldd + kt * 64 + k8) = *(const u32x4*)(T + n * 72 + k8); }
    __syncthreads();
}
__device__ __forceinline__ void cvt_ffn_tile(const Params& p, unsigned char* shm, int tid, bf16_t* W, int l, int sub, int t) {
    const size_t wo = (size_t)(l * 2 + sub) * DM * DFF; const float* gk = p.in[2] + (l * 6 + (sub ? 4 : 0)) * DM;
    if (t < 704) cvt_tile(shm, tid, p.in[26] + wo, W + W_13, DM, DFF, 1, gk, LDX, t);
    else if (t < 1408) cvt_tile(shm, tid, p.in[27] + wo, W + W_13, DM, DFF, 2, gk, LDX, t - 704);
    else cvt_tile(shm, tid, p.in[28] + wo, W + W_2, DFF, DM, 0, nullptr, DFF, t - 1408);
}
__device__ __forceinline__ void cvt_mixer_tile(const Params& p, unsigned char* shm, int tid, bf16_t* W, int l, int t) {
    if (t < 1728) cvt_tile(shm, tid, p.in[3] + (size_t)l * DM * 13824, W + W_IN, DM, 13824, 0, p.in[2] + (l * 6 + 2) * DM, LDX, t);
    else if (t < 1792) cvt_tile(shm, tid, p.in[19] + (size_t)l * 1024 * 1024, W + W_GLU, 1024, 1024, 0, nullptr, 1024, t - 1728);
    else if (t < 1920) cvt_tile(shm, tid, p.in[22] + (size_t)l * 1024 * DM, W + W_BRL, 1024, DM, 0, nullptr, 1024, t - 1792);
    else if (t < 2048) cvt_tile(shm, tid, p.in[23] + (size_t)l * 1024 * DM, W + W_BRS, 1024, DM, 0, nullptr, 1024, t - 1920);
    else if (t < 2112) cvt_tile(shm, tid, p.in[24] + (size_t)l * 512 * DM, W + W_BRA, 512, DM, 0, nullptr, 512, t - 2048);
    else cvt_tile(shm, tid, p.in[25] + (size_t)l * DM * DM, W + W_OUT, DM, DM, 0, nullptr, DM, t - 2112);
}
constexpr int CVT_FFN_TILES = 2112, CVT_MIXER_TILES = 2368;
__device__ void cvt_set(const Params& p, unsigned char* shm, bf16_t* W, int l, int sub  , unsigned* ctr) {
    const int tid = ltid(p.wave), total = sub == 1 ? CVT_MIXER_TILES : CVT_FFN_TILES;
    volatile int* tk = (volatile int*)(shm + 131072 + 128);
    if (ctr == nullptr) {
        for (int t = lbid(); t < total; t += gridDim.x) { if (sub == 1) cvt_mixer_tile(p, shm, tid, W, l, t); else cvt_ffn_tile(p, shm, tid, W, l, sub == 2 ? 1 : 0, t); }
        return;
    }
    for (;;) {
        if (tid == 0) *tk = (int)__hip_atomic_fetch_add(ctr, 1u, __ATOMIC_RELAXED, __HIP_MEMORY_SCOPE_AGENT);
        __syncthreads();
        const int t = __builtin_amdgcn_readfirstlane(*tk);
        __syncthreads();
        if (t >= total) break;
        if (sub == 1) cvt_mixer_tile(p, shm, tid, W, l, t); else cvt_ffn_tile(p, shm, tid, W, l, sub == 2 ? 1 : 0, t);
    }
}

__device__ void norm_rows(const Params& p, int mode, float scale, const float* gpost) {
    const int tid = ltid(p.wave), bid = lbid(), lane = tid & 63, wid = tid >> 6;
    bf16_t* X = (bf16_t*)(p.ws + WS_H); const bf16_t* Y = (const bf16_t*)(p.ws + B_Y); float* RS = (float*)(p.ws + SM_RS);
    for (int row = bid * 8 + wid; row < MT; row += gridDim.x * 8) {
        f32x4 xv[8];
        if (mode == 0) {
            const float* xr = row < 8192 ? p.in[0] + (size_t)row * DM : p.in[1] + (size_t)(row - 8192) * DM;
#pragma unroll
            for (int c = 0; c < 4; ++c) { xv[2 * c] = *(const f32x4*)(xr + (c * 64 + lane) * 8); xv[2 * c + 1] = *(const f32x4*)(xr + (c * 64 + lane) * 8 + 4); }
            asm volatile("" ::: "memory");
        } else {
            f32x4 yv[8]; float ss = 0.f; u32x4 xw[4], yw[4]; f32x4 gq[8];
#pragma unroll
            for (int c = 0; c < 4; ++c) { xw[c] = *(const u32x4*)(X + (size_t)row * LDX + (c * 64 + lane) * 8); yw[c] = *(const u32x4*)(Y + (size_t)row * DM + (c * 64 + lane) * 8); }
#pragma unroll
            for (int c = 0; c < 4; ++c) { gq[2 * c] = *(const f32x4*)(gpost + (c * 64 + lane) * 8); gq[2 * c + 1] = *(const f32x4*)(gpost + (c * 64 + lane) * 8 + 4); }
            asm volatile("" ::: "memory");
#pragma unroll
            for (int c = 0; c < 4; ++c) { unpack8(xw[c], xv[2 * c], xv[2 * c + 1]); unpack8(yw[c], yv[2 * c], yv[2 * c + 1]); }
#pragma unroll
            for (int c = 0; c < 8; ++c) ss += yv[c][0] * yv[c][0] + yv[c][1] * yv[c][1] + yv[c][2] * yv[c][2] + yv[c][3] * yv[c][3];
            ss = wave_sum(ss);
            const float rs = rsqrtf(ss * (1.0f / DM) + RMS_EPS) * scale;
#pragma unroll
            for (int c = 0; c < 4; ++c) { xv[2 * c] += yv[2 * c] * gq[2 * c] * rs; xv[2 * c + 1] += yv[2 * c + 1] * gq[2 * c + 1] * rs; }
        }
        if (mode == 2) {
#pragma unroll
            for (int c = 0; c < 4; ++c) { *(f32x4*)(p.out + (size_t)row * DM + (c * 64 + lane) * 8) = xv[2 * c]; *(f32x4*)(p.out + (size_t)row * DM + (c * 64 + lane) * 8 + 4) = xv[2 * c + 1]; }
        } else {
            float ss = 0.f;
#pragma unroll
            for (int c = 0; c < 8; ++c) ss += xv[c][0] * xv[c][0] + xv[c][1] * xv[c][1] + xv[c][2] * xv[c][2] + xv[c][3] * xv[c][3];
            ss = wave_sum(ss);
#pragma unroll
            for (int c = 0; c < 4; ++c) *(u32x4*)(X + (size_t)row * LDX + (c * 64 + lane) * 8) = pack8(xv[2 * c], xv[2 * c + 1]);
            if (lane == 0) RS[row] = rsqrtf(ss * (1.0f / DM) + RMS_EPS);
        }
    }
}

__device__ void s5_stage1(const Params& p, int l) {
    float2* Apow = (float2*)(p.ws + SM_APOW); float2* Bbar = (float2*)(p.ws + SM_BBAR);
    for (int idx = lbid() * 512 + ltid(p.wave); idx < 8192; idx += gridDim.x * 512) {
        const float lr = p.in[11][l * 8192 + idx], li = p.in[12][l * 8192 + idx], dt = expf(p.in[13][l * 128 + (idx >> 6)]);
        f32x4 br4[4], bi4[4];
#pragma unroll
        for (int c = 0; c < 4; ++c) { br4[c] = *(const f32x4*)(p.in[14] + (size_t)l * 131072 + idx * 16 + c * 4); bi4[c] = *(const f32x4*)(p.in[15] + (size_t)l * 131072 + idx * 16 + c * 4); }
        asm volatile("" ::: "memory");
        float ar = 1.f, ai = 0.f;
        for (int k = 0; k < 18; ++k) { const float mag = expf((float)k * lr * dt); float s, c; sincosf((float)k * li * dt, &s, &c); Apow[idx * 18 + k] = make_float2(mag * c, mag * s); if (k == 1) { ar = mag * c; ai = mag * s; } }
        const float den = lr * lr + li * li, cr = ((ar - 1.0f) * lr + ai * li) / den, ci = (ai * lr - (ar - 1.0f) * li) / den;
#pragma unroll
        for (int c = 0; c < 16; ++c) { const float br = br4[c >> 2][c & 3], bi = bi4[c >> 2][c & 3];
            Bbar[idx * 16 + c] = make_float2(cr * br - ci * bi, cr * bi + ci * br); }
    }
}
__device__ void s5_stage2(const Params& p, int l) {
    const float2* Apow = (const float2*)(p.ws + SM_APOW); const float2* Bbar = (const float2*)(p.ws + SM_BBAR);
    float* Kd = (float*)(p.ws + SM_KD); bf16_t* Gm = (bf16_t*)(p.ws + SM_G); bf16_t* Ym = (bf16_t*)(p.ws + SM_Y); bf16_t* LWT = (bf16_t*)(p.ws + SM_LWT);
    const float* cre = p.in[16] + (size_t)l * 131072; const float* cim = p.in[17] + (size_t)l * 131072;
    const int gs = gridDim.x * 512, t0 = lbid() * 512 + ltid(p.wave);
    for (int o = t0; o < 524288; o += gs) {
        const int c2 = o & 15, c = (o >> 4) & 15, k = (o >> 8) & 15, dg = o >> 12;
        float acc = 0.f;
        for (int p0 = 0; p0 < 64; p0 += 8) {
            float2 A[8], Bb[8]; float Cr[8], Ci[8];
#pragma unroll
            for (int q = 0; q < 8; ++q) { const int sidx = dg * 64 + p0 + q; A[q] = Apow[sidx * 18 + k]; Bb[q] = Bbar[sidx * 16 + c2]; Cr[q] = cre[(dg * 16 + c) * 64 + p0 + q]; Ci[q] = cim[(dg * 16 + c) * 64 + p0 + q]; }
            asm volatile("" ::: "memory");
#pragma unroll
            for (int q = 0; q < 8; ++q) { const float abr = A[q].x * Bb[q].x - A[q].y * Bb[q].y, abi = A[q].x * Bb[q].y + A[q].y * Bb[q].x; acc += Cr[q] * abr - Ci[q] * abi; }
        }
        Kd[o] = acc;
    }
    for (int ob = t0; ob < 64 * 65536; ob += 4 * gs) {
        float2 A1[4], B1[4], A2v[4]; float Cr[4], Ci[4];
#pragma unroll
        for (int q = 0; q < 4; ++q) { const int o = min(ob + q * gs, 64 * 65536 - 1); const int kk = o & 255, n = (o >> 8) & 255, g = o >> 16;
            { const int d = n >> 7, pp = n & 63, s = kk >> 4, c2 = kk & 15, e = d == 0 ? 15 - s : s; const int sidx = (d * 64 + g) * 64 + pp; A1[q] = Apow[sidx * 18 + e]; B1[q] = Bbar[sidx * 16 + c2]; }
            { const int tau = n >> 4, c = n & 15, d = kk >> 7, pp = kk & 63, e = d == 0 ? tau + 1 : 16 - tau; const int sidx = (d * 64 + g) * 64 + pp;
              A2v[q] = Apow[sidx * 18 + e]; Cr[q] = cre[((d * 64 + g) * 16 + c) * 64 + pp]; Ci[q] = cim[((d * 64 + g) * 16 + c) * 64 + pp]; } }
        asm volatile("" ::: "memory");
#pragma unroll
        for (int q = 0; q < 4; ++q) { const int o = ob + q * gs; if (o >= 64 * 65536) break; const int kk = o & 255, n = (o >> 8) & 255, g = o >> 16;
            Gm[o] = f2bf(((n >> 6) & 1) ? A1[q].x * B1[q].y + A1[q].y * B1[q].x : A1[q].x * B1[q].x - A1[q].y * B1[q].y);
            Ym[((size_t)g * 256 + n) * 512 + 256 + kk] = f2bf(((kk >> 6) & 1) ? -(Cr[q] * A2v[q].y + Ci[q] * A2v[q].x) : Cr[q] * A2v[q].x - Ci[q] * A2v[q].y); }
    }
    for (int o = t0; o < 262144; o += gs) {
        const int i = o & 63, j = (o >> 6) & 63, n = (o >> 12) & 15, gate = (o >> 16) & 1, d = o >> 17;
        const float* src = gate ? p.in[8] : p.in[6];
        LWT[o] = f2bf(src[(size_t)((l * 2 + d) * 16 + n) * 4096 + i * 64 + j]);
    }
}
__device__ void s5_stage3(const Params& p, int l) {
    const float* Kd = (const float*)(p.ws + SM_KD); bf16_t* Ym = (bf16_t*)(p.ws + SM_Y); const float* Dk = p.in[18] + l * 1024;
    const int gs = gridDim.x * 512;
    for (int ob = lbid() * 512 + ltid(p.wave); ob < 64 * 65536; ob += 4 * gs) {
        float kf[4], kr[4], dd[4];
#pragma unroll
        for (int q = 0; q < 4; ++q) { const int o = min(ob + q * gs, 64 * 65536 - 1); const int kk = o & 255, n = (o >> 8) & 255, g = o >> 16, s = kk >> 4, c2 = kk & 15, tau = n >> 4, c = n & 15;
            const int df = s <= tau ? tau - s : 0, dr = s >= tau ? s - tau : 0;
            kf[q] = Kd[((0 * 64 + g) * 16 + df) * 256 + c * 16 + c2]; kr[q] = Kd[((1 * 64 + g) * 16 + dr) * 256 + c * 16 + c2]; dd[q] = Dk[g * 16 + c]; }
        asm volatile("" ::: "memory");
#pragma unroll
        for (int q = 0; q < 4; ++q) { const int o = ob + q * gs; if (o >= 64 * 65536) break; const int kk = o & 255, n = (o >> 8) & 255, g = o >> 16, s = kk >> 4, c2 = kk & 15, tau = n >> 4, c = n & 15;
            float v = 0.f; if (s <= tau) v += kf[q]; if (s >= tau) v += kr[q]; if (s == tau && c == c2) v += dd[q];
            Ym[((size_t)g * 256 + n) * 512 + kk] = f2bf(v); }
    }
}
__device__ void s5_bscan(const Params& p, unsigned char* shm) {
    const float2* Apow = (const float2*)(p.ws + SM_APOW); const float* S = (const float*)((const unsigned char*)p.out + O_S); bf16_t* A2 = (bf16_t*)(p.ws + B_A2);
    float2* Es = (float2*)shm;
    const int tid = ltid(p.wave);
    for (int it = lbid(); it < 192; it += gridDim.x) {
        const bool lng = it < 128;
        const int pp = tid & 63, g = lng ? it >> 1 : it - 128, d = lng ? (it & 1) : ((tid >> 6) & 1), seg = lng ? tid >> 6 : 0, seq = lng ? 4 : tid >> 7;
        const int j0 = lng ? 512 + seg * 128 : seq * 128;
        const float2 A16 = Apow[((d * 64 + g) * 64 + pp) * 18 + 16];
        const float* Sg = S + (size_t)g * NSUB * 256 + d * 128 + pp; bf16_t* Xg = A2 + (size_t)g * NSUB * 512 + 256 + d * 128 + pp;
        float xr = 0.f, xi = 0.f;
        if (lng) {
            for (int jb = 0; jb < 128; jb += 16) {
                float sr[16], si[16];
#pragma unroll
                for (int u = 0; u < 16; ++u) { const int j = d ? (j0 + 127 - (jb + u)) : (j0 + jb + u); sr[u] = Sg[(size_t)j * 256]; si[u] = Sg[(size_t)j * 256 + 64]; }
                asm volatile("" ::: "memory");
#pragma unroll
                for (int u = 0; u < 16; ++u) { const float nr = A16.x * xr - A16.y * xi + sr[u], ni = A16.x * xi + A16.y * xr + si[u]; xr = nr; xi = ni; }
            }
            Es[seg * 64 + pp] = make_float2(xr, xi);
            float2 Ab = A16;
#pragma unroll
            for (int q = 0; q < 7; ++q) Ab = make_float2(Ab.x * Ab.x - Ab.y * Ab.y, 2.0f * Ab.x * Ab.y);
            __syncthreads();
            xr = 0.f; xi = 0.f;
            for (int q = 0; q < 8; ++q) { const int sq = d ? 7 - q : q; const bool use = d ? (sq > seg) : (sq < seg);
                if (use) { const float2 E = Es[sq * 64 + pp]; const float nr = Ab.x * xr - Ab.y * xi + E.x, ni = Ab.x * xi + Ab.y * xr + E.y; xr = nr; xi = ni; } }
        }
        for (int jb = 0; jb < 128; jb += 16) {
            float sr[16], si[16];
#pragma unroll
            for (int u = 0; u < 16; ++u) { const int j = d ? (j0 + 127 - (jb + u)) : (j0 + jb + u); sr[u] = Sg[(size_t)j * 256]; si[u] = Sg[(size_t)j * 256 + 64]; }
            asm volatile("" ::: "memory");
#pragma unroll
            for (int u = 0; u < 16; ++u) { const int j = d ? (j0 + 127 - (jb + u)) : (j0 + jb + u);
                Xg[(size_t)j * 512] = f2bf(xr); Xg[(size_t)j * 512 + 64] = f2bf(xi);
                const float nr = A16.x * xr - A16.y * xi + sr[u], ni = A16.x * xi + A16.y * xr + si[u]; xr = nr; xi = ni; }
        }
        __syncthreads();
    }
}

template <int PASS>
__device__ void lru_items(const Params& p, unsigned char* shm, int l) {
    bf16_t* xraw = (bf16_t*)shm;
    float* xcf = (float*)(shm + 8704);
    bf16_t* xcb = (bf16_t*)(shm + 25344);
    bf16_t* wt = (bf16_t*)(shm + 34560);
    float* As = (float*)(shm + 71424);
    float* Bs = (float*)(shm + 104192);
    float* Pq = (float*)(shm + 136960);
    float* Hq = (float*)(shm + 139008);
    const bf16_t* XL = (const bf16_t*)(p.ws + B_XL); bf16_t* GL = (bf16_t*)(p.ws + B_GL); const bf16_t* LWT = (const bf16_t*)(p.ws + SM_LWT);
    float* SA = (float*)(p.ws + SM_SA); float* SH = (float*)(p.ws + SM_SH); const float* CIN = (const float*)(p.ws + SM_CIN);
    const float* cw = p.in[4] + l * 4096; const float* cbias = p.in[5] + l * 1024;
    const int tid = ltid(p.wave), lane = tid & 63, w = tid >> 6, fr = lane & 15, fq = lane >> 4, G_ = gridDim.x, total = NCHK * 16;
    int n_loaded = -1;
    float c0 = 0.f, c1 = 0.f, c2 = 0.f, c3 = 0.f, cb = 0.f, gba[4], gbx[4], gsp[4];
#pragma unroll
    for (int jt = 0; jt < 4; ++jt) { gba[jt] = 0.f; gbx[jt] = 0.f; gsp[jt] = 0.f; }
    u32x4 xr0 = (u32x4){0u, 0u, 0u, 0u}, xr1 = (u32x4){0u, 0u, 0u, 0u};
#define LRU_LOAD(IT) do { const int ck_ = (IT) >> 4, n_ = (IT) & 15, t0_ = ck_ * 64; const int ss_ = t0_ < 8192 ? (t0_ & ~2047) : 8192, se_ = t0_ < 8192 ? ss_ + 2048 : MT; \
        { const int row = tid >> 3, c8 = tid & 7, tok = t0_ - 2 + row; xr0 = (u32x4){0u, 0u, 0u, 0u}; if (tok >= ss_ && tok < se_) xr0 = *(const u32x4*)(XL + (size_t)tok * 1024 + n_ * 64 + c8 * 8); } \
        if (tid < 24) { const int row = 64 + (tid >> 3), c8 = tid & 7, tok = t0_ - 2 + row; xr1 = (u32x4){0u, 0u, 0u, 0u}; if (tok >= ss_ && tok < se_) xr1 = *(const u32x4*)(XL + (size_t)tok * 1024 + n_ * 64 + c8 * 8); } } while (0)
    int it = lbid();
    if (it < total) LRU_LOAD(it);
    for (; it < total; it += G_) {
        const int ck = it >> 4, n = it & 15, t0 = ck * 64;
        *(u32x4*)(xraw + (tid >> 3) * 64 + (tid & 7) * 8) = xr0;
        if (tid < 24) *(u32x4*)(xraw + (64 + (tid >> 3)) * 64 + (tid & 7) * 8) = xr1;
        if (n != n_loaded) {
            n_loaded = n;
#pragma unroll
            for (int i = 0; i < 4; ++i) { const int e = tid + 512 * i, mtx = e >> 9, rem = e & 511, j = rem >> 3, c8 = rem & 7;
                *(u32x4*)(wt + (mtx * 64 + j) * 72 + c8 * 8) = *(const u32x4*)(LWT + ((size_t)(mtx * 16 + n) * 64 + j) * 64 + c8 * 8); }
            { const int ch = n * 64 + (tid & 63); c0 = cw[ch]; c1 = cw[1024 + ch]; c2 = cw[2048 + ch]; c3 = cw[3072 + ch]; cb = cbias[ch]; }
#pragma unroll
            for (int jt = 0; jt < 4; ++jt) { const int pi = (l * 2 + (w >> 2)) * 1024 + n * 64 + jt * 16 + fr; gba[jt] = p.in[7][pi]; gbx[jt] = p.in[9][pi]; gsp[jt] = -8.0f * log1pf(__expf(-p.in[10][pi])); }
        }
        u32x4 glv = (u32x4){0u, 0u, 0u, 0u}; float cin = 0.f;
        const size_t go = (size_t)(t0 + (tid >> 3)) * 1024 + n * 64 + (tid & 7) * 8;
        const size_t so = (size_t)(ck * 2 + ((tid >> 6) & 1)) * 1024 + n * 64 + (tid & 63);
        if (PASS == 1) { glv = *(const u32x4*)(GL + go); cin = CIN[so]; }
        asm volatile("" ::: "memory");
        __syncthreads();
        if (it + G_ < total) LRU_LOAD(it + G_);
        asm volatile("" ::: "memory");
        { const int j = tid & 63;
#pragma unroll
          for (int i = 0; i < 8; ++i) { const int t = (tid >> 6) + 8 * i;
              const float v = cb + bf2f(xraw[t * 64 + j]) * c0 + bf2f(xraw[(t + 1) * 64 + j]) * c1 + bf2f(xraw[(t + 2) * 64 + j]) * c2 + bf2f(xraw[(t + 3) * 64 + j]) * c3;
              xcf[t * 65 + j] = v; xcb[t * 72 + j] = f2bf(v); } }
        __syncthreads();
        { const int d = w >> 2, tt = w & 3;
          const bf16x8 a0 = *(const bf16x8*)(xcb + (tt * 16 + fr) * 72 + fq * 8), a1 = *(const bf16x8*)(xcb + (tt * 16 + fr) * 72 + 32 + fq * 8);
#pragma unroll
          for (int jt = 0; jt < 4; ++jt) {
              f32x4 accr = (f32x4){0.f, 0.f, 0.f, 0.f}, acci = (f32x4){0.f, 0.f, 0.f, 0.f};
              const bf16_t* wr_ = wt + ((d * 2 + 0) * 64 + jt * 16 + fr) * 72 + fq * 8; const bf16_t* wi_ = wt + ((d * 2 + 1) * 64 + jt * 16 + fr) * 72 + fq * 8;
              accr = __builtin_amdgcn_mfma_f32_16x16x32_bf16(a0, *(const bf16x8*)wr_, accr, 0, 0, 0);
              accr = __builtin_amdgcn_mfma_f32_16x16x32_bf16(a1, *(const bf16x8*)(wr_ + 32), accr, 0, 0, 0);
              acci = __builtin_amdgcn_mfma_f32_16x16x32_bf16(a0, *(const bf16x8*)wi_, acci, 0, 0, 0);
              acci = __builtin_amdgcn_mfma_f32_16x16x32_bf16(a1, *(const bf16x8*)(wi_ + 32), acci, 0, 0, 0);
              const int j = jt * 16 + fr;
#pragma unroll
              for (int i = 0; i < 4; ++i) { const int t = tt * 16 + fq * 4 + i;
                  const float r = sigm(accr[i] + gba[jt]), ig = sigm(acci[i] + gbx[jt]), a = __expf(r * gsp[jt]);
                  As[(d * 64 + t) * 64 + j] = a;
                  Bs[(d * 64 + t) * 64 + j] = sqrtf(fmaxf(1.0f - a * a, 0.f)) * ig * xcf[t * 65 + j]; }
          } }
        __syncthreads();
        {
            const int seg = tid >> 7, d = (tid >> 6) & 1, j = tid & 63;
            float h = 0.f, P = 1.f;
#pragma unroll
            for (int s = 0; s < 16; ++s) { const int st = seg * 16 + s, t = d ? 63 - st : st; const float a = As[(d * 64 + t) * 64 + j]; h = a * h + Bs[(d * 64 + t) * 64 + j]; P *= a; }
            Pq[seg * 128 + (tid & 127)] = P; Hq[seg * 128 + (tid & 127)] = h;
            __syncthreads();
            if (PASS == 0) {
                if (tid < 128) { float hh = Hq[tid], PP = Pq[tid];
#pragma unroll
                    for (int q = 1; q < 4; ++q) { const float pq = Pq[q * 128 + tid]; hh = pq * hh + Hq[q * 128 + tid]; PP *= pq; }
                    SA[so] = PP; SH[so] = hh; }
            } else {
                float c = cin;
#pragma unroll
                for (int q = 0; q < 3; ++q) if (q < seg) c = Pq[q * 128 + (tid & 127)] * c + Hq[q * 128 + (tid & 127)];
#pragma unroll
                for (int s = 0; s < 16; ++s) { const int st = seg * 16 + s, t = d ? 63 - st : st; c = As[(d * 64 + t) * 64 + j] * c + Bs[(d * 64 + t) * 64 + j]; Bs[(d * 64 + t) * 64 + j] = c; }
                __syncthreads();
                const int t = tid >> 3, c8 = tid & 7;
                f32x4 g0, g1; unpack8(glv, g0, g1);
                const f32x4 f0 = *(const f32x4*)(Bs + t * 64 + c8 * 8), f1 = *(const f32x4*)(Bs + t * 64 + c8 * 8 + 4), r0 = *(const f32x4*)(Bs + (64 + t) * 64 + c8 * 8), r1 = *(const f32x4*)(Bs + (64 + t) * 64 + c8 * 8 + 4);
                *(u32x4*)(GL + go) = pack8((f0 + r0) * g0, (f1 + r1) * g1);
            }
        }
        __syncthreads();
    }
#undef LRU_LOAD
}
__device__ void lru_carry(const Params& p) {
    const float* SA = (const float*)(p.ws + SM_SA); const float* SH = (const float*)(p.ws + SM_SH); float* CIN = (float*)(p.ws + SM_CIN);
    const int tid_ = ltid(p.wave);
    const int G_ = gridDim.x, b0 = lbid(), first = G_ >= 212 ? 192 : 0;
    for (int it = (b0 - first + G_) % G_; it < 20; it += G_) {
        const int c = it * 512 + tid_, ch = c & 1023, d = (c >> 10) & 1, seq = c >> 11;
        const int k0 = seq < 4 ? seq * 32 : 128, nk = seq < 4 ? 32 : 256;
        float carry = 0.f;
        for (int kb = 0; kb < nk; kb += 16) {
            float a[16], h[16];
#pragma unroll
            for (int u = 0; u < 16; ++u) { const int k = d ? (k0 + nk - 1 - (kb + u)) : (k0 + kb + u); a[u] = SA[(size_t)(k * 2 + d) * 1024 + ch]; h[u] = SH[(size_t)(k * 2 + d) * 1024 + ch]; }
            asm volatile("" ::: "memory");
#pragma unroll
            for (int u = 0; u < 16; ++u) { const int k = d ? (k0 + nk - 1 - (kb + u)) : (k0 + kb + u); CIN[(size_t)(k * 2 + d) * 1024 + ch] = carry; carry = a[u] * carry + h[u]; }
        }
    }
}

struct AttnGeom { int hd, seq_start, dil, n_lat, r, q0; };
__device__ __forceinline__ AttnGeom attn_geom(int it) {
    AttnGeom G; G.hd = it / 192; const int qt = it % 192;
    int T, lt; if (qt < 64) { G.seq_start = (qt >> 4) * 2048; T = 2048; lt = qt & 15; } else { G.seq_start = 8192; T = 16384; lt = qt - 64; }
    const int g = G.hd >> 3; G.dil = g == 0 ? 1 : (g == 1 ? 4 : 16); G.n_lat = T / G.dil; const int tpr = G.n_lat >> 7; G.r = lt / tpr; G.q0 = (lt % tpr) << 7; return G;
}
__device__ void attn_items(const Params& p, unsigned char* shm) {
    bf16_t* Ks = (bf16_t*)shm;
    bf16_t* Vt = (bf16_t*)(shm + 36864);
    bf16_t* Ps = (bf16_t*)(shm + 77824);
    float* BT = (float*)(shm + 120832);
    bf16_t* Qb = (bf16_t*)(p.ws + B_Q); const bf16_t* Kb = (const bf16_t*)(p.ws + B_K); const bf16_t* Vb = (const bf16_t*)(p.ws + B_V);
    float* LSE = (float*)(p.ws + SM_LSE);
    const int tid = ltid(p.wave), lane = tid & 63, w = tid >> 6, fr = lane & 15, fq = lane >> 4, G_ = gridDim.x;
    for (int i = tid; i < 24 * 129; i += 512) { const int hd = i / 129, j = i % 129; BT[hd * 132 + j] = p.in[21][(int)BUCKET[hd >> 3][j] * 24 + hd]; }
    u32x4 kreg[5], vreg[5]; bf16x8 q0r, q1r;
    const int total = 24 * 192;
    int it = lbid();
#define ATT_LOAD(IT) do { const AttnGeom G = attn_geom(IT); \
        _Pragma("unroll") for (int i = 0; i < 5; ++i) { const int e = tid + 512 * i, kk = e >> 3, c8 = e & 7, lat = G.q0 - 64 + kk; const bool ok = e < 2176 && kk < 256 && lat >= 0 && lat < G.n_lat; \
            kreg[i] = (u32x4){0u, 0u, 0u, 0u}; vreg[i] = (u32x4){0u, 0u, 0u, 0u}; \
            if (ok) { const size_t go = (size_t)(G.seq_start + G.r + G.dil * lat) * 1536 + G.hd * 64 + c8 * 8; kreg[i] = *(const u32x4*)(Kb + go); vreg[i] = *(const u32x4*)(Vb + go); } } \
        const size_t qo = (size_t)(G.seq_start + G.r + G.dil * (G.q0 + 16 * w + fr)) * 1536 + G.hd * 64; \
        q0r = *(const bf16x8*)(Qb + qo + fq * 8); q1r = *(const bf16x8*)(Qb + qo + 32 + fq * 8); } while (0)
    if (it < total) ATT_LOAD(it);
    for (; it < total; it += G_) {
        const AttnGeom G = attn_geom(it);
#pragma unroll
        for (int i = 0; i < 5; ++i) { const int e = tid + 512 * i, kk = e >> 3, c8 = e & 7;
            if (e < 2176) {
                if (kk < 256) *(u32x4*)(Ks + kk * 72 + c8 * 8) = kreg[i];
#pragma unroll
                for (int j = 0; j < 8; ++j) Vt[(c8 * 8 + j) * 320 + (kk ^ (c8 << 3))] = (bf16_t)((vreg[i][j >> 1] >> ((j & 1) * 16)) & 0xffffu); } }
        const bf16x8 aq0 = q0r, aq1 = q1r;
        __syncthreads();
        if (it + G_ < total) ATT_LOAD(it + G_);
        asm volatile("" ::: "memory");
        const float* bs = BT + G.hd * 132;
        f32x4 s[9];
#pragma unroll
        for (int kt = 0; kt < 9; ++kt) { const bf16_t* kr = Ks + (16 * w + 16 * kt + fr) * 72 + fq * 8;
            f32x4 a = (f32x4){0.f, 0.f, 0.f, 0.f};
            a = __builtin_amdgcn_mfma_f32_16x16x32_bf16(aq0, *(const bf16x8*)kr, a, 0, 0, 0);
            a = __builtin_amdgcn_mfma_f32_16x16x32_bf16(aq1, *(const bf16x8*)(kr + 32), a, 0, 0, 0); s[kt] = a; }
        float mx[4], ls[4];
#pragma unroll
        for (int i = 0; i < 4; ++i) { const int qi = fq * 4 + i; float m = -3.0e38f;
#pragma unroll
            for (int kt = 0; kt < 9; ++kt) { const int rel = 16 * kt + fr - 64 - qi, klat = G.q0 - 64 + 16 * w + 16 * kt + fr;
                const bool ok = rel >= -64 && rel <= 64 && klat >= 0 && klat < G.n_lat; const int bi = min(max(rel + 64, 0), 128);
                const float v = ok ? s[kt][i] + bs[bi] : -1.0e30f; s[kt][i] = v; m = fmaxf(m, v); }
            m = fmaxf(m, __shfl_xor(m, 1)); m = fmaxf(m, __shfl_xor(m, 2)); m = fmaxf(m, __shfl_xor(m, 4)); m = fmaxf(m, __shfl_xor(m, 8));
            float sum = 0.f;
#pragma unroll
            for (int kt = 0; kt < 9; ++kt) { const float pv = __expf(s[kt][i] - m); s[kt][i] = pv; sum += pv; }
            sum += __shfl_xor(sum, 1); sum += __shfl_xor(sum, 2); sum += __shfl_xor(sum, 4); sum += __shfl_xor(sum, 8);
            mx[i] = m; ls[i] = sum; }
        bf16_t* Pw = Ps + w * 16 * 168;
#pragma unroll
        for (int i = 0; i < 4; ++i) {
#pragma unroll
            for (int kt = 0; kt < 9; ++kt) Pw[(fq * 4 + i) * 168 + 16 * kt + fr] = f2bf(s[kt][i]);
            Pw[(fq * 4 + i) * 168 + 144 + fr] = 0; }
        __syncthreads();
        f32x4 o[4];
#pragma unroll
        for (int nt = 0; nt < 4; ++nt) o[nt] = (f32x4){0.f, 0.f, 0.f, 0.f};
#pragma unroll
        for (int ks = 0; ks < 5; ++ks) { const bf16x8 ap = *(const bf16x8*)(Pw + fr * 168 + ks * 32 + fq * 8);
#pragma unroll
            for (int nt = 0; nt < 4; ++nt) { const int dim = nt * 16 + fr; o[nt] = __builtin_amdgcn_mfma_f32_16x16x32_bf16(ap, *(const bf16x8*)(Vt + dim * 320 + ((16 * w + ks * 32 + fq * 8) ^ ((dim >> 3) << 3))), o[nt], 0, 0, 0); } }
        __syncthreads();
#pragma unroll
        for (int i = 0; i < 4; ++i) { const float inv = 1.0f / ls[i];
#pragma unroll
            for (int nt = 0; nt < 4; ++nt) Pw[(fq * 4 + i) * 168 + nt * 16 + fr] = f2bf(o[nt][i] * inv);
            if (fr == 0) LSE[(size_t)(G.seq_start + G.r + G.dil * (G.q0 + 16 * w + fq * 4 + i)) * 24 + G.hd] = mx[i] + __logf(ls[i]); }
        __syncthreads();
#pragma unroll
        for (int h = 0; h < 2; ++h) { const int c = lane + 64 * h, row = c >> 3, c8 = c & 7;
            *(u32x4*)(Qb + (size_t)(G.seq_start + G.r + G.dil * (G.q0 + 16 * w + row)) * 1536 + G.hd * 64 + c8 * 8) = *(const u32x4*)(Pw + row * 168 + c8 * 8); }
        __syncthreads();
    }
#undef ATT_LOAD
}
__device__ void attn_combine(const Params& p) {
    const bf16_t* Ab = (const bf16_t*)(p.ws + B_Q); const float* LSE = (const float*)(p.ws + SM_LSE); bf16_t* YA = (bf16_t*)(p.ws + B_YATT);
    for (int e = lbid() * 512 + ltid(p.wave); e < MT * 64; e += gridDim.x * 512) {
        const int tok = e >> 6, h = (e >> 3) & 7, c8 = e & 7;
        const float l0 = LSE[(size_t)tok * 24 + h], l1 = LSE[(size_t)tok * 24 + 8 + h], l2 = LSE[(size_t)tok * 24 + 16 + h];
        const float m = fmaxf(l0, fmaxf(l1, l2)); float w0 = __expf(l0 - m), w1 = __expf(l1 - m), w2 = __expf(l2 - m); const float inv = 1.0f / (w0 + w1 + w2); w0 *= inv; w1 *= inv; w2 *= inv;
        f32x4 a0, a1, b0, b1, c0, c1;
        const u32x4 ua = *(const u32x4*)(Ab + (size_t)tok * 1536 + h * 64 + c8 * 8), ub = *(const u32x4*)(Ab + (size_t)tok * 1536 + (8 + h) * 64 + c8 * 8), uc = *(const u32x4*)(Ab + (size_t)tok * 1536 + (16 + h) * 64 + c8 * 8);
        asm volatile("" ::: "memory");
        unpack8(ua, a0, a1); unpack8(ub, b0, b1); unpack8(uc, c0, c1);
        *(u32x4*)(YA + (size_t)tok * 512 + h * 64 + c8 * 8) = pack8(a0 * w0 + b0 * w1 + c0 * w2, a1 * w0 + b1 * w1 + c1 * w2);
    }
}


#define XB_TMO      128
#define XB_XCNT(j)  (256  + 64 * (j))
#define XB_XSUB(j)  (1280 + 64 * (j))
#define XB_XGEN(j)  (2304 + 64 * (j))
#define XB_TOP      3328
#define XB_TOPGEN   3392
#define XCD_BAR_WORDS 3456
#define XB_SPIN_CAP (1u << 18)
__device__ __forceinline__ unsigned xb_ld(unsigned* p)              { return __hip_atomic_load(p, __ATOMIC_RELAXED, __HIP_MEMORY_SCOPE_AGENT); }
__device__ __forceinline__ unsigned xb_add(unsigned* p, unsigned v) { return __hip_atomic_fetch_add(p, v, __ATOMIC_RELAXED, __HIP_MEMORY_SCOPE_AGENT); }
__device__ __forceinline__ unsigned xb_xcc_id() { return (unsigned)__builtin_amdgcn_s_getreg((3 << 11) | 20) & 0xFu; }
#define XB_SPIN(cond, bar) do { unsigned _sp = 0; while (cond) { __builtin_amdgcn_s_sleep(1); \
    if ((++_sp & 255u) == 0u) { if (xb_ld(&(bar)[XB_TMO])) break; if (_sp > XB_SPIN_CAP) { atomicAdd(&(bar)[XB_TMO], 1u); break; } } } } while (0)
struct XcdBarrier { unsigned* bar; unsigned x; volatile LAS unsigned* st; };
__device__ __forceinline__ XcdBarrier xcd_barrier_post(unsigned* bar, volatile LAS unsigned* st, int wave) {
    XcdBarrier b; b.bar = bar; b.x = xb_xcc_id(); b.st = st;
    if (ltid(wave) == 0) (void)xb_add(&bar[XB_XCNT(b.x)], 1u);
    return b;
}
__device__ __forceinline__ void xcd_barrier_complete(unsigned* bar, unsigned x, unsigned& nloc, unsigned& nx) {
    const unsigned G = gridDim.x * gridDim.y * gridDim.z;
    unsigned sum, cnt, mine, sp = 0u;
    for (;;) {
        sum = 0u; cnt = 0u; mine = 0u;
#pragma unroll
        for (unsigned j = 0; j < 16; ++j) { const unsigned c = xb_ld(&bar[XB_XCNT(j)]); sum += c; cnt += (c > 0u) ? 1u : 0u; mine = (j == x) ? c : mine; }
        if (sum == G) break;
        __builtin_amdgcn_s_sleep(1);
        if ((++sp & 255u) == 0u) { if (xb_ld(&bar[XB_TMO])) break; if (sp > XB_SPIN_CAP) { atomicAdd(&bar[XB_TMO], 1u); break; } }
    }
    nloc = mine > 0u ? mine : 1u; nx = cnt > 0u ? cnt : 1u;
}
__device__ __forceinline__ void xcd_barrier(const XcdBarrier& b, int wave) {
    asm volatile("s_waitcnt vmcnt(0)" ::: "memory");
    __syncthreads();
    if (ltid(wave) == 0) {
        unsigned* bar = b.bar;
        __builtin_amdgcn_s_waitcnt(0);
        unsigned nloc = b.st[0], nx = b.st[1];
        if (nloc == 0u) { xcd_barrier_complete(bar, b.x, nloc, nx); b.st[0] = nloc; b.st[1] = nx; }
        const unsigned old = xb_add(&bar[XB_XSUB(b.x)], 1u);
        const unsigned gen = old / nloc;
        if (old + 1u == (gen + 1u) * nloc) {
            __builtin_amdgcn_fence(__ATOMIC_RELEASE, "agent");
            asm volatile("s_waitcnt vmcnt(0)" ::: "memory");
            const unsigned og = xb_add(&bar[XB_TOP], 1u);
            const unsigned tg = og / nx;
            if (og + 1u == (tg + 1u) * nx) xb_add(&bar[XB_TOPGEN], 1u);
            else XB_SPIN(xb_ld(&bar[XB_TOPGEN]) == tg, bar);
            __builtin_amdgcn_fence(__ATOMIC_ACQUIRE, "agent");
            xb_add(&bar[XB_XGEN(b.x)], 1u);
            asm volatile("s_waitcnt vmcnt(0)" ::: "memory");
        } else {
            XB_SPIN(xb_ld(&bar[XB_XGEN(b.x)]) == gen, bar);
            __builtin_amdgcn_fence(__ATOMIC_ACQUIRE, "agent");
            asm volatile("s_waitcnt vmcnt(0)" ::: "memory");
        }
    }
    __syncthreads();
}

__device__ __forceinline__ Gemm mk_gemm(const bf16_t* A, int lda, const bf16_t* Bt, int ldb, int K, int nM, int nN, int nb = 1, size_t sA = 0, size_t sB = 0) {
    Gemm g; g.A = A; g.Bt = Bt; g.lda = lda; g.ldb = ldb; g.K = K; g.nM = nM; g.nN = nN; g.nb = nb; g.sA = sA; g.sB = sB; return g; }

__device__ __forceinline__ void tail_park(unsigned char* shm, int tid, const void* wnext, const void* ctr, int code) {
    volatile unsigned* st = (volatile unsigned*)(shm + 131072 + 192);
    if (tid == 0) { const unsigned long long a = (unsigned long long)wnext, b = (unsigned long long)ctr;
        st[0] = (unsigned)a; st[1] = (unsigned)(a >> 32); st[2] = (unsigned)b; st[3] = (unsigned)(b >> 32); st[4] = (unsigned)code; }
}
__device__ __forceinline__ void tail_run(const Params& p, unsigned char* shm) {
    volatile unsigned* st = (volatile unsigned*)(shm + 131072 + 192);
    __syncthreads();
    const unsigned a0 = __builtin_amdgcn_readfirstlane(st[0]), a1 = __builtin_amdgcn_readfirstlane(st[1]), b0 = __builtin_amdgcn_readfirstlane(st[2]), b1 = __builtin_amdgcn_readfirstlane(st[3]);
    const int code = __builtin_amdgcn_readfirstlane(st[4]);
    bf16_t* Wn = (bf16_t*)(((unsigned long long)a1 << 32) | a0); unsigned* ctr = (unsigned*)(((unsigned long long)b1 << 32) | b0);
    if (code & 256) cvt_set(p, shm, Wn, (code >> 4) & 15, code & 15, ctr);
}
__global__ __launch_bounds__(512, 2) void mega(Params p0) {
    Params p = p0; p.wave = __builtin_amdgcn_readfirstlane((int)(threadIdx.x >> 6));
    extern __shared__ __attribute__((aligned(16))) unsigned char shm[];
    LAS unsigned char* lds = (LAS unsigned char*)shm;
    cg::grid_group grid = cg::this_grid();
    volatile LAS unsigned* xst = (volatile LAS unsigned*)(lds + LDS_BYTES - 16);
    XcdBarrier xb; xb.bar = (unsigned*)(p.ws + SM_BAR); xb.x = 0; xb.st = xst;
    if (p.ph_hi - p.ph_lo > 1) { if (ltid(p.wave) == 0) { xst[0] = 0u; xst[1] = 0u; } __syncthreads(); xb = xcd_barrier_post((unsigned*)(p.ws + SM_BAR), xst, p.wave); }
#pragma nounroll
    for (int ph = p.ph_lo; ph < p.ph_hi; ++ph) {
        unsigned char* ws = p.ws; asm volatile("" : "+s"(ws));
        const int l = ph == 0 ? 0 : (ph - 1) / 14, kind = ph == 0 ? 0 : (ph - 1) % 14 + 1;
        const int wsub = kind <= 2 ? 0 : (kind >= 12 ? 2 : 1);
        bf16_t* W = (bf16_t*)(ws + WS_W + (size_t)((l * 3 + wsub) & 1) * WS_WSZ);
        bf16_t* H = (bf16_t*)(ws + WS_H);
        bf16_t* HID = (bf16_t*)(ws + B_HID); bf16_t* Y = (bf16_t*)(ws + B_Y); bf16_t* A2 = (bf16_t*)(ws + B_A2);
        bf16_t* Y1 = (bf16_t*)(ws + B_Y1); bf16_t* Mb = (bf16_t*)(ws + B_M);
        unsigned char* ob = (unsigned char*)p.out; asm volatile("" : "+s"(ob));
        bf16_t* YS5 = (bf16_t*)(ob + O_YS5); const float* RSp = (const float*)(ws + SM_RS);
        const float* ng = p.in[2]; const float* gl_ = ng + l * 6 * DM;
        unsigned* dynq = (unsigned*)(ws + SM_BAR) + XCD_BAR_WORDS;
#ifdef PROBE_MASK
        for (int rep = 0, reps = ((PROBE_MASK >> kind) & 1) ? 2 : 1; rep < reps; ++rep)
#endif
        switch (kind) {
        case 0:
            cvt_set(p, shm, W, 0, 0, nullptr); s5_stage1(p, 0);
            PREP(1) norm_rows(p, 0, 0.f, nullptr);
            break;
        case 1: case 12: {
            EpiSwiglu e; e.O = HID; e.rs = RSp; gemm_phase<EpiSwiglu, true>(lds, mk_gemm(H, LDX, W + W_13, LDX, DM, MT / 256, 44), e, p.wave, dynq + (l * 6 + (kind == 1 ? 0 : 4)) * 128);
            __syncthreads();
            { const int l2 = ph >= 15 ? 1 : 0, k2 = ph - 14 * l2, ws2 = k2 == 1 ? 0 : 2;
              bf16_t* Wn = (bf16_t*)(p.ws + WS_W + (size_t)((l2 * 3 + ws2 + 1) & 1) * WS_WSZ); unsigned* ctr = (unsigned*)(p.ws + SM_BAR) + XCD_BAR_WORDS + 12 * 128 + (l2 * 3 + ws2) * 16;
              if (k2 == 1) cvt_set(p, shm, Wn, l2, 1, ctr); else if (l2 == 0) cvt_set(p, shm, Wn, 1, 0, ctr); }
        } break;
        case 2: case 13: {
            EpiBf16 e; e.O = Y; e.ldc = DM; gemm_phase<EpiBf16, true>(lds, mk_gemm(HID, DFF, W + W_2, DFF, DFF, MT / 256, 8), e, p.wave, dynq + (l * 6 + (kind == 2 ? 1 : 5)) * 128);
        } break;
        case 3:
            s5_stage2(p, l);
            norm_rows(p, 1, 0.5f, gl_ + 1 * DM);
            if ((PROBE2 >> 1) & 1) norm_rows(p, 1, 0.0f, gl_ + 1 * DM);
            break;
        case 4: {
            EpiWin e; e.ws = ws; e.rs = RSp; gemm_phase<EpiWin, true>(lds, mk_gemm(H, LDX, W + W_IN, LDX, DM, MT / 256, 54), e, p.wave, dynq + (l * 6 + 2) * 128);
            __syncthreads();
            { const int l2 = ph >= 15 ? 1 : 0;
              bf16_t* Wn = (bf16_t*)(p.ws + WS_W + (size_t)((l2 * 3 + 2) & 1) * WS_WSZ); unsigned* ctr = (unsigned*)(p.ws + SM_BAR) + XCD_BAR_WORDS + 12 * 128 + (l2 * 3 + 1) * 16;
              cvt_set(p, shm, Wn, l2, 2, ctr); }
        } break;
        case 5: {
            PREP(3) { EpiS e; e.S = (float*)(ob + O_S); gemm_phase(lds, mk_gemm(A2, 512, (const bf16_t*)(ws + SM_G), 256, 256, NSUB / 256, 1, 64, (size_t)NSUB * 512, 65536), e, p.wave); }
            __syncthreads();
            PREP(4) lru_items<0>(p, shm, l);
            attn_items(p, shm);
        } break;
        case 6:
            PREP(5) { lru_carry(p); s5_bscan(p, shm); attn_combine(p); }
            s5_stage3(p, l);
            break;
        case 7: {
            PREP(3) { EpiY e; e.Y1 = Y1; gemm_phase(lds, mk_gemm(A2, 512, (const bf16_t*)(ws + SM_Y), 512, 512, NSUB / 256, 1, 64, (size_t)NSUB * 512, 131072), e, p.wave); }
            __syncthreads();
            lru_items<1>(p, shm, l);
        } break;
        case 8: {
            EpiGlu e; e.Y1 = Y1; e.O = YS5; e.bias = p.in[20] + l * 1024; gemm_phase(lds, mk_gemm(Y1, 1024, W + W_GLU, 1024, 1024, MT / 256, 4), e, p.wave);
        } break;
        case 9: {
            { EpiMerge<true> e; e.Gt = (const bf16_t*)(ws + B_GA); e.Mo = Mb; gemm_phase(lds, mk_gemm((const bf16_t*)(ws + B_GL), 1024, W + W_BRL, 1024, 1024, MT / 256, 8), e, p.wave); }
            { EpiMerge<false> e; e.Gt = (const bf16_t*)(ws + B_GB); e.Mo = Mb; gemm_phase(lds, mk_gemm(YS5, 1024, W + W_BRS, 1024, 1024, MT / 256, 8), e, p.wave); }
            { EpiMerge<false> e; e.Gt = (const bf16_t*)(ws + B_GC); e.Mo = Mb; gemm_phase(lds, mk_gemm((const bf16_t*)(ws + B_YATT), 512, W + W_BRA, 512, 512, MT / 256, 8), e, p.wave); }
        } break;
        case 10: {
            EpiBf16 e; e.O = Y; e.ldc = DM; gemm_phase<EpiBf16, true>(lds, mk_gemm(Mb, DM, W + W_OUT, DM, DM, MT / 256, 8), e, p.wave, dynq + (l * 6 + 3) * 128);
        } break;
        case 11:
            norm_rows(p, 1, 1.0f, gl_ + 3 * DM);
            if ((PROBE2 >> 1) & 1) norm_rows(p, 1, 0.0f, gl_ + 3 * DM);
            break;
        default:
            if (l == 0) s5_stage1(p, 1);
            norm_rows(p, l == 0 ? 1 : 2, 0.5f, gl_ + 5 * DM);
            break;
        }
        if (ph + 1 < p.ph_hi) { if (p.ph_hi > 4096) grid.sync(); else xcd_barrier(xb, p.wave); }
    }
}
constexpr int N_PHASES = 1 + 2 * 14;

extern "C" void kernel_launch(void* const* d_in, const int* in_sizes, int n_in, void* d_out, int out_size, void* d_ws, size_t ws_size, hipStream_t stream) {
    static int grid = 0;
    if (grid == 0) {
        if (n_in != 29 || ws_size < WS_END) { fprintf(stderr, "kernel_launch: need 29 inputs and %zu bytes of workspace (got %d, %zu)\n", (size_t)WS_END, n_in, ws_size); grid = -1; return; }
        if (hipFuncSetAttribute((const void*)mega, hipFuncAttributeMaxDynamicSharedMemorySize, LDS_BYTES) != hipSuccess) { fprintf(stderr, "hipFuncSetAttribute failed\n"); grid = -1; return; }
        int dev = 0, cus = 0, per_cu = 0;
        (void)hipGetDevice(&dev); (void)hipDeviceGetAttribute(&cus, hipDeviceAttributeMultiprocessorCount, dev);
        (void)hipOccupancyMaxActiveBlocksPerMultiprocessor(&per_cu, (const void*)mega, 512, LDS_BYTES);
        if (per_cu < 1) per_cu = 1;
        (void)hipGetLastError();
        grid = cus * 1;
    }
    if (grid < 0) return;
    Params p{};
    for (int i = 0; i < 29; ++i) p.in[i] = (const float*)d_in[i];
    p.out = (float*)d_out; p.ws = (unsigned char*)d_ws;
    if (hipMemsetAsync((char*)d_ws + SM_BAR, 0, (XCD_BAR_WORDS + 13 * 128) * sizeof(unsigned), stream) != hipSuccess) { fprintf(stderr, "memset of the barrier / ticket words failed\n"); return; }
#if ONE_LAUNCH
    p.ph_lo = 0; p.ph_hi = N_PHASES;
    void* args[] = {&p};
    hipError_t e = hipLaunchCooperativeKernel((void*)mega, dim3(grid), dim3(512), args, LDS_BYTES, stream);
    if (e != hipSuccess) fprintf(stderr, "cooperative launch failed: %s (grid %d)\n", hipGetErrorString(e), grid);
#else
    for (int ph = 0; ph < N_PHASES; ++ph) { p.ph_lo = ph; p.ph_hi = ph + 1; hipLaunchKernelGGL(mega, dim3(grid), dim3(512), LDS_BYTES, stream, p); }
#endif
}
```
